# Optimizing an MI355X kernel written in HIP

```python
import math
import jax, jax.numpy as jnp
from jax import lax
import numpy as np


D_MODEL = 1024
BATCH = 8
SEQ = 2048
DEPTH = 2
DEC_BATCH = 8
DEC_SEQ = 32
PAST_LEN = 2048

CHUNK = 64
Q_BLOCK = 128
POOL_WIDTH = D_MODEL // 4
POOL_WINDOWS = (2, 4, 8, 16)
POOL_GROUPS = len(POOL_WINDOWS)
POOL_GROUP_DIM = POOL_WIDTH // POOL_GROUPS
POOL_HIST = max(POOL_WINDOWS) - 1
ATTN_WIDTH = D_MODEL // 2
N_HEADS = 4
HEAD_DIM = ATTN_WIDTH // (2 * N_HEADS)
V_DIM = 2 * HEAD_DIM
ROPE_THETA = 10000.0
CONV_WIDTH = D_MODEL // 4
CONV_K = 31
CONV_HIST = CONV_K - 1
MIX_WIDTH = POOL_WIDTH + ATTN_WIDTH + CONV_WIDTH
IN_WIDTH = POOL_WIDTH + 3 * ATTN_WIDTH + 2 * CONV_WIDTH
D_FF = ((-(-8 * D_MODEL // 3) + 255) // 256) * 256
EPS = 1e-6

kernel_name = "hybrid_pool_diffattn_conformer_stream_step"


def rms_norm(x, g):
    xf = x.astype(jnp.float32)
    y = xf * lax.rsqrt(jnp.mean(xf * xf, axis=-1, keepdims=True) + EPS)
    return (y * g.astype(jnp.float32)).astype(x.dtype)


def layer_norm(x, g, b):
    xf = x.astype(jnp.float32)
    mu = jnp.mean(xf, axis=-1, keepdims=True)
    xc = xf - mu
    y = xc * lax.rsqrt(jnp.mean(xc * xc, axis=-1, keepdims=True) + EPS)
    return (y * g.astype(jnp.float32) + b.astype(jnp.float32)).astype(x.dtype)


def rope(x, pos):
    half = HEAD_DIM // 2
    inv = ROPE_THETA ** (-jnp.arange(half, dtype=jnp.float32) / half)
    ang = pos.astype(jnp.float32)[:, None] * inv[None, :]
    cos = jnp.cos(ang)[:, None, None, :]
    sin = jnp.sin(ang)[:, None, None, :]
    xf = x.astype(jnp.float32)
    x1, x2 = xf[..., :half], xf[..., half:]
    return jnp.concatenate([x1 * cos - x2 * sin, x2 * cos + x1 * sin], axis=-1).astype(x.dtype)


def pool_mixer(u, hist, pos, pool_w, pool_scale):
    L = u.shape[1]
    ext = jnp.concatenate([hist, u], axis=1)
    c = jnp.cumsum(ext.astype(jnp.float32), axis=1)
    cz = jnp.concatenate([jnp.zeros_like(c[:, :1]), c], axis=1)
    uf = u.astype(jnp.float32)
    outs = []
    for g, w in enumerate(POOL_WINDOWS):
        sl = slice(g * POOL_GROUP_DIM, (g + 1) * POOL_GROUP_DIM)
        win_sum = cz[:, POOL_HIST + 1:POOL_HIST + 1 + L, sl] - cz[:, POOL_HIST + 1 - w:POOL_HIST + 1 - w + L, sl]
        count = jnp.minimum(pos + 1, w).astype(jnp.float32)[None, :, None]
        d = win_sum / count - uf[..., sl]
        outs.append(jnp.einsum('blc,cd->bld', d.astype(u.dtype), pool_w[g]))
    y = jnp.concatenate(outs, axis=-1) * pool_scale
    return y, ext[:, -POOL_HIST:]


def diff_attention(q, k, v, lam, mask):
    s = jnp.einsum('bqhcd,bkhcd->bhcqk', q, k, preferred_element_type=jnp.float32) * (HEAD_DIM ** -0.5)
    if mask is not None:
        s = jnp.where(mask, s, -1e30)
    p = jax.nn.softmax(s, axis=-1)
    pd = p[:, :, 0] - lam * p[:, :, 1]
    return jnp.einsum('bhqk,bkhe->bqhe', pd.astype(v.dtype), v)


def prompt_attention(q, k, v, lam):
    B, S = q.shape[0], q.shape[1]
    nb = S // Q_BLOCK
    qb = q.reshape(B, nb, Q_BLOCK, N_HEADS, 2, HEAD_DIM).transpose(1, 0, 2, 3, 4, 5)
    key_chunk = jnp.arange(S) // CHUNK

    def block(args):
        qi, i = args
        q_chunk = (i * Q_BLOCK + jnp.arange(Q_BLOCK)) // CHUNK
        mask = key_chunk[None, :] <= q_chunk[:, None]
        return diff_attention(qi, k, v, lam, mask)

    o = lax.map(block, (qb, jnp.arange(nb)))
    return o.transpose(1, 0, 2, 3, 4).reshape(B, S, N_HEADS, V_DIM)


def conv_mixer(a, b, hist, conv_dw, conv_dw_b, conv_ln_g, conv_ln_b, conv_pw):
    u = a * jax.nn.sigmoid(b)
    ext = jnp.concatenate([hist, u], axis=1)
    y = lax.conv_general_dilated(ext, conv_dw[:, None, :], window_strides=(1,), padding='VALID',
                                 dimension_numbers=('NWC', 'WIO', 'NWC'), feature_group_count=CONV_WIDTH)
    y = layer_norm(y + conv_dw_b, conv_ln_g, conv_ln_b)
    y = jax.nn.silu(y) @ conv_pw
    return y, ext[:, -CONV_HIST:]


def hybrid_layer(x, pos, pool_hist, conv_hist, past_k, past_v, layer,
                 norm_mix_g, w_in, pool_w, pool_scale, lambda_qk, diff_norm_g,
                 conv_dw, conv_dw_b, conv_ln_g, conv_ln_b, conv_pw, w_out,
                 norm_ffn_g, w_gate_up, w_down):
    B, L, _ = x.shape
    h = rms_norm(x, norm_mix_g)
    z = h @ w_in
    o1 = POOL_WIDTH
    o2 = o1 + ATTN_WIDTH
    o3 = o2 + ATTN_WIDTH
    o4 = o3 + ATTN_WIDTH
    o5 = o4 + CONV_WIDTH
    u_pool = z[..., :o1]
    q = rope(z[..., o1:o2].reshape(B, L, N_HEADS, 2, HEAD_DIM), pos)
    k = rope(z[..., o2:o3].reshape(B, L, N_HEADS, 2, HEAD_DIM), pos)
    v = z[..., o3:o4].reshape(B, L, N_HEADS, V_DIM)
    a_conv = z[..., o4:o5]
    b_conv = z[..., o5:]

    y_pool, new_pool = pool_mixer(u_pool, pool_hist, pos, pool_w, pool_scale)

    lam_init = 0.8 - 0.6 * math.exp(-0.3 * layer)
    lq = lambda_qk.astype(jnp.float32)
    lam = jnp.exp(jnp.sum(lq[0] * lq[1])) - jnp.exp(jnp.sum(lq[2] * lq[3])) + lam_init
    if past_k is None:
        o = prompt_attention(q, k, v, lam)
    else:
        o = diff_attention(q, jnp.concatenate([past_k, k], axis=1), jnp.concatenate([past_v, v], axis=1), lam, None)
    o = (rms_norm(o, diff_norm_g) * (1.0 - lam_init)).reshape(B, L, ATTN_WIDTH)

    y_conv, new_conv = conv_mixer(a_conv, b_conv, conv_hist, conv_dw, conv_dw_b, conv_ln_g, conv_ln_b, conv_pw)

    x = x + jnp.concatenate([y_pool, o, y_conv], axis=-1) @ w_out
    h = rms_norm(x, norm_ffn_g)
    g, u = jnp.split(h @ w_gate_up, 2, axis=-1)
    x = x + (jax.nn.silu(g) * u) @ w_down
    return x, k, v, new_pool, new_conv


def setup_inputs(seed: int = 0) -> dict:
    key = jax.random.key(seed)
    ks = jax.random.split(key, 24)
    f = jnp.float32
    nrm = lambda k, shape, s: jax.random.normal(k, shape, f) * s
    return {
        "x_prompt": nrm(ks[0], (BATCH, SEQ, D_MODEL), 1.0),
        "x_sample": nrm(ks[1], (DEC_BATCH, DEC_SEQ, D_MODEL), 1.0),
        "cache_k": nrm(ks[2], (DEPTH, DEC_BATCH, PAST_LEN, N_HEADS, 2, HEAD_DIM), 1.0),
        "cache_v": nrm(ks[3], (DEPTH, DEC_BATCH, PAST_LEN, N_HEADS, V_DIM), 1.0),
        "state_pool": nrm(ks[4], (DEPTH, DEC_BATCH, POOL_HIST, POOL_WIDTH), 1.0),
        "state_conv": nrm(ks[5], (DEPTH, DEC_BATCH, CONV_HIST, CONV_WIDTH), 0.5),
        "norm_mix_g": 1.0 + nrm(ks[6], (DEPTH, D_MODEL), 0.05),
        "w_in": nrm(ks[7], (DEPTH, D_MODEL, IN_WIDTH), D_MODEL ** -0.5),
        "pool_w": nrm(ks[8], (DEPTH, POOL_GROUPS, POOL_GROUP_DIM, POOL_GROUP_DIM), POOL_GROUP_DIM ** -0.5),
        "pool_scale": 1.0 + nrm(ks[9], (DEPTH, POOL_WIDTH), 0.1),
        "lambda_qk": nrm(ks[10], (DEPTH, 4, HEAD_DIM), 0.1),
        "diff_norm_g": 1.0 + nrm(ks[11], (DEPTH, V_DIM), 0.05),
        "conv_dw": nrm(ks[12], (DEPTH, CONV_K, CONV_WIDTH), CONV_K ** -0.5),
        "conv_dw_b": nrm(ks[13], (DEPTH, CONV_WIDTH), 0.01),
        "conv_ln_g": 1.0 + nrm(ks[14], (DEPTH, CONV_WIDTH), 0.05),
        "conv_ln_b": nrm(ks[15], (DEPTH, CONV_WIDTH), 0.01),
        "conv_pw": nrm(ks[16], (DEPTH, CONV_WIDTH, CONV_WIDTH), CONV_WIDTH ** -0.5),
        "w_out": nrm(ks[17], (DEPTH, MIX_WIDTH, D_MODEL), MIX_WIDTH ** -0.5),
        "norm_ffn_g": 1.0 + nrm(ks[18], (DEPTH, D_MODEL), 0.05),
        "w_gate_up": nrm(ks[19], (DEPTH, D_MODEL, 2 * D_FF), D_MODEL ** -0.5),
        "w_down": nrm(ks[20], (DEPTH, D_FF, D_MODEL), D_FF ** -0.5),
        "final_norm_g": 1.0 + nrm(ks[21], (D_MODEL,), 0.05),
    }


def reference(x_prompt, x_sample, cache_k, cache_v, state_pool, state_conv,
              norm_mix_g, w_in, pool_w, pool_scale, lambda_qk, diff_norm_g,
              conv_dw, conv_dw_b, conv_ln_g, conv_ln_b, conv_pw, w_out,
              norm_ffn_g, w_gate_up, w_down, final_norm_g):
    B, S, _ = x_prompt.shape
    Ls = x_sample.shape[1]
    past_len = cache_k.shape[2]
    pos_p = jnp.arange(S, dtype=jnp.int32)
    pos_s = past_len + jnp.arange(Ls, dtype=jnp.int32)
    zero_pool = jnp.zeros((B, POOL_HIST, POOL_WIDTH), x_prompt.dtype)
    zero_conv = jnp.zeros((B, CONV_HIST, CONV_WIDTH), x_prompt.dtype)

    xp, xs = x_prompt, x_sample
    kp, vp, pp, cp = [], [], [], []
    ks_, vs_, ps_, cs_ = [], [], [], []
    for l in range(DEPTH):
        w = (norm_mix_g[l], w_in[l], pool_w[l], pool_scale[l], lambda_qk[l], diff_norm_g[l],
             conv_dw[l], conv_dw_b[l], conv_ln_g[l], conv_ln_b[l], conv_pw[l], w_out[l],
             norm_ffn_g[l], w_gate_up[l], w_down[l])
        xp, k1, v1, p1, c1 = hybrid_layer(xp, pos_p, zero_pool, zero_conv, None, None, l, *w)
        xs, k2, v2, p2, c2 = hybrid_layer(xs, pos_s, state_pool[l], state_conv[l], cache_k[l], cache_v[l], l, *w)
        kp.append(k1); vp.append(v1); pp.append(p1); cp.append(c1)
        ks_.append(k2); vs_.append(v2); ps_.append(p2); cs_.append(c2)

    y_prompt = rms_norm(xp, final_norm_g)
    y_sample = rms_norm(xs, final_norm_g)
    return (y_prompt, y_sample,
            jnp.stack(kp), jnp.stack(vp), jnp.stack(pp), jnp.stack(cp),
            jnp.stack(ks_), jnp.stack(vs_), jnp.stack(ps_), jnp.stack(cs_))
```

```cpp
#define MK_MULTI 0
#include <hip/hip_runtime.h>
#include <hip/hip_cooperative_groups.h>
#include <cstdio>
#include <cstdint>
namespace cg = cooperative_groups;
namespace pg8 {
#define PG8_LAS __attribute__((address_space(3)))
typedef unsigned short bf16_t;
typedef short bf16x8 __attribute__((ext_vector_type(8)));
typedef float f32x4 __attribute__((ext_vector_type(4)));
typedef unsigned u32x4 __attribute__((ext_vector_type(4)));
constexpr int BM = 256, BK = 64, HALF = 128, HTB = HALF * BK * 2  , STAGE_BYTES = 8 * HTB, NXCD = 8, WGM = 8;

__host__ __device__ __forceinline__ int lds_byte(int r, int c) { const int st = (r >> 4) * 2 + (c >> 5), rr = r & 15, cc = c & 31, ob = rr * 64 + cc * 2; return st * 1024 + (ob ^ (((ob >> 9) & 1) << 5)); }
__host__ __device__ __forceinline__ void stage_rc(int b, int& R, int& C) { const int st = b / 1024, sb = b % 1024, swz = sb ^ (((sb >> 9) & 1) << 5); R = (st >> 1) * 16 + swz / 64; C = (st & 1) * 32 + (swz % 64) / 2; }
__host__ __device__ __forceinline__ int perm32(int rho) { const int n = rho >> 4, i = rho & 15; return 8 * (i >> 2) + 4 * n + (i & 3); }

struct Unit { int pm, pn; };
struct Gemm { const bf16_t* A; const bf16_t* Bt; int M, N, K; };

struct StaticOrder {
    int nM, nN, nwg, G, c;
    __host__ __device__ void init(int M, int N, int G_, int c_) { nM = M / BM; nN = N / BM; nwg = nM * nN; G = G_; c = c_; }
    __host__ __device__ bool next(int i, Unit& u) const {
        const long L = (long)i * G + c; if (L >= nwg) return false;
        int wgid = (int)L; { const int q = nwg / NXCD, r = nwg % NXCD, xcd = wgid % NXCD, off = wgid / NXCD; wgid = (xcd < r ? xcd * (q + 1) : r * (q + 1) + (xcd - r) * q) + off; }
        const int nig = WGM * nN, gid = wgid / nig, fm = gid * WGM, gsz = (nM - fm) < WGM ? (nM - fm) : WGM;
        u.pm = fm + ((wgid % nig) % gsz); u.pn = (wgid % nig) / gsz; return true;
    }
    __device__ __forceinline__ void a_ready(const Unit&) const {}
    __device__ __forceinline__ void done(const Unit&) const {}
};

__device__ __forceinline__ unsigned cvt_pk_bf16(float lo, float hi) { unsigned r; asm volatile("v_cvt_pk_bf16_f32 %0, %1, %2" : "=v"(r) : "v"(lo), "v"(hi)); return r; }
typedef float f32x2 __attribute__((ext_vector_type(2)));
template <class Epi, class Sched, bool ALIGN_EPI = false, bool SP2 = false>
__device__ __forceinline__ void gemm_phase(PG8_LAS unsigned char* lds, const Gemm g, const Sched& S, const Epi& E) {
    int tid_l = threadIdx.x; asm volatile("" : "+v"(tid_l));
    const int tid = tid_l, wid = __builtin_amdgcn_readfirstlane(tid >> 6), lane = tid & 63, wr = wid >> 2, wc = wid & 3, fr = lane & 15, fq = lane >> 4;
    const int K = g.K, nt = K / BK;
    unsigned voffA[2], voffB[2];
#pragma unroll
    for (int i = 0; i < 2; ++i) { int R, C; stage_rc(tid * 16 + i * 8192, R, C); const int Rb = Epi::PERM ? ((R & ~31) + perm32(R & 31)) : R;
        voffA[i] = (unsigned)(R * K + C) * 2u; voffB[i] = (unsigned)(Rb * K + C) * 2u; }
    const size_t kstep = (size_t)(BK * 2);
    const size_t hstep = (size_t)HALF * K * 2;
    const size_t tstep = 2 * hstep;
    const unsigned ldsw = (unsigned)wid * 1024u;
    const int aoff = lds_byte(wr * 64 + fr, fq * 8), boff = lds_byte(wc * 32 + fr, fq * 8);
#define PG8_SA(b, h) (((b) * 2 + (h)) * HTB)
#define PG8_SB(b, h) ((4 + (b) * 2 + (h)) * HTB)
#define PG8_STAGE(bufoff, gbase, voff) do { _Pragma("unroll") for (int _i = 0; _i < 2; ++_i) \
        __builtin_amdgcn_global_load_lds((const unsigned*)((const char*)(gbase) + (voff)[_i]), (PG8_LAS unsigned*)(lds + (bufoff) + ldsw + _i * 8192), 16, 0, 0); } while (0)
#define PG8_LDA(dst, b, h) do { _Pragma("unroll") for (int m = 0; m < 4; ++m) _Pragma("unroll") for (int k = 0; k < 2; ++k) dst[m][k] = *(const PG8_LAS bf16x8*)(lds + PG8_SA(b, h) + aoff + m * 2048 + k * 1024); } while (0)
#define PG8_LDB(dst, b, h) do { _Pragma("unroll") for (int n = 0; n < 2; ++n) _Pragma("unroll") for (int k = 0; k < 2; ++k) dst[n][k] = *(const PG8_LAS bf16x8*)(lds + PG8_SB(b, h) + boff + n * 2048 + k * 1024); } while (0)
#define PG8_MMA(ai, bj, At, Bt) do { __builtin_amdgcn_s_setprio(1); _Pragma("unroll") for (int m = 0; m < 4; ++m) _Pragma("unroll") for (int n = 0; n < 2; ++n) _Pragma("unroll") for (int k = 0; k < 2; ++k) \
        acc[ai][bj][m][n] = __builtin_amdgcn_mfma_f32_16x16x32_bf16(Bt[n][k], At[m][k], acc[ai][bj][m][n], 0, 0, 0); __builtin_amdgcn_s_setprio(0); } while (0)
#define PG8_WAIT_V(n) asm volatile("s_waitcnt vmcnt(" #n ")" ::: "memory")
#define PG8_WAIT_L(n) asm volatile("s_waitcnt lgkmcnt(" #n ")" ::: "memory")
#define PG8_BAR __builtin_amdgcn_s_barrier()
#define PG8_SCHED __builtin_amdgcn_sched_barrier(0)
    Unit cur, nxt; int ui = 0;
    if (!S.next(0, cur)) return;
    f32x4 acc[2][2][4][2];
#pragma unroll
    for (int a = 0; a < 2; ++a)
#pragma unroll
        for (int b = 0; b < 2; ++b)
#pragma unroll
            for (int m = 0; m < 4; ++m)
#pragma unroll
                for (int n = 0; n < 2; ++n) acc[a][b][m][n] = (f32x4){0.f, 0.f, 0.f, 0.f};
    bf16x8 At[4][2], B0[2][2], B1[2][2];
    const char* cA = (const char*)g.A + (size_t)cur.pm * tstep; const char* cB = (const char*)g.Bt + (size_t)cur.pn * tstep;
    S.a_ready(cur);
    if constexpr (SP2) {
        PG8_STAGE(PG8_SB(0, 0), cB, voffB); PG8_STAGE(PG8_SB(0, 1), cB + hstep, voffB); PG8_STAGE(PG8_SA(0, 0), cA, voffA); PG8_STAGE(PG8_SA(0, 1), cA + hstep, voffA);
        if (wr == 1) PG8_BAR;
        PG8_WAIT_V(2); PG8_BAR;
        PG8_STAGE(PG8_SB(1, 0), cB + kstep, voffB); PG8_STAGE(PG8_SA(1, 0), cA + kstep, voffA); PG8_STAGE(PG8_SB(1, 1), cB + hstep + kstep, voffB);
        PG8_WAIT_V(6); PG8_BAR;
    } else {
        PG8_STAGE(PG8_SB(0, 0), cB, voffB); PG8_STAGE(PG8_SA(0, 0), cA, voffA); PG8_STAGE(PG8_SB(0, 1), cB + hstep, voffB); PG8_STAGE(PG8_SA(0, 1), cA + hstep, voffA);
        if (wr == 1) PG8_BAR;
        PG8_WAIT_V(4); PG8_BAR;
        PG8_STAGE(PG8_SB(1, 0), cB + kstep, voffB); PG8_STAGE(PG8_SA(1, 0), cA + kstep, voffA); PG8_STAGE(PG8_SB(1, 1), cB + hstep + kstep, voffB);
        PG8_WAIT_V(6); PG8_BAR;
    }
    for (;;) {
        const bool has_next = S.next(ui + 1, nxt);
        const char* nA = has_next ? (const char*)g.A + (size_t)nxt.pm * tstep : cA; const char* nB = has_next ? (const char*)g.Bt + (size_t)nxt.pn * tstep : cB;
        for (int t = 0; t < nt; t += 2) {
            const bool last = (t == nt - 2);
            const char* a1 = cA + (size_t)(t + 1) * kstep;
            const char* a2 = last ? nA : cA + (size_t)(t + 2) * kstep; const char* b2 = last ? nB : cB + (size_t)(t + 2) * kstep;
            const char* a3 = a2 + kstep; const char* b3 = b2 + kstep;
            if (last && has_next) S.a_ready(nxt);
            if constexpr (SP2) {
            PG8_LDB(B0, 0, 0); PG8_LDB(B1, 0, 1); PG8_SCHED; PG8_LDA(At, 0, 0); PG8_STAGE(PG8_SA(1, 1), a1 + hstep, voffA);
            PG8_WAIT_V(8); PG8_WAIT_L(0); PG8_BAR; PG8_MMA(0, 0, At, B0); PG8_MMA(0, 1, At, B1); PG8_BAR; PG8_SCHED;
            PG8_LDA(At, 0, 1); PG8_STAGE(PG8_SB(0, 0), b2, voffB); PG8_STAGE(PG8_SB(0, 1), b2 + hstep, voffB); PG8_STAGE(PG8_SA(0, 0), a2, voffA);
            PG8_WAIT_V(8); PG8_WAIT_L(0); PG8_BAR; PG8_MMA(1, 0, At, B0); PG8_MMA(1, 1, At, B1); PG8_BAR; PG8_SCHED;
            PG8_LDB(B0, 1, 0); PG8_LDB(B1, 1, 1); PG8_SCHED; PG8_LDA(At, 1, 0); PG8_STAGE(PG8_SA(0, 1), a2 + hstep, voffA);
            PG8_WAIT_V(8); PG8_WAIT_L(0); PG8_BAR; PG8_MMA(0, 0, At, B0); PG8_MMA(0, 1, At, B1); PG8_BAR; PG8_SCHED;
            PG8_LDA(At, 1, 1); PG8_STAGE(PG8_SB(1, 0), b3, voffB); PG8_STAGE(PG8_SB(1, 1), b3 + hstep, voffB); PG8_STAGE(PG8_SA(1, 0), a3, voffA);
            PG8_WAIT_V(8); PG8_WAIT_L(0); PG8_BAR; PG8_MMA(1, 0, At, B0); PG8_MMA(1, 1, At, B1); PG8_BAR; PG8_SCHED;
            } else {
            PG8_LDB(B0, 0, 0); PG8_SCHED; PG8_LDA(At, 0, 0); PG8_STAGE(PG8_SA(1, 1), a1 + hstep, voffA);
            PG8_WAIT_L(8); PG8_BAR; PG8_WAIT_L(0); PG8_MMA(0, 0, At, B0); PG8_BAR; PG8_SCHED;
            PG8_LDB(B1, 0, 1); PG8_STAGE(PG8_SB(0, 0), b2, voffB);
            PG8_BAR; PG8_WAIT_L(0); PG8_MMA(0, 1, At, B1); PG8_BAR;
            PG8_LDA(At, 0, 1); PG8_STAGE(PG8_SA(0, 0), a2, voffA);
            PG8_BAR; PG8_WAIT_L(0); PG8_MMA(1, 0, At, B0); PG8_BAR; PG8_SCHED;
            PG8_STAGE(PG8_SB(0, 1), b2 + hstep, voffB);
            PG8_WAIT_V(6); PG8_BAR; PG8_MMA(1, 1, At, B1); PG8_BAR;
            PG8_LDB(B0, 1, 0); PG8_SCHED; PG8_LDA(At, 1, 0); PG8_STAGE(PG8_SA(0, 1), a2 + hstep, voffA);
            PG8_WAIT_L(8); PG8_BAR; PG8_WAIT_L(0); PG8_MMA(0, 0, At, B0); PG8_BAR; PG8_SCHED;
            PG8_LDB(B1, 1, 1); PG8_STAGE(PG8_SB(1, 0), b3, voffB);
            PG8_BAR; PG8_WAIT_L(0); PG8_MMA(0, 1, At, B1); PG8_BAR;
            PG8_LDA(At, 1, 1); PG8_STAGE(PG8_SA(1, 0), a3, voffA);
            PG8_BAR; PG8_WAIT_L(0); PG8_MMA(1, 0, At, B0); PG8_BAR; PG8_SCHED;
            PG8_STAGE(PG8_SB(1, 1), b3 + hstep, voffB);
            PG8_WAIT_V(6); PG8_BAR; PG8_MMA(1, 1, At, B1); PG8_BAR;
            }
        }
        if constexpr (ALIGN_EPI) { if (wr == 0) PG8_BAR; }
        if constexpr (!Epi::AFTER_DRAIN) { E(acc, cur, wr, wc, fr, fq); S.done(cur); }
        if (!has_next) break;
#pragma unroll
        for (int a = 0; a < 2; ++a)
#pragma unroll
            for (int b = 0; b < 2; ++b)
#pragma unroll
                for (int m = 0; m < 4; ++m)
#pragma unroll
                    for (int n = 0; n < 2; ++n) acc[a][b][m][n] = (f32x4){0.f, 0.f, 0.f, 0.f};
        cur = nxt; cA = nA; cB = nB; ++ui;
        if constexpr (ALIGN_EPI) { if (wr == 1) PG8_BAR; }
    }
    PG8_WAIT_V(0);
    if constexpr (!ALIGN_EPI) { if (wr == 0) PG8_BAR; }
    PG8_BAR;
    if constexpr (Epi::AFTER_DRAIN) { E.fused(acc, cur, wr, wc, fr, fq, lds, wid, lane); S.done(cur); }
#undef PG8_SA
#undef PG8_SB
#undef PG8_STAGE
#undef PG8_LDA
#undef PG8_LDB
#undef PG8_MMA
#undef PG8_WAIT_V
#undef PG8_WAIT_L
#undef PG8_BAR
#undef PG8_SCHED
}
}
#define PG8_SP2 true
#define PG8_ALIGN true
namespace pg8 {
constexpr int MT = 16640, MP = 16384;
constexpr float RMS_EPS = 1e-6f;
constexpr float QC2 = 0.125f * 1.4426950408889634f;
typedef unsigned u32x2 __attribute__((ext_vector_type(2)));
__device__ __forceinline__ float row_rs(const float* SS, int row, int fq) {
    float s = 0.f;
#pragma unroll
    for (int j = 0; j < 4; ++j) s += SS[(unsigned)(4 * fq + j) * MT + row];
    s += __shfl_xor(s, 16); s += __shfl_xor(s, 32);
    return rsqrtf(s * (1.0f / 1024.0f) + RMS_EPS);
}
__device__ __forceinline__ void rows_rs8(const float* SS, int row0, int fq, float (&r)[8]) {
    float s[8][4];
    if (row0 < MP) {
#pragma unroll
        for (int k = 0; k < 8; ++k)
#pragma unroll
            for (int j = 0; j < 4; ++j) s[k][j] = SS[(unsigned)(4 * fq + j) * MT + row0 + (k >> 2) * HALF + (k & 3) * 16];
    } else { const float* S2 = SS + 16 * MT + (row0 - MP);
#pragma unroll
        for (int h2 = 0; h2 < 2; ++h2) { float q[4][8];
            __builtin_amdgcn_sched_barrier(0);
#pragma unroll
            for (int k = 0; k < 4; ++k)
#pragma unroll
                for (int j = 0; j < 8; ++j) q[k][j] = S2[(unsigned)(8 * fq + j) * 256 + h2 * HALF + k * 16];
            __builtin_amdgcn_sched_barrier(0);
#pragma unroll
            for (int k = 0; k < 4; ++k)
#pragma unroll
                for (int j = 0; j < 4; ++j) s[h2 * 4 + k][j] = q[k][j] + q[k][j + 4]; }
    }
    __builtin_amdgcn_sched_barrier(0);
#pragma unroll
    for (int k = 0; k < 8; ++k) { float t = (s[k][0] + s[k][1]) + (s[k][2] + s[k][3]); t += __shfl_xor(t, 16); t += __shfl_xor(t, 32); r[k] = rsqrtf(t * (1.0f / 1024.0f) + RMS_EPS); }
    __builtin_amdgcn_sched_barrier(0);
}
__device__ __forceinline__ void store8(bf16_t* p, f32x4 a, f32x4 b) {
    u32x4 w; w.x = cvt_pk_bf16(a[0], a[1]); w.y = cvt_pk_bf16(a[2], a[3]); w.z = cvt_pk_bf16(b[0], b[1]); w.w = cvt_pk_bf16(b[2], b[3]);
    *(u32x4*)p = w;
}
__device__ __forceinline__ float sigm(float x) { return __builtin_amdgcn_rcpf(1.0f + __builtin_amdgcn_exp2f(-1.4426950408889634f * x)); }
__device__ __forceinline__ f32x4 sigm4(f32x4 x) { f32x4 r; r[0] = sigm(x[0]); r[1] = sigm(x[1]); r[2] = sigm(x[2]); r[3] = sigm(x[3]); return r; }

struct EpiRes {
    static constexpr bool PERM = true, AFTER_DRAIN = false;
    bf16_t* xb; float* SS; int dry;
    __device__ __forceinline__ void operator()(const f32x4 (&acc)[2][2][4][2], const Unit& u, int wr, int wc, int fr, int fq) const {
        const int col0 = u.pn * BM + wc * 32 + 8 * fq;
#pragma unroll
        for (int ai = 0; ai < 2; ++ai) {
            u32x4 xw[4][2];
#pragma unroll
            for (int m = 0; m < 4; ++m)
#pragma unroll
                for (int bj = 0; bj < 2; ++bj) xw[m][bj] = *(const u32x4*)(xb + (unsigned)(u.pm * BM + ai * HALF + wr * 64 + m * 16 + fr) * 1024 + col0 + bj * HALF);
            __builtin_amdgcn_sched_barrier(0);
#pragma unroll
            for (int m = 0; m < 4; ++m) {
                const int rl = ai * HALF + wr * 64 + m * 16 + fr;
                const unsigned goff = (unsigned)(u.pm * BM + rl) * 1024 + col0;
                float ss = 0.f;
#pragma unroll
                for (int bj = 0; bj < 2; ++bj) {
                    const u32x4 w = xw[m][bj];
                    f32x4 o0, o1;
                    o0[0] = __builtin_bit_cast(float, w.x << 16) + acc[ai][bj][m][0][0]; o0[1] = __builtin_bit_cast(float, w.x & 0xffff0000u) + acc[ai][bj][m][0][1];
                    o0[2] = __builtin_bit_cast(float, w.y << 16) + acc[ai][bj][m][0][2]; o0[3] = __builtin_bit_cast(float, w.y & 0xffff0000u) + acc[ai][bj][m][0][3];
                    o1[0] = __builtin_bit_cast(float, w.z << 16) + acc[ai][bj][m][1][0]; o1[1] = __builtin_bit_cast(float, w.z & 0xffff0000u) + acc[ai][bj][m][1][1];
                    o1[2] = __builtin_bit_cast(float, w.w << 16) + acc[ai][bj][m][1][2]; o1[3] = __builtin_bit_cast(float, w.w & 0xffff0000u) + acc[ai][bj][m][1][3];
                    if (!dry) store8(xb + goff + bj * HALF, o0, o1);
                    ss += (o0[0] * o0[0] + o0[1] * o0[1]) + (o0[2] * o0[2] + o0[3] * o0[3]) + (o1[0] * o1[0] + o1[1] * o1[1]) + (o1[2] * o1[2] + o1[3] * o1[3]);
                }
                ss += __shfl_xor(ss, 16); ss += __shfl_xor(ss, 32);
                if (fq == 0 && !dry) SS[(unsigned)(u.pn * 4 + wc) * MT + u.pm * BM + rl] = ss;
                if (dry) asm volatile("" :: "v"(ss));
            }
        }
    }
};
struct EpiSwiGLU {
    static constexpr bool PERM = true, AFTER_DRAIN = false;
    bf16_t* H; const float* SS;
    __device__ __forceinline__ void operator()(const f32x4 (&acc)[2][2][4][2], const Unit& u, int wr, int wc, int fr, int fq) const {
        const int row0 = u.pm * BM + wr * 64 + fr, col0 = u.pn * 128 + wc * 32 + 8 * fq;
        float r8[8]; rows_rs8(SS, row0, fq, r8);
#pragma unroll
        for (int ai = 0; ai < 2; ++ai)
#pragma unroll
            for (int m = 0; m < 4; ++m) {
                const int row = row0 + ai * HALF + m * 16; const float r = r8[ai * 4 + m];
                const f32x4 g0 = acc[ai][0][m][0] * r, g1 = acc[ai][0][m][1] * r, u0 = acc[ai][1][m][0] * r, u1 = acc[ai][1][m][1] * r;
                store8(H + (unsigned)row * 2816 + col0, g0 * sigm4(g0) * u0, g1 * sigm4(g1) * u1);
            }
    }
};
struct EpiInProj {
    static constexpr bool PERM = true, AFTER_DRAIN = false;
    const float* SS; const float* TAB; bf16_t *UP, *Q, *K, *V, *UC; float *kP, *kS, *vP, *vS;
    __device__ __forceinline__ void operator()(const f32x4 (&acc)[2][2][4][2], const Unit& u, int wr, int wc, int fr, int fq) const {
        const int pn = u.pn; const bool smp = (u.pm >= 64);
        const int row0 = u.pm * BM + wr * 64 + fr, cw = wc * 32 + 8 * fq;
        float r8[8]; rows_rs8(SS, row0, fq, r8);
        if (pn == 0) {
#pragma unroll
            for (int ai = 0; ai < 2; ++ai)
#pragma unroll
                for (int m = 0; m < 4; ++m) { const int row = row0 + ai * HALF + m * 16; const float r = r8[ai * 4 + m];
#pragma unroll
                    for (int bj = 0; bj < 2; ++bj) store8(UP + (unsigned)row * 256 + bj * HALF + cw, acc[ai][bj][m][0] * r, acc[ai][bj][m][1] * r); }
        } else if (pn <= 4) {
            const bool isq = pn <= 2; const int t2 = (pn - 1) & 1, j = 4 * (wc & 1) + fq;
#pragma unroll
            for (int ai = 0; ai < 2; ++ai) {
                f32x4 csv[4], snv[4];
#pragma unroll
                for (int m = 0; m < 4; ++m) { const int row = row0 + ai * HALF + m * 16; const int pos = smp ? 2048 + ((row - MP) & 31) : (row & 2047);
                    csv[m] = *(const f32x4*)(TAB + pos * 64 + 4 * j); snv[m] = *(const f32x4*)(TAB + pos * 64 + 32 + 4 * j); }
                __builtin_amdgcn_sched_barrier(0);
#pragma unroll
                for (int m = 0; m < 4; ++m) { const int row = row0 + ai * HALF + m * 16; const float r = r8[ai * 4 + m];
                    const f32x4 cs = csv[m], sn = snv[m];
#pragma unroll
                    for (int bj = 0; bj < 2; ++bj) { const int grp = t2 * 4 + bj * 2 + (wc >> 1);
                        const f32x4 x1 = acc[ai][bj][m][0] * r, x2 = acc[ai][bj][m][1] * r;
                        const f32x4 o1 = x1 * cs - x2 * sn, o2 = x2 * cs + x1 * sn;
                        const unsigned bo = (unsigned)row * 512 + grp * 64 + 32 * (wc & 1) + 8 * fq;
                        if (isq) store8(Q + bo, o1 * QC2, o2 * QC2);
                        else { store8(K + bo, o1, o2);
                            float* kf = (smp ? kS + (unsigned)(row - MP) * 512 : kP + (unsigned)row * 512) + grp * 64 + 4 * j;
                            *(f32x4*)kf = o1; *(f32x4*)(kf + 32) = o2; } } } }
        } else if (pn <= 6) {
#pragma unroll
            for (int ai = 0; ai < 2; ++ai)
#pragma unroll
                for (int m = 0; m < 4; ++m) { const int row = row0 + ai * HALF + m * 16; const float r = r8[ai * 4 + m];
#pragma unroll
                    for (int bj = 0; bj < 2; ++bj) { const int col = (pn - 5) * 256 + bj * HALF + cw;
                        const f32x4 v0 = acc[ai][bj][m][0] * r, v1 = acc[ai][bj][m][1] * r;
                        store8(V + (unsigned)row * 512 + col, v0, v1);
                        float* vf = (smp ? vS + (unsigned)(row - MP) * 512 : vP + (unsigned)row * 512) + col;
                        *(f32x4*)vf = v0; *(f32x4*)(vf + 4) = v1; } }
        } else {
            const int T = pn - 7;
#pragma unroll
            for (int ai = 0; ai < 2; ++ai)
#pragma unroll
                for (int m = 0; m < 4; ++m) { const int row = row0 + ai * HALF + m * 16; const float r = r8[ai * 4 + m];
                    const f32x4 a0 = acc[ai][0][m][0] * r, a1 = acc[ai][0][m][1] * r, b0 = acc[ai][1][m][0] * r, b1 = acc[ai][1][m][1] * r;
                    store8(UC + (unsigned)row * 256 + T * 128 + cw, a0 * sigm4(b0), a1 * sigm4(b1)); }
        }
    }
};
}
#include <hip/hip_bf16.h>
#include <cmath>
namespace attn_body {
using bf16=__hip_bfloat16;
using bf16x8=__attribute__((ext_vector_type(8)))short;
using s16x4=__attribute__((ext_vector_type(4)))short;
using f32x16=__attribute__((ext_vector_type(16)))float;
using u32x4=__attribute__((ext_vector_type(4)))unsigned;
constexpr int BATCH=8,NHEAD=8,SEQ=2048,D=64,DM=512;
constexpr int NW=8,QBLK=32,QB=QBLK*NW,KVBLK=64,NQB=SEQ/QB;
constexpr int ATTN_PITCH=DM, ATTN_UNIT_ROWS=QB;
__device__ __forceinline__ int crow(int r,int hi){return (r&3)+8*(r>>2)+4*hi;}
#define SBAR() __builtin_amdgcn_sched_barrier(0)
__device__ __forceinline__ void cmask(f32x16&p0,f32x16&p1,int jb,int wid){
  if(jb>(wid>>1)){ const float NEG=-INFINITY;
  #pragma unroll
  for(int r=0;r<16;++r){p0[r]=NEG;p1[r]=NEG;} }
}

constexpr int NSLOT=3, SLOTB=8192;
constexpr int LDS_K=0, LDS_V=NSLOT*SLOTB, LDS_WS=2*NSLOT*SLOTB, LDS_OST=LDS_WS+NW*64*4, LDS_BYTES=LDS_OST+NW*4096;
constexpr float C2=0.125f*1.4426950408889634f;
__device__ __forceinline__ void glds16(const void*gsrc,unsigned lds_dst){unsigned keep;
  asm volatile("s_mov_b32 %0, m0\n\ts_mov_b32 m0, %2\n\ts_nop 0\n\tglobal_load_lds_dwordx4 %1, off\n\ts_mov_b32 m0, %0":"=&s"(keep):"v"(gsrc),"s"(lds_dst):"memory");}
__device__ __forceinline__ float max3f(float a,float b,float c){float r;asm("v_max3_f32 %0, %1, %2, %3":"=v"(r):"v"(a),"v"(b),"v"(c));return r;}
__device__ __forceinline__ float max2f(float a,float b){float r;asm("v_max_f32_e32 %0, %1, %2":"=v"(r):"v"(a),"v"(b));return r;}
__device__ __forceinline__ float fadd_s(float a,float b){float r;asm("v_add_f32_e32 %0, %1, %2":"=v"(r):"v"(a),"v"(b));return r;}
__device__ __forceinline__ float fsub_s(float a,float b){float r;asm("v_sub_f32_e32 %0, %1, %2":"=v"(r):"v"(a),"v"(b));return r;}
typedef float f32x2_t __attribute__((ext_vector_type(2))); typedef __bf16 bf16x2_t __attribute__((ext_vector_type(2)));
__device__ __forceinline__ unsigned cvtpk_s(float lo,float hi){f32x2_t v={lo,hi};bf16x2_t b=__builtin_convertvector(v,bf16x2_t);return __builtin_bit_cast(unsigned,b);}
#define WAIT_BAR(N) asm volatile("s_waitcnt vmcnt(" #N ") lgkmcnt(0)\n\ts_barrier":::"memory")

__device__ __forceinline__ void qkt(f32x16&p0,f32x16&p1,const char*Kslot,const bf16x8*qr,const f32x16&negm,int r32,int hi){
  const char*kb=Kslot+hi*1024+r32*16;
  #pragma unroll
  for(int d0=0;d0<4;++d0){
    const bf16x8 b0=*reinterpret_cast<const bf16x8*>(kb+d0*2048);
    const bf16x8 b1=*reinterpret_cast<const bf16x8*>(kb+d0*2048+512);
    if(d0==0){p0=__builtin_amdgcn_mfma_f32_32x32x16_bf16(b0,qr[0],negm,0,0,0);p1=__builtin_amdgcn_mfma_f32_32x32x16_bf16(b1,qr[0],negm,0,0,0);}
    else{p0=__builtin_amdgcn_mfma_f32_32x32x16_bf16(b0,qr[d0],p0,0,0,0);p1=__builtin_amdgcn_mfma_f32_32x32x16_bf16(b1,qr[d0],p1,0,0,0);}}
}
typedef __attribute__((address_space(3))) const char* lds_cptr;
typedef short v4i16_t __attribute__((ext_vector_type(4)));
__device__ __forceinline__ void kload8(bf16x8*kf,lds_cptr kp){
  kf[0]=*(const __attribute__((address_space(3))) bf16x8*)(kp);      kf[1]=*(const __attribute__((address_space(3))) bf16x8*)(kp+512);
  kf[2]=*(const __attribute__((address_space(3))) bf16x8*)(kp+2048); kf[3]=*(const __attribute__((address_space(3))) bf16x8*)(kp+2560);
  kf[4]=*(const __attribute__((address_space(3))) bf16x8*)(kp+4096); kf[5]=*(const __attribute__((address_space(3))) bf16x8*)(kp+4608);
  kf[6]=*(const __attribute__((address_space(3))) bf16x8*)(kp+6144); kf[7]=*(const __attribute__((address_space(3))) bf16x8*)(kp+6656);
}
__device__ __forceinline__ void kload2(bf16x8*kf,lds_cptr kp,int j){ kf[2*j]=*(const __attribute__((address_space(3))) bf16x8*)(kp+j*2048); kf[2*j+1]=*(const __attribute__((address_space(3))) bf16x8*)(kp+j*2048+512); }
__device__ __forceinline__ s16x4 vtr(lds_cptr p){ return __builtin_bit_cast(s16x4,__builtin_amdgcn_ds_read_tr16_b64_v4i16((__attribute__((address_space(3))) v4i16_t*)p)); }
__device__ __forceinline__ float rowmax(const f32x16&p0,const f32x16&p1){
  float a=max3f(p0[0],p0[1],p1[0]),b=max3f(p0[2],p0[3],p1[1]);a=max3f(a,p1[2],p1[3]);
  #pragma unroll
  for(int r=4;r<16;r+=4){a=max3f(a,p0[r],p0[r+1]);b=max3f(b,p0[r+2],p0[r+3]);a=max3f(a,p1[r],p1[r+1]);b=max3f(b,p1[r+2],p1[r+3]);}
  const float m=max2f(a,b);
  auto rr=__builtin_amdgcn_permlane32_swap(__float_as_uint(m),__float_as_uint(m),false,false);
  return max2f(__uint_as_float(rr[0]),__uint_as_float(rr[1]));
}
__device__ __forceinline__ void pv(f32x16*o,int vb,bf16x8 pa0,bf16x8 pa1,bf16x8 pa2,bf16x8 pa3){
  #pragma unroll
  for(int d0=0;d0<2;++d0){s16x4 lo[4],hi[4];
    #pragma unroll
    for(int ks=0;ks<4;++ks){
      asm volatile("ds_read_b64_tr_b16 %0,%1 offset:%c2":"=&v"(lo[ks]):"v"(vb),"i"(d0*4096+ks*1024):"memory");
      asm volatile("ds_read_b64_tr_b16 %0,%1 offset:%c2":"=&v"(hi[ks]):"v"(vb),"i"(d0*4096+ks*1024+512):"memory");}
    asm volatile("s_waitcnt lgkmcnt(0)":::"memory");SBAR();
    #define PK(k) (bf16x8){lo[k][0],lo[k][1],lo[k][2],lo[k][3],hi[k][0],hi[k][1],hi[k][2],hi[k][3]}
    o[d0]=__builtin_amdgcn_mfma_f32_32x32x16_bf16(pa0,PK(0),o[d0],0,0,0);
    o[d0]=__builtin_amdgcn_mfma_f32_32x32x16_bf16(pa1,PK(1),o[d0],0,0,0);
    o[d0]=__builtin_amdgcn_mfma_f32_32x32x16_bf16(pa2,PK(2),o[d0],0,0,0);
    o[d0]=__builtin_amdgcn_mfma_f32_32x32x16_bf16(pa3,PK(3),o[d0],0,0,0);
    #undef PK
  }
}

#ifndef ATTN_STORE16
#define ATTN_STORE16(p,v) (*(u32x4*)(p)=(v))
#endif
template<int THRL> __device__ __forceinline__ void attn_unit(int b,int h,int hv,int qb,const bf16*Q,const bf16*__restrict__ K,const bf16*__restrict__ V,bf16*O,int ocol,char*shm){
  int tid_l=threadIdx.x; asm volatile("":"+v"(tid_l)); const int tid=tid_l,lane=tid&63,r32=lane&31,hi=lane>>5; const int wid=__builtin_amdgcn_readfirstlane(tid>>6);
  const long rowbase=(long)b*SEQ; const int q0=qb*QB;
  const bf16*Qw=Q+(rowbase+q0+wid*QBLK)*DM+h*D;
  const bf16*Kh=K+rowbase*DM+h*D,*Vh=V+rowbase*DM+hv*D;
  const unsigned lds0=(unsigned)(uintptr_t)shm;
  float*wsf=(float*)(shm+LDS_WS)+wid*64;
  const bf16*ksrc=Kh+(long)lane*DM+wid*8;
  const bf16*vsrc=Vh+(long)(16*(wid&3)+(lane>>2))*DM+(wid>>2)*32+(lane&3)*8;
  const unsigned kdst=lds0+LDS_K+wid*1024, vdst=lds0+LDS_V+wid*1024;
  #define DMA_K(t,slot) glds16(ksrc+(long)(t)*KVBLK*DM,(unsigned)__builtin_amdgcn_readfirstlane(kdst+(slot)))
  #define DMA_V(t,slot) glds16(vsrc+(long)(t)*KVBLK*DM,(unsigned)__builtin_amdgcn_readfirstlane(vdst+(slot)))
  const int vb0=(int)(lds0+LDS_V)+((lane>>4)&1)*32+(lane&3)*8+(4*hi+((lane&15)>>2))*64;
  const char*Kbase=shm+LDS_K; bf16x8 kf[8];
  const lds_cptr shm3=(lds_cptr)shm; const lds_cptr kp0=shm3+LDS_K+hi*1024+r32*16; const lds_cptr vp0=shm3+LDS_V+((lane>>4)&1)*32+(lane&3)*8+(4*hi+((lane&15)>>2))*64;
  const int NT=(q0+QB)/KVBLK;
  DMA_K(0,0);DMA_V(0,0);DMA_K(1,SLOTB);
  bf16x8 qr[4];
  #pragma unroll
  for(int d0=0;d0<4;++d0)qr[d0]=*reinterpret_cast<const bf16x8*>(&Qw[(long)r32*DM+d0*16+hi*8]);
  float mhat=0.f,l_reg=0.f;f32x16 o[2];o[0]=f32x16{};o[1]=f32x16{};f32x16 negm=f32x16{};asm volatile("":"+v"(negm));
  const int qrel=wid*QBLK+r32;
  #define CMASK(P0,P1,t) do{int jb_=(t)-(NT-4); if(jb_>=0)cmask(P0,P1,jb_,wid);}while(0)
  bool resc=false;
  #define START(P0,P1) do{ const float rm=rowmax(P0,P1); resc=false; \
    { const float dl=rm; mhat=fadd_s(mhat,dl); \
      _Pragma("unroll") for(int r=0;r<16;++r){P0[r]=fsub_s(P0[r],dl);P1[r]=fsub_s(P1[r],dl);} \
      _Pragma("unroll") for(int r=0;r<16;++r)negm[r]=-mhat; asm volatile("":"+v"(negm)); } \
    _Pragma("unroll") for(int r=0;r<16;++r)P0[r]=__builtin_amdgcn_exp2f(P0[r]); }while(0)
  #define RESC() do{ if(resc){ asm volatile("s_waitcnt lgkmcnt(0)":::"memory"); \
      _Pragma("unroll") for(int d_=0;d_<2;++d_) _Pragma("unroll") for(int r=0;r<16;++r)o[d_][r]*=wsf[crow(r,hi)]; } }while(0)
  f32x16 pA0,pA1,pB0,pB1;
  int sl_prev=0,sl_cur=0,sl_next=SLOTB;
  #define ROT() do{sl_prev=sl_cur;sl_cur=sl_next;sl_next=(sl_next==(NSLOT-1)*SLOTB)?0:sl_next+SLOTB;}while(0)
  DMA_K(2,2*SLOTB);
  WAIT_BAR(3);
  qkt(pA0,pA1,Kbase,qr,negm,r32,hi);asm volatile("s_nop 15\n\ts_nop 7":"+v"(pA0),"+v"(pA1));CMASK(pA0,pA1,0);
  START(pA0,pA1);
  _Pragma("unroll") for(int r=0;r<16;++r)pA1[r]=__builtin_amdgcn_exp2f(pA1[r]);
  WAIT_BAR(0);
  DMA_K(3,0);DMA_V(1,SLOTB);
  ROT();
  kload8(kf,kp0+sl_cur);
  WAIT_BAR(2);
  s16x4 vlo[8],vhi[8]; u32x4 pw0,pw1,pw2,pw3;
  #define PKW(P,B) cvtpk_s(P[B],P[B+1])
  #define PAF(k) __builtin_bit_cast(bf16x8,pw##k)
  #define VFR(i) (bf16x8){vlo[i][0],vlo[i][1],vlo[i][2],vlo[i][3],vhi[i][0],vhi[i][1],vhi[i][2],vhi[i][3]}
  #define PIN(x) asm volatile("":"+v"(x))
  #define MX3(a,b,c) __builtin_fmaxf(__builtin_fmaxf((a),(b)),(c))
  #define GAPA(MF,A0,A1,A2,A3,W0,W1,PW) do{ MF; sacc+=A0; sacc+=A1; sacc+=A2; sacc+=A3; PIN(sacc); W0; W1; PIN(PW); SBAR(); }while(0)
  #define EX(v) __builtin_amdgcn_exp2f(v)
  #define GAPB(MF,X,B) do{ MF; X[B]=EX(X[B]); X[B+1]=EX(X[B+1]); X[B+2]=EX(X[B+2]); X[B+3]=EX(X[B+3]); PIN(X); SBAR(); }while(0)
  #define VRD(i) do{ vlo[i]=vtr(vp_+(((i)>>2)*4096+((i)&3)*1024)); vhi[i]=vtr(vp_+(((i)>>2)*4096+((i)&3)*1024+512)); }while(0)
  #define KRD(G,j) do{ if(G){ kload2(kf,kp0+sl_next,j); SBAR(); } }while(0)
  #define STEP(C0,C1,P0,P1,t,GK,GV,GL) do{ SBAR(); \
    const lds_cptr vp_=vp0+sl_prev; \
    VRD(0); SBAR(); float sacc=(P0[0]+P0[1]); \
    GAPA(C0=__builtin_amdgcn_mfma_f32_32x32x16_bf16(kf[0],qr[0],negm,0,0,0), P0[2],P0[3],P0[4],P0[5],     pw0[0]=PKW(P0,0), pw0[1]=PKW(P0,2), pw0); \
    VRD(4); SBAR(); GAPA(C1=__builtin_amdgcn_mfma_f32_32x32x16_bf16(kf[1],qr[0],negm,0,0,0), P0[6],P0[7],P0[8],P0[9],     pw0[2]=PKW(P0,4), pw0[3]=PKW(P0,6), pw0); \
    VRD(1); SBAR(); GAPA(C0=__builtin_amdgcn_mfma_f32_32x32x16_bf16(kf[2],qr[1],C0,0,0,0),   P0[10],P0[11],P0[12],P0[13], pw1[0]=PKW(P0,8), pw1[1]=PKW(P0,10), pw1); \
    VRD(5); SBAR(); GAPA(C1=__builtin_amdgcn_mfma_f32_32x32x16_bf16(kf[3],qr[1],C1,0,0,0),   P0[14],P0[15],P1[0],P1[1],   pw1[2]=PKW(P0,12),pw1[3]=PKW(P0,14), pw1); \
    VRD(2); SBAR(); GAPA(C0=__builtin_amdgcn_mfma_f32_32x32x16_bf16(kf[4],qr[2],C0,0,0,0),   P1[2],P1[3],P1[4],P1[5],     pw2[0]=PKW(P1,0), pw2[1]=PKW(P1,2), pw2); \
    VRD(6); SBAR(); GAPA(C1=__builtin_amdgcn_mfma_f32_32x32x16_bf16(kf[5],qr[2],C1,0,0,0),   P1[6],P1[7],P1[8],P1[9],     pw2[2]=PKW(P1,4), pw2[3]=PKW(P1,6), pw2); \
    VRD(3); SBAR(); GAPA(C0=__builtin_amdgcn_mfma_f32_32x32x16_bf16(kf[6],qr[3],C0,0,0,0),   P1[10],P1[11],P1[12],P1[13], pw3[0]=PKW(P1,8), pw3[1]=PKW(P1,10), pw3); \
    VRD(7); SBAR(); GAPA(C1=__builtin_amdgcn_mfma_f32_32x32x16_bf16(kf[7],qr[3],C1,0,0,0),   P1[14],P1[15],0.f,0.f,       pw3[2]=PKW(P1,12),pw3[3]=PKW(P1,14), pw3); \
    l_reg+=sacc; \
    if(GK){DMA_K((t)+3,sl_cur);} if(GV){DMA_V((t)+1,sl_next);} \
    CMASK(C0,C1,t); \
    { float a=MX3(C0[0],C0[1],C1[0]),b=MX3(C0[2],C0[3],C1[1]); a=MX3(a,C1[2],C1[3]); \
      _Pragma("unroll") for(int r=4;r<16;r+=4){a=MX3(a,C0[r],C0[r+1]);b=MX3(b,C0[r+2],C0[r+3]);a=MX3(a,C1[r],C1[r+1]);b=MX3(b,C1[r+2],C1[r+3]);} \
      float rm=__builtin_fmaxf(a,b); { auto rr=__builtin_amdgcn_permlane32_swap(__float_as_uint(rm),__float_as_uint(rm),false,false); rm=__builtin_fmaxf(__uint_as_float(rr[0]),__uint_as_float(rr[1])); } \
      resc=false; \
      if(__builtin_expect(__any(rm>(float)THRL),0)){ const float dl=__builtin_fmaxf(rm,0.f); mhat+=dl; \
        _Pragma("unroll") for(int r=0;r<16;++r){C0[r]-=dl;C1[r]-=dl;} \
        _Pragma("unroll") for(int r=0;r<16;++r)negm[r]=-mhat; asm volatile("":"+v"(negm)); \
        const float f=__builtin_amdgcn_exp2f(-dl); l_reg*=f; if(hi==0)wsf[r32]=f; resc=true; } } \
    SBAR(); \
    GAPB(o[0]=__builtin_amdgcn_mfma_f32_32x32x16_bf16(PAF(0),VFR(0),o[0],0,0,0), C0,0); \
    GAPB(o[1]=__builtin_amdgcn_mfma_f32_32x32x16_bf16(PAF(0),VFR(4),o[1],0,0,0), C0,4); \
    KRD(GL,0); GAPB(o[0]=__builtin_amdgcn_mfma_f32_32x32x16_bf16(PAF(1),VFR(1),o[0],0,0,0), C0,8); \
    KRD(GL,1); GAPB(o[1]=__builtin_amdgcn_mfma_f32_32x32x16_bf16(PAF(1),VFR(5),o[1],0,0,0), C0,12); \
    KRD(GL,2); GAPB(o[0]=__builtin_amdgcn_mfma_f32_32x32x16_bf16(PAF(2),VFR(2),o[0],0,0,0), C1,0); \
    KRD(GL,3); GAPB(o[1]=__builtin_amdgcn_mfma_f32_32x32x16_bf16(PAF(2),VFR(6),o[1],0,0,0), C1,4); \
    GAPB(o[0]=__builtin_amdgcn_mfma_f32_32x32x16_bf16(PAF(3),VFR(3),o[0],0,0,0), C1,8); \
    GAPB(o[1]=__builtin_amdgcn_mfma_f32_32x32x16_bf16(PAF(3),VFR(7),o[1],0,0,0), C1,12); \
    }while(0)
  int t=1;
  #undef CMASK
  #define CMASK(P0,P1,t) do{}while(0)
  for(;t+5<NT;t+=2){
    STEP(pB0,pB1,pA0,pA1,t,true,true,true);     WAIT_BAR(2); RESC(); ROT();
    STEP(pA0,pA1,pB0,pB1,t+1,true,true,true);   WAIT_BAR(2); RESC(); ROT();
  }
  #undef CMASK
  #define CMASK(P0,P1,t) do{int jb_=(t)-(NT-4); if(jb_>=0)cmask(P0,P1,jb_,wid);}while(0)
  #define ENDW(tt) do{ if((tt)+3<NT){WAIT_BAR(2);} else if((tt)+2<NT){WAIT_BAR(1);} else {WAIT_BAR(0);} }while(0)
  for(;t+1<NT;t+=2){
    STEP(pB0,pB1,pA0,pA1,t,(t+3<NT),(t+1<NT),(t+1<NT));       ENDW(t);   RESC(); ROT();
    STEP(pA0,pA1,pB0,pB1,t+1,(t+4<NT),(t+2<NT),(t+2<NT));     ENDW(t+1); RESC(); ROT();
  }
  STEP(pB0,pB1,pA0,pA1,NT-1,false,false,false); RESC();
  { float sacc=pB0[0]+pB0[1]; _Pragma("unroll") for(int r=2;r<16;++r)sacc+=pB0[r]; _Pragma("unroll") for(int r=0;r<16;++r)sacc+=pB1[r]; l_reg+=sacc;
    pw0=(u32x4){PKW(pB0,0),PKW(pB0,2),PKW(pB0,4),PKW(pB0,6)};pw1=(u32x4){PKW(pB0,8),PKW(pB0,10),PKW(pB0,12),PKW(pB0,14)};pw2=(u32x4){PKW(pB1,0),PKW(pB1,2),PKW(pB1,4),PKW(pB1,6)};pw3=(u32x4){PKW(pB1,8),PKW(pB1,10),PKW(pB1,12),PKW(pB1,14)};
    SBAR(); pv(o,vb0+sl_cur,PAF(0),PAF(1),PAF(2),PAF(3)); }
  #undef PKW
  #undef PAF
  #undef VFR
  #undef PIN
  #undef MX3
  #undef GAPA
  #undef GAPB
  #undef EX
  #undef VRD
  #undef KRD
  #undef STEP
  #undef ENDW
  {auto rr=__builtin_amdgcn_permlane32_swap(__float_as_uint(l_reg),__float_as_uint(l_reg),false,false);l_reg=__uint_as_float(rr[0])+__uint_as_float(rr[1]);}
  if(hi==0)wsf[32+r32]=l_reg;asm volatile("s_waitcnt lgkmcnt(0)":::"memory");
  float rli[16];
  #pragma unroll
  for(int r=0;r<16;++r)rli[r]=__builtin_amdgcn_rcpf(wsf[32+crow(r,hi)]);
  bf16*Ow=O+(rowbase+q0+wid*QBLK)*1024+ocol;
  { bf16*stg=(bf16*)(shm+LDS_OST)+wid*2048;
    #pragma unroll
    for(int r=0;r<16;++r){const int orow=crow(r,hi);
      #pragma unroll
      for(int d0=0;d0<2;++d0)stg[orow*64+d0*32+r32]=__float2bfloat16(o[d0][r]*rli[r]);}
    asm volatile("s_waitcnt lgkmcnt(0)":::"memory");
    #pragma unroll
    for(int i=0;i<4;++i){const int row=i*8+(lane>>3),ch=lane&7; const u32x4 v=*(const u32x4*)(stg+row*64+ch*8); ATTN_STORE16(Ow+(long)row*1024+ch*8,v);} }
  asm volatile("s_waitcnt lgkmcnt(0)\n\ts_barrier":::"memory");
  #undef DMA_K
  #undef DMA_V
  #undef CMASK
  #undef START
  #undef RESC
  #undef ROT
}
constexpr int ATTN_LDS_BYTES=LDS_BYTES;
#undef SBAR
#undef WAIT_BAR
}
#ifndef MK_MULTI
#define MK_MULTI 0
#endif
#ifndef REP_SYNC
#define REP_SYNC 0
#endif
#ifndef REP_FOLD
#define REP_FOLD 1
#endif
#ifndef REP_SLACK
#define REP_SLACK 1
#endif
#ifndef SLACK_W
#define SLACK_W 1
#endif
constexpr int NWAVES = 8, NPH = 14;
constexpr int MT = pg8::MT, MP = pg8::MP, DM_ = 1024, INW = 2304, DFF = 2816;
constexpr size_t MiB = 1u << 20;
constexpr size_t WS_TAB = 1 * MiB;
constexpr size_t WS_LAM = 2 * MiB;
constexpr size_t WS_SS = 3 * MiB;
constexpr size_t WS_WIN = 5 * MiB, WS_WOUT = 14 * MiB, WS_WGU = 18 * MiB, WS_WDN = 40 * MiB;
constexpr size_t WS_XB = 52 * MiB;
constexpr size_t WS_SPO = 86 * MiB;
constexpr size_t WS_SPM = 95 * MiB;
constexpr size_t WS_Q = 96 * MiB, WS_K = 113 * MiB, WS_V = 130 * MiB, WS_UP = 147 * MiB, WS_UC = 156 * MiB, WS_O4 = 165 * MiB, WS_MIX = 197 * MiB;
constexpr size_t WS_H = 96 * MiB;
constexpr size_t WS_END = 230 * MiB;
static_assert(WS_H + (size_t)MT * DFF * 2 <= WS_MIX && WS_MIX + (size_t)MT * 1024 * 2 <= WS_END, "ws map");
constexpr size_t O_Y = 0, O_KP = 17039360, O_VP = 33816576, O_PP = 50593792, O_CP = 50655232, O_KS = 50778112, O_VS = 51040256, O_PS = 51302400, O_CS = 51363840, O_END = 51486720;
constexpr int LDS_BYTES = 147456;

#define LAS __attribute__((address_space(3)))
typedef unsigned short bf16;
typedef unsigned v4u __attribute__((ext_vector_type(4)));
typedef unsigned v2u __attribute__((ext_vector_type(2)));
typedef float f32x4 __attribute__((ext_vector_type(4)));
typedef float f32x16 __attribute__((ext_vector_type(16)));
typedef short bf16x8 __attribute__((ext_vector_type(8)));
__device__ __forceinline__ unsigned f2bf(float f) { unsigned u = __builtin_bit_cast(unsigned, f); return (u + 0x7fffu + ((u >> 16) & 1u)) >> 16; }
__device__ __forceinline__ unsigned pk2(float lo, float hi) { return f2bf(lo) | (f2bf(hi) << 16); }
__device__ __forceinline__ float bflo(unsigned w) { return __builtin_bit_cast(float, w << 16); }
__device__ __forceinline__ float bfhi(unsigned w) { return __builtin_bit_cast(float, w & 0xffff0000u); }
__device__ __forceinline__ float wave_sum(float v) {
#pragma unroll
    for (int o = 1; o < 64; o <<= 1) v += __shfl_xor(v, o);
    return v;
}
struct Args { const float* in[22]; float* out; unsigned char* ws; int ph_lo, ph_hi; };
struct Frame { int tid, lane, wave, vcu, G, gw, NGW; };

#define XB_TMO      128
#define XB_XCNT(j)  (256  + 64 * (j))
#define XB_XSUB(j)  (1280 + 64 * (j))
#define XB_XGEN(j)  (2304 + 64 * (j))
#define XB_TOP      3328
#define XB_TOPGEN   3392
#define XCD_BAR_WORDS 3456
#define XB_SPIN_CAP (1u << 18)

__device__ __forceinline__ unsigned xb_ld(unsigned* p)              { return __hip_atomic_load(p, __ATOMIC_RELAXED, __HIP_MEMORY_SCOPE_AGENT); }
__device__ __forceinline__ unsigned xb_add(unsigned* p, unsigned v) { return __hip_atomic_fetch_add(p, v, __ATOMIC_RELAXED, __HIP_MEMORY_SCOPE_AGENT); }
__device__ __forceinline__ unsigned xb_xcc_id() { return (unsigned)__builtin_amdgcn_s_getreg((3 << 11) | 20) & 0xFu; }
#define XB_SPIN(cond, bar) do { unsigned _sp = 0; while (cond) { __builtin_amdgcn_s_sleep(1); \
    if ((++_sp & 255u) == 0u) { if (xb_ld(&(bar)[XB_TMO])) break; if (_sp > XB_SPIN_CAP) { atomicAdd(&(bar)[XB_TMO], 1u); break; } } } } while (0)

struct XcdBarrier {
    unsigned* bar; unsigned x;
    volatile LAS unsigned* st;
};

__device__ __forceinline__ XcdBarrier xcd_barrier_post(unsigned* bar, volatile LAS unsigned* st) {
    XcdBarrier b; b.bar = bar; b.x = xb_xcc_id(); b.st = st;
    if (threadIdx.x == 0) (void)xb_add(&bar[XB_XCNT(b.x)], 1u);
    return b;
}
__device__ __forceinline__ void xcd_barrier_complete(unsigned* bar, unsigned x, unsigned& nloc, unsigned& nx) {
    const unsigned G = gridDim.x * gridDim.y * gridDim.z;
    unsigned sum, cnt, mine, sp = 0u;
    for (;;) {
        sum = 0u; cnt = 0u; mine = 0u;
#pragma unroll
        for (unsigned j = 0; j < 16; ++j) { const unsigned c = xb_ld(&bar[XB_XCNT(j)]); sum += c; cnt += (c > 0u) ? 1u : 0u; mine = (j == x) ? c : mine; }
        if (sum == G) break;
        __builtin_amdgcn_s_sleep(1);
        if ((++sp & 255u) == 0u) { if (xb_ld(&bar[XB_TMO])) break; if (sp > XB_SPIN_CAP) { atomicAdd(&bar[XB_TMO], 1u); break; } }
    }
    nloc = mine > 0u ? mine : 1u; nx = cnt > 0u ? cnt : 1u;
}

__device__ __forceinline__ void xcd_barrier(const XcdBarrier& b) {
    asm volatile("s_waitcnt vmcnt(0)" ::: "memory");
    __syncthreads();
    if (threadIdx.x == 0) {
        unsigned* bar = b.bar;
        __builtin_amdgcn_s_waitcnt(0);
        unsigned nloc = b.st[0], nx = b.st[1];
        if (nloc == 0u) { xcd_barrier_complete(bar, b.x, nloc, nx); b.st[0] = nloc; b.st[1] = nx; }
        const unsigned old = xb_add(&bar[XB_XSUB(b.x)], 1u);
        const unsigned gen = old / nloc;
        if (old + 1u == (gen + 1u) * nloc) {
            __builtin_amdgcn_fence(__ATOMIC_RELEASE, "agent");
            asm volatile("s_waitcnt vmcnt(0)" ::: "memory");
            const unsigned og = xb_add(&bar[XB_TOP], 1u);
            const unsigned tg = og / nx;
            if (og + 1u == (tg + 1u) * nx) xb_add(&bar[XB_TOPGEN], 1u);
            else XB_SPIN(xb_ld(&bar[XB_TOPGEN]) == tg, bar);
            __builtin_amdgcn_fence(__ATOMIC_ACQUIRE, "agent");
            xb_add(&bar[XB_XGEN(b.x)], 1u);
            asm volatile("s_waitcnt vmcnt(0)" ::: "memory");
        } else {
            XB_SPIN(xb_ld(&bar[XB_XGEN(b.x)]) == gen, bar);
            __builtin_amdgcn_fence(__ATOMIC_ACQUIRE, "agent");
            asm volatile("s_waitcnt vmcnt(0)" ::: "memory");
        }
    }
    __syncthreads();
}

constexpr int MISC_OFF = 147200;
__device__ __forceinline__ int perm_in(int n) {
    if (n < 256) return n;
    if (n < 1280) { const int p = n & 63, j = p >> 3, nn = (p >> 2) & 1, i = p & 3; return (n & ~63) + 32 * nn + 4 * j + i; }
    if (n < 1792) return n;
    const int x = n - 1792, T = x >> 8, bj = (x >> 7) & 1, cc = x & 127; return 1792 + 256 * bj + 128 * T + cc;
}
__device__ __forceinline__ int perm_gu(int n) { const int T = n >> 8, bj = (n >> 7) & 1, cc = n & 127; return 2816 * bj + 128 * T + cc; }
template <int MODE> __device__ __forceinline__ void transpose_item(const float* W, int ldw, const float* gk, bf16* WT, int ldwt, int koff, int nblk, LAS float* scr, int item, int lane) {
    (void)scr;
    const int kb = item / nblk, nb = item % nblk, k0 = 64 * kb, np = 64 * nb + lane;
    const int src = (MODE == 1) ? perm_in(np) : (MODE == 2) ? perm_gu(np) : np;
    const float* wp = W + (size_t)k0 * ldw + src;
    float v[64];
#pragma unroll
    for (int t = 0; t < 64; ++t) v[t] = wp[(size_t)t * ldw];
    __builtin_amdgcn_sched_barrier(0);
    bf16* op = WT + (size_t)np * ldwt + koff + k0;
#pragma unroll
    for (int kc = 0; kc < 8; ++kc) {
        float g[8];
#pragma unroll
        for (int t = 0; t < 8; ++t) g[t] = gk ? gk[k0 + 8 * kc + t] : 1.0f;
        v4u o; o.x = pg8::cvt_pk_bf16(v[8 * kc] * g[0], v[8 * kc + 1] * g[1]); o.y = pg8::cvt_pk_bf16(v[8 * kc + 2] * g[2], v[8 * kc + 3] * g[3]);
        o.z = pg8::cvt_pk_bf16(v[8 * kc + 4] * g[4], v[8 * kc + 5] * g[5]); o.w = pg8::cvt_pk_bf16(v[8 * kc + 6] * g[6], v[8 * kc + 7] * g[7]);
        *(v4u*)(op + 8 * kc) = o; }
}
__device__ __forceinline__ void fold_item(const float* pool_w, const float* pool_scale, const float* conv_pw, const float* w_out, bf16* WT, LAS float* scr, int item, int lane) {
    const int kb = item >> 4, nb = item & 15, n = nb * 64 + lane;
    float acc[8];
#pragma unroll
    for (int i = 0; i < 8; ++i) acc[i] = 0.f;
    int k0, D, rb;
    if (kb < 32) { k0 = kb * 8; D = 64; const int g = k0 >> 6; rb = 64 * g; const float ps = pool_scale[64 * g + lane];
        float pw[8];
#pragma unroll
        for (int i = 0; i < 8; ++i) pw[i] = pool_w[(size_t)(g * 64 + ((k0 + i) & 63)) * 64 + lane];
        __builtin_amdgcn_sched_barrier(0);
#pragma unroll
        for (int i = 0; i < 8; ++i) scr[i * 64 + lane] = pw[i] * ps;
    } else { k0 = 768 + (kb - 32) * 8; D = 256; rb = 768;
        f32x4 cw[8];
#pragma unroll
        for (int i = 0; i < 8; ++i) cw[i] = *(const f32x4*)(conv_pw + (size_t)(k0 - 768 + i) * 256 + 4 * lane);
        __builtin_amdgcn_sched_barrier(0);
#pragma unroll
        for (int i = 0; i < 8; ++i) *(LAS f32x4*)(scr + i * 256 + 4 * lane) = cw[i];
    }
    asm volatile("s_waitcnt lgkmcnt(0)" ::: "memory");
    const float* wp = w_out + (size_t)rb * 1024 + n;
#pragma unroll 1
    for (int d = 0; d < D; d += 32) {
        float wv[32];
#pragma unroll
        for (int q = 0; q < 32; ++q) wv[q] = wp[(size_t)(d + q) * 1024];
        __builtin_amdgcn_sched_barrier(0);
#pragma unroll
        for (int q = 0; q < 32; q += 4)
#pragma unroll
            for (int i = 0; i < 8; ++i) { const f32x4 cf = *(const LAS f32x4*)(scr + i * D + d + q); acc[i] += (cf.x * wv[q] + cf.y * wv[q + 1]) + (cf.z * wv[q + 2] + cf.w * wv[q + 3]); }
        __builtin_amdgcn_sched_barrier(0);
    }
    asm volatile("s_waitcnt lgkmcnt(0)" ::: "memory");
    v4u o; o.x = pk2(acc[0], acc[1]); o.y = pk2(acc[2], acc[3]); o.z = pk2(acc[4], acc[5]); o.w = pk2(acc[6], acc[7]);
    *(v4u*)(WT + (size_t)n * 1024 + k0) = o;
}
constexpr int WI_A = 576, WI_B = 3840, WI_C = 5568, WI_END = 7680;
__device__ __forceinline__ void wi_in(const Args& A, LAS float* scr, int lane, int l, int it) { transpose_item<1>(A.in[7] + (size_t)l * 1024 * INW, INW, A.in[6] + l * 1024, (bf16*)(A.ws + WS_WIN) + (size_t)l * INW * 1024, 1024, 0, INW / 64, scr, it, lane); }
__device__ __forceinline__ void wi_gu(const Args& A, LAS float* scr, int lane, int l, int it) { transpose_item<2>(A.in[19] + (size_t)l * 1024 * 2 * DFF, 2 * DFF, A.in[18] + l * 1024, (bf16*)(A.ws + WS_WGU) + (size_t)l * 2 * DFF * 1024, 1024, 0, 2 * DFF / 64, scr, it, lane); }
__device__ __forceinline__ void wi_dn(const Args& A, LAS float* scr, int lane, int l, int it) { transpose_item<0>(A.in[20] + (size_t)l * DFF * 1024, 1024, nullptr, (bf16*)(A.ws + WS_WDN) + (size_t)l * 1024 * DFF, DFF, 0, 1024 / 64, scr, it, lane); }
__device__ __forceinline__ void wi_mid(const Args& A, LAS float* scr, int lane, int l, int it) { transpose_item<0>(A.in[17] + (size_t)l * 1024 * 1024 + 256 * 1024, 1024, nullptr, (bf16*)(A.ws + WS_WOUT) + (size_t)l * 1024 * 1024, 1024, 256, 1024 / 64, scr, it, lane); }
__device__ __forceinline__ void wi_fold(const Args& A, LAS float* scr, int lane, int l, int it) { fold_item(A.in[8] + (size_t)l * 4 * 64 * 64, A.in[9] + l * 256, A.in[16] + (size_t)l * 256 * 256, A.in[17] + (size_t)l * 1024 * 1024, (bf16*)(A.ws + WS_WOUT) + (size_t)l * 1024 * 1024, scr, it, lane); }
__device__ __forceinline__ void weight_items(const Args& A, LAS float* scr, int lane, int first, int last, int w0, int nw) {
#pragma unroll 1
    for (int idx = first + w0; idx < last; idx += nw) {
        if (idx < WI_A) wi_in(A, scr, lane, 0, idx);
        else if (idx < WI_B) { const int a = idx - WI_A; if (a < 1408) wi_gu(A, scr, lane, 0, a); else if (a < 2112) wi_dn(A, scr, lane, 0, a - 1408); else if (a < 2240) wi_mid(A, scr, lane, 0, a - 2112); else wi_fold(A, scr, lane, 0, a - 2240); }
        else if (idx < WI_C) { const int b2 = idx - WI_B; if (b2 < 576) wi_in(A, scr, lane, 1, b2); else if (b2 < 704) wi_mid(A, scr, lane, 1, b2 - 576); else wi_fold(A, scr, lane, 1, b2 - 704); }
        else { const int c2 = idx - WI_C; if (c2 < 1408) wi_gu(A, scr, lane, 1, c2); else wi_dn(A, scr, lane, 1, c2 - 1408); }
    }
}
__device__ __forceinline__ void slack_weights(const Frame& F, const Args& A, LAS unsigned char* lds, int nwg, int first, int last) {
    const int rounds = (nwg + F.G - 1) / F.G, nfull = nwg - (rounds - 1) * F.G, c = (int)blockIdx.x;
    int sl = F.lane; asm volatile("" : "+v"(sl));
    LAS float* scr = (LAS float*)(lds + F.wave * 16640);
    if (nfull >= F.G) weight_items(A, scr, sl, first, last, F.gw, F.NGW);
    else if (c >= nfull) weight_items(A, scr, sl, first, last, (c - nfull) * NWAVES + F.wave, (F.G - nfull) * NWAVES);
    __syncthreads();
}
__device__ __forceinline__ void p0_prologue(const Frame& F, const Args& A, LAS unsigned char* lds) {
    unsigned char* ws = A.ws;
    LAS float* scr = (LAS float*)(lds + F.wave * 16640);
    int lane_l = F.lane; asm volatile("" : "+v"(lane_l)); const int gw = F.gw, NGW = F.NGW, lane = lane_l;
    weight_items(A, scr, lane, 0, SLACK_W ? WI_A : WI_END, gw, NGW);
    { bf16* XB = (bf16*)(ws + WS_XB); float* SS = (float*)(ws + WS_SS);
      for (int m0 = gw * 2; m0 < MT; m0 += NGW * 2) {
        f32x4 v[2][4];
#pragma unroll
        for (int q = 0; q < 2; ++q) { const int m = m0 + q; const float* xr = (m < MP) ? A.in[0] + (size_t)m * 1024 : A.in[1] + (size_t)(m - MP) * 1024;
#pragma unroll
            for (int j = 0; j < 4; ++j) v[q][j] = *((const f32x4*)xr + lane + 64 * j); }
        __builtin_amdgcn_sched_barrier(0);
#pragma unroll
        for (int q = 0; q < 2; ++q) { const int m = m0 + q; float s = 0.f;
#pragma unroll
            for (int j = 0; j < 4; ++j) { const f32x4 w = v[q][j]; s += (w.x * w.x + w.y * w.y) + (w.z * w.z + w.w * w.w);
                v2u o; o.x = pk2(w.x, w.y); o.y = pk2(w.z, w.w); *((v2u*)(XB + (size_t)m * 1024) + lane + 64 * j) = o; }
            s = wave_sum(s);
            if (lane < 16) SS[(size_t)lane * MT + m] = (lane == 0) ? s : 0.f;
            if (m >= MP && lane < 32) SS[(size_t)16 * MT + lane * 256 + (m - MP)] = (lane == 0) ? s : 0.f; }
      } }
    { float* TAB = (float*)(ws + WS_TAB);
      for (int i = gw * 64 + lane; i < 2080 * 32; i += NGW * 64) { const int pos = i >> 5, f = i & 31;
        const float inv = powf(10000.0f, -(float)f / 32.0f); const float ang = (float)pos * inv; float sv, cv; sincosf(ang, &sv, &cv);
        TAB[pos * 64 + f] = cv; TAB[pos * 64 + 32 + f] = sv; } }
    if (gw < 2) { const float* lq = A.in[10] + gw * 256; const float a = wave_sum(lq[lane] * lq[64 + lane]), b = wave_sum(lq[128 + lane] * lq[192 + lane]);
        const float lam_init = 0.8f - 0.6f * expf(-0.3f * (float)gw);
        if (lane == 0) ((float*)(ws + WS_LAM))[gw] = expf(a) - expf(b) + lam_init; }
}

__device__ __forceinline__ int crow(int r, int hi) { return (r & 3) + 8 * (r >> 2) + 4 * hi; }
__device__ __forceinline__ void sample_attn_unit(const Frame& F, const Args& A, int l, int bh, int split, LAS unsigned char* lds) {
    int lane_l = F.lane; asm volatile("" : "+v"(lane_l)); const int b = bh >> 2, h = bh & 3, lane = lane_l, wid = F.wave, r32 = lane & 31, hi = lane >> 5;
    LAS unsigned short* PL = (LAS unsigned short*)lds;
    LAS float* OX = (LAS float*)(lds + 20480);
    LAS float* MB = (LAS float*)(lds + 40960);
    LAS float* LB = MB + 256;
    const bool last = (split == 7), two = last && (wid == 7);
    const int eb = wid & 3, kh = wid >> 2, nks = (last && kh == 1) ? 10 : 8;
    const size_t cro = ((size_t)(l * 8 + b) * 2048 + split * 256) * 512 + h * 128, nro = ((size_t)(l * 8 + b) * 32) * 512 + h * 128;
    const float* Kc = A.in[2] + cro; const float* Vc = A.in[3] + cro;
    const float* Kn = A.out + O_KS + nro; const float* Vn = A.out + O_VS + nro;
    const bf16* Qrow = (const bf16*)(A.ws + WS_Q) + (size_t)(MP + b * 32 + r32) * 512 + h * 128;
    bf16x8 vfr[10];
    { float t[10][8];
#pragma unroll
      for (int ks = 0; ks < 10; ++ks)
#pragma unroll
        for (int j = 0; j < 8; ++j) { const float* vp = (ks < 8) ? Vc + (size_t)(128 * kh + 16 * ks + 8 * hi + j) * 512 : Vn + (size_t)(16 * (ks - 8) + 8 * hi + j) * 512;
            t[ks][j] = (ks < nks) ? vp[32 * eb + r32] : 0.f; }
      __builtin_amdgcn_sched_barrier(0);
#pragma unroll
      for (int ks = 0; ks < 10; ++ks) { v4u w; w.x = pk2(t[ks][0], t[ks][1]); w.y = pk2(t[ks][2], t[ks][3]); w.z = pk2(t[ks][4], t[ks][5]); w.w = pk2(t[ks][6], t[ks][7]); vfr[ks] = __builtin_bit_cast(bf16x8, w); }
      __builtin_amdgcn_sched_barrier(0); }
    float* SPO = (float*)(A.ws + WS_SPO); float* SPM = (float*)(A.ws + WS_SPM);
    for (int c = 0; c < 2; ++c) {
        f32x16 s[2]; s[0] = f32x16{}; s[1] = f32x16{};
        bf16x8 qf[4];
        { v2u q0[4], q1[4]; f32x4 ka[2][4], kb[2][4];
#pragma unroll
          for (int d0 = 0; d0 < 4; ++d0) { const bf16* qp = Qrow + c * 64 + 32 * (d0 & 1) + 16 * hi + 4 * (d0 >> 1); q0[d0] = *(const v2u*)qp; q1[d0] = *(const v2u*)(qp + 8);
              const float* kp = Kc + (size_t)(32 * wid + r32) * 512 + c * 64 + 16 * d0 + 8 * hi; ka[0][d0] = *(const f32x4*)kp; kb[0][d0] = *(const f32x4*)(kp + 4);
              const float* kn = Kn + (size_t)r32 * 512 + c * 64 + 16 * d0 + 8 * hi;
              ka[1][d0] = two ? *(const f32x4*)kn : (f32x4){0.f, 0.f, 0.f, 0.f}; kb[1][d0] = two ? *(const f32x4*)(kn + 4) : (f32x4){0.f, 0.f, 0.f, 0.f}; }
          __builtin_amdgcn_sched_barrier(0);
#pragma unroll
          for (int d0 = 0; d0 < 4; ++d0) { v4u qw; qw.x = q0[d0].x; qw.y = q0[d0].y; qw.z = q1[d0].x; qw.w = q1[d0].y; qf[d0] = __builtin_bit_cast(bf16x8, qw); }
#pragma unroll
          for (int ch = 0; ch < 2; ++ch) if (ch == 0 || two) {
#pragma unroll
              for (int d0 = 0; d0 < 4; ++d0) { v4u kw; kw.x = pk2(ka[ch][d0].x, ka[ch][d0].y); kw.y = pk2(ka[ch][d0].z, ka[ch][d0].w); kw.z = pk2(kb[ch][d0].x, kb[ch][d0].y); kw.w = pk2(kb[ch][d0].z, kb[ch][d0].w);
                  s[ch] = __builtin_amdgcn_mfma_f32_32x32x16_bf16(__builtin_bit_cast(bf16x8, kw), qf[d0], s[ch], 0, 0, 0); } } }
        float m = s[0][0];
#pragma unroll
        for (int r = 1; r < 16; ++r) m = fmaxf(m, s[0][r]);
        if (two) {
#pragma unroll
            for (int r = 0; r < 16; ++r) m = fmaxf(m, s[1][r]); }
        m = fmaxf(m, __shfl_xor(m, 32));
        if (hi == 0) MB[wid * 32 + r32] = m;
        __syncthreads();
        float M = MB[r32];
#pragma unroll
        for (int w = 1; w < 8; ++w) M = fmaxf(M, MB[w * 32 + r32]);
        float lsum = 0.f;
#pragma unroll
        for (int ch = 0; ch < 2; ++ch) if (ch == 0 || two) {
#pragma unroll
            for (int r = 0; r < 16; ++r) { s[ch][r] = __builtin_amdgcn_exp2f(s[ch][r] - M); lsum += s[ch][r]; }
            const int kbase = (ch == 0) ? 32 * wid : 256;
#pragma unroll
            for (int t = 0; t < 4; ++t) { v2u w; w.x = pk2(s[ch][4 * t], s[ch][4 * t + 1]); w.y = pk2(s[ch][4 * t + 2], s[ch][4 * t + 3]);
                *(LAS v2u*)(PL + r32 * 296 + kbase + 8 * t + 4 * hi) = w; } }
        lsum += __shfl_xor(lsum, 32);
        if (hi == 0) LB[wid * 32 + r32] = lsum;
        __syncthreads();
        f32x16 o = {};
#pragma unroll
        for (int ks = 0; ks < 10; ++ks) if (ks < nks) {
            const int key0 = (ks < 8) ? 128 * kh + 16 * ks : 256 + 16 * (ks - 8);
            const bf16x8 pf = *(const LAS bf16x8*)(PL + r32 * 296 + key0 + 8 * hi);
            o = __builtin_amdgcn_mfma_f32_32x32x16_bf16(vfr[ks], pf, o, 0, 0, 0); }
        if (kh == 1) {
#pragma unroll
            for (int r = 0; r < 16; ++r) OX[eb * 1024 + r * 64 + lane] = o[r]; }
        __syncthreads();
        if (kh == 0) { const size_t pi = ((size_t)(bh * 8 + split) * 2 + c) * 32 + r32;
#pragma unroll
            for (int t = 0; t < 4; ++t) { f32x4 v; v.x = o[4 * t] + OX[eb * 1024 + (4 * t) * 64 + lane]; v.y = o[4 * t + 1] + OX[eb * 1024 + (4 * t + 1) * 64 + lane];
                v.z = o[4 * t + 2] + OX[eb * 1024 + (4 * t + 2) * 64 + lane]; v.w = o[4 * t + 3] + OX[eb * 1024 + (4 * t + 3) * 64 + lane];
                *(f32x4*)(SPO + pi * 128 + 32 * eb + 8 * t + 4 * hi) = v; }
            if (wid == 0 && hi == 0) { float Lq = LB[r32];
#pragma unroll
                for (int w = 1; w < 8; ++w) Lq += LB[w * 32 + r32];
                SPM[pi * 2] = M; SPM[pi * 2 + 1] = Lq; } }
    }
    __syncthreads();
}

template <int NB> __device__ __forceinline__ void sample_gemm_res(const Frame& F, const bf16* Arows, int lda, const bf16* Bt, int K, bf16* XBs, float* SS, LAS unsigned char* lds) {
    int lane_l = F.lane; asm volatile("" : "+v"(lane_l));
    const int lane = lane_l, ks = F.wave, r32 = lane & 31, hi = lane >> 5, rt = F.vcu >> 5, ct = F.vcu & 31;
    const int Kw = K >> 3, nst = Kw >> 4;
    const bf16* ap = Arows + (size_t)(32 * rt + r32) * lda + ks * Kw + 8 * hi;
    const bf16* bp = Bt + (size_t)(32 * ct + r32) * K + ks * Kw + 8 * hi;
    f32x16 acc = {};
#pragma unroll 1
    for (int s0 = 0; s0 < nst; s0 += NB) {
        bf16x8 a[NB], b[NB];
#pragma unroll
        for (int i = 0; i < NB; ++i) { a[i] = *(const bf16x8*)(ap + 16 * (s0 + i)); b[i] = *(const bf16x8*)(bp + 16 * (s0 + i)); }
        __builtin_amdgcn_sched_barrier(0);
#pragma unroll
        for (int i = 0; i < NB; ++i) acc = __builtin_amdgcn_mfma_f32_32x32x16_bf16(a[i], b[i], acc, 0, 0, 0);
        __builtin_amdgcn_sched_barrier(0);
    }
    LAS float* RED = (LAS float*)lds;
    LAS float* SSQ = (LAS float*)(lds + 32768);
    if (ks > 0) {
#pragma unroll
        for (int r = 0; r < 16; ++r) RED[(ks - 1) * 1024 + r * 64 + lane] = acc[r]; }
    __syncthreads();
    if (ks == 0) {
        float v[16]; unsigned xo[16];
#pragma unroll
        for (int r = 0; r < 16; ++r) { float t = acc[r];
#pragma unroll
            for (int w = 0; w < 7; ++w) t += RED[w * 1024 + r * 64 + lane];
            v[r] = t; xo[r] = (unsigned)XBs[(unsigned)(32 * rt + crow(r, hi)) * 1024 + 32 * ct + r32]; }
        __builtin_amdgcn_sched_barrier(0);
#pragma unroll
        for (int r = 0; r < 16; ++r) { const float x = v[r] + bflo(xo[r]);
            XBs[(unsigned)(32 * rt + crow(r, hi)) * 1024 + 32 * ct + r32] = (bf16)f2bf(x);
            SSQ[crow(r, hi) * 33 + r32] = x * x; }
    }
    __syncthreads();
    if (ks == 0 && lane < 32) { float s = 0.f;
#pragma unroll
        for (int c2 = 0; c2 < 32; ++c2) s += SSQ[lane * 33 + c2];
        SS[(size_t)16 * MT + ct * 256 + 32 * rt + lane] = s; }
    __syncthreads();
}

__device__ __forceinline__ void conv_item_fast(const Args& A, int l, int item, int lane) {
    const int row0 = item * 8; const bool smp = row0 >= MP;
    const int b = smp ? (row0 - MP) >> 5 : row0 >> 11, t0 = smp ? (row0 - MP) & 31 : row0 & 2047, L = smp ? 32 : 2048;
    const bf16* UC = (const bf16*)(A.ws + WS_UC) + (size_t)(row0 - t0) * 256 + 4 * lane;
    const float* dw = A.in[12] + (size_t)l * 31 * 256 + 4 * lane;
    v2u P[38];
#pragma unroll
    for (int s = 0; s < 38; ++s) { const int tt = t0 - 30 + s; P[s] = (v2u){0u, 0u}; if (tt >= 0) P[s] = *(const v2u*)(UC + (size_t)tt * 256); }
    f32x4 acc[8];
#pragma unroll
    for (int i = 0; i < 8; ++i) acc[i] = (f32x4){0.f, 0.f, 0.f, 0.f};
    f32x4 R[8];
#pragma unroll
    for (int i = 0; i < 7; ++i) { const v2u w = P[i]; R[i] = (f32x4){bflo(w.x), bfhi(w.x), bflo(w.y), bfhi(w.y)}; }
#pragma unroll
    for (int j = 0; j < 31; ++j) { const f32x4 wv = *(const f32x4*)(dw + j * 256);
        { const v2u w = P[7 + j]; R[7] = (f32x4){bflo(w.x), bfhi(w.x), bflo(w.y), bfhi(w.y)}; }
#pragma unroll
        for (int i = 0; i < 8; ++i) acc[i] += wv * R[i];
#pragma unroll
        for (int i = 0; i < 7; ++i) R[i] = R[i + 1];
        __builtin_amdgcn_sched_barrier(0); }
    if (t0 + 7 >= L - 30) { float* cout = A.out + (smp ? O_CS : O_CP) + ((size_t)(l * 8 + b) * 30) * 256 + 4 * lane;
#pragma unroll
        for (int i = 0; i < 8; ++i) { const int tq = t0 + i; const v2u w = P[30 + i]; if (tq >= L - 30) *(f32x4*)(cout + (size_t)(tq - (L - 30)) * 256) = (f32x4){bflo(w.x), bfhi(w.x), bflo(w.y), bfhi(w.y)}; } }
    const f32x4 bias = *(const f32x4*)(A.in[13] + l * 256 + 4 * lane), lg = *(const f32x4*)(A.in[14] + l * 256 + 4 * lane), lb = *(const f32x4*)(A.in[15] + l * 256 + 4 * lane);
    bf16* MIX = (bf16*)(A.ws + WS_MIX) + (size_t)row0 * 1024 + 768 + 4 * lane;
#pragma unroll
    for (int i = 0; i < 8; ++i) { f32x4 y = acc[i] + bias;
        const float mu = wave_sum((y.x + y.y) + (y.z + y.w)) * (1.0f / 256.0f); y = y - mu;
        const float var = wave_sum((y.x * y.x + y.y * y.y) + (y.z * y.z + y.w * y.w)) * (1.0f / 256.0f);
        const float rs = rsqrtf(var + 1e-6f); y = y * rs * lg + lb; y = y * pg8::sigm4(y);
        v2u o; o.x = pk2(y.x, y.y); o.y = pk2(y.z, y.w); *(v2u*)(MIX + (size_t)i * 1024) = o; }
}
__device__ __forceinline__ void conv_item(const Args& A, int l, int item, int lane) {
    const int row0 = item * 8; const bool smp = row0 >= MP;
    const int b = smp ? (row0 - MP) >> 5 : row0 >> 11, t0 = smp ? (row0 - MP) & 31 : row0 & 2047, L = smp ? 32 : 2048;
    const bf16* UC = (const bf16*)(A.ws + WS_UC) + (size_t)(row0 - t0) * 256 + 4 * lane;
    const float* hist = A.in[5] + ((size_t)(l * 8 + b) * 30) * 256 + 4 * lane;
    const float* dw = A.in[12] + (size_t)l * 31 * 256 + 4 * lane;
    f32x4 acc[8], R[8];
#pragma unroll
    for (int i = 0; i < 8; ++i) acc[i] = (f32x4){0.f, 0.f, 0.f, 0.f};
    float* cout = A.out + (smp ? O_CS : O_CP) + ((size_t)(l * 8 + b) * 30) * 256 + 4 * lane;
#define CONV_ROW(dst, tt_) do { const int tt = (tt_); const int ttc = tt < 0 ? 0 : tt; \
        const v2u w_ = *(const v2u*)(UC + (size_t)ttc * 256); f32x4 rv_ = (f32x4){bflo(w_.x), bfhi(w_.x), bflo(w_.y), bfhi(w_.y)}; \
        if (tt < 0) rv_ = (f32x4){0.f, 0.f, 0.f, 0.f}; dst = rv_; } while (0)
#define CONV_HIST(dst, tt_) do { const int tt = (tt_); int hr = 30 + tt; hr = hr < 0 ? 0 : (hr > 29 ? 29 : hr); const f32x4 hv_ = *(const f32x4*)(hist + (size_t)hr * 256); if (tt < 0) dst = hv_; } while (0)
#pragma unroll
    for (int i = 0; i < 7; ++i) CONV_ROW(R[i], t0 - 30 + i);
    if (smp) {
#pragma unroll
        for (int i = 0; i < 7; ++i) CONV_HIST(R[i], t0 - 30 + i); }
#pragma unroll 1
    for (int jb = 0; jb < 32; jb += 8) {
        f32x4 N[8], Wt[8];
#pragma unroll
        for (int jj = 0; jj < 8; ++jj) { const int j = jb + jj; int tt2 = t0 - 23 + j; if (tt2 > L - 1) tt2 = L - 1; CONV_ROW(N[jj], tt2);
            const int jc = j < 31 ? j : 30; Wt[jj] = *(const f32x4*)(dw + jc * 256); if (j >= 31) Wt[jj] = (f32x4){0.f, 0.f, 0.f, 0.f}; }
        if (smp && t0 - 23 + jb < 0) {
#pragma unroll
            for (int jj = 0; jj < 8; ++jj) CONV_HIST(N[jj], t0 - 23 + jb + jj); }
        __builtin_amdgcn_sched_barrier(0);
#pragma unroll
        for (int jj = 0; jj < 8; ++jj) { const int j = jb + jj; R[7] = N[jj];
            if (j >= 23 && j < 31) { const int tq = t0 + (j - 23); if (tq >= L - 30) *(f32x4*)(cout + (size_t)(tq - (L - 30)) * 256) = R[7]; }
#pragma unroll
            for (int i = 0; i < 8; ++i) acc[i] += Wt[jj] * R[i];
#pragma unroll
            for (int i = 0; i < 7; ++i) R[i] = R[i + 1]; }
    }
#undef CONV_HIST
#undef CONV_ROW
    const f32x4 bias = *(const f32x4*)(A.in[13] + l * 256 + 4 * lane), lg = *(const f32x4*)(A.in[14] + l * 256 + 4 * lane), lb = *(const f32x4*)(A.in[15] + l * 256 + 4 * lane);
    bf16* MIX = (bf16*)(A.ws + WS_MIX) + (size_t)row0 * 1024 + 768 + 4 * lane;
#pragma unroll
    for (int i = 0; i < 8; ++i) { f32x4 y = acc[i] + bias;
        const float mu = wave_sum((y.x + y.y) + (y.z + y.w)) * (1.0f / 256.0f); y = y - mu;
        const float var = wave_sum((y.x * y.x + y.y * y.y) + (y.z * y.z + y.w * y.w)) * (1.0f / 256.0f);
        const float rs = rsqrtf(var + 1e-6f); y = y * rs * lg + lb; y = y * pg8::sigm4(y);
        v2u o; o.x = pk2(y.x, y.y); o.y = pk2(y.z, y.w); *(v2u*)(MIX + (size_t)i * 1024) = o; }
}
__device__ __forceinline__ void pool_item(const Args& A, int l, int item, int lane) {
    const int row = item * 2 + (lane >> 5), c0 = (lane & 31) * 8, g = c0 >> 6, w = 2 << g;
    const bool smp = row >= MP; const int b = smp ? (row - MP) >> 5 : row >> 11, t = smp ? (row - MP) & 31 : row & 2047, L = smp ? 32 : 2048;
    const bf16* UP = (const bf16*)(A.ws + WS_UP) + (size_t)(row - t) * 256 + c0;
    const float* hist = A.in[4] + ((size_t)(l * 8 + b) * 15) * 256 + c0;
    float sum[8], own[8];
    v4u pv[16];
#pragma unroll
    for (int jj = 0; jj < 16; ++jj) { const int tt = t - jj; pv[jj] = (v4u){0u, 0u, 0u, 0u}; if (jj < w && tt >= 0) pv[jj] = *(const v4u*)(UP + (size_t)tt * 256); }
    __builtin_amdgcn_sched_barrier(0);
#pragma unroll
    for (int i = 0; i < 8; ++i) sum[i] = 0.f;
#pragma unroll
    for (int jj = 0; jj < 16; ++jj) { const v4u v = pv[jj];
        const float fv[8] = {bflo(v.x), bfhi(v.x), bflo(v.y), bfhi(v.y), bflo(v.z), bfhi(v.z), bflo(v.w), bfhi(v.w)};
#pragma unroll
        for (int i = 0; i < 8; ++i) { sum[i] += fv[i]; if (jj == 0) own[i] = fv[i]; } }
    if (smp && t < w - 1) { for (int jj = t + 1; jj < w; ++jj) { const int tt = t - jj;
            const f32x4 a = *(const f32x4*)(hist + (size_t)(15 + tt) * 256), bq = *(const f32x4*)(hist + (size_t)(15 + tt) * 256 + 4);
            sum[0] += a.x; sum[1] += a.y; sum[2] += a.z; sum[3] += a.w; sum[4] += bq.x; sum[5] += bq.y; sum[6] += bq.z; sum[7] += bq.w; } }
    const int cnt = smp ? w : ((t + 1 < w) ? t + 1 : w); const float ic = 1.0f / (float)cnt;
    v4u o; o.x = pk2(sum[0] * ic - own[0], sum[1] * ic - own[1]); o.y = pk2(sum[2] * ic - own[2], sum[3] * ic - own[3]);
    o.z = pk2(sum[4] * ic - own[4], sum[5] * ic - own[5]); o.w = pk2(sum[6] * ic - own[6], sum[7] * ic - own[7]);
    *(v4u*)((bf16*)(A.ws + WS_MIX) + (size_t)row * 1024 + c0) = o;
    if (t >= L - 15) { float* po = A.out + (smp ? O_PS : O_PP) + ((size_t)(l * 8 + b) * 15 + (t - (L - 15))) * 256 + c0;
        *(f32x4*)po = (f32x4){own[0], own[1], own[2], own[3]}; *(f32x4*)(po + 4) = (f32x4){own[4], own[5], own[6], own[7]}; }
}
__device__ __forceinline__ void post_item(const Args& A, int l, int row0, int lane, float lam, float osc) {
    const int h = lane >> 4, e = (lane & 15) * 8;
    const bf16* O4 = (const bf16*)(A.ws + WS_O4) + (size_t)row0 * 1024 + h * 256 + e;
    v4u a[4], bq[4];
#pragma unroll
    for (int i = 0; i < 4; ++i) { a[i] = *(const v4u*)(O4 + (size_t)i * 1024); bq[i] = *(const v4u*)(O4 + (size_t)i * 1024 + 128); }
    __builtin_amdgcn_sched_barrier(0);
    const f32x4 g0 = *(const f32x4*)(A.in[11] + l * 128 + e), g1 = *(const f32x4*)(A.in[11] + l * 128 + e + 4);
#pragma unroll
    for (int i = 0; i < 4; ++i) {
        float o[8] = {bflo(a[i].x) - lam * bflo(bq[i].x), bfhi(a[i].x) - lam * bfhi(bq[i].x), bflo(a[i].y) - lam * bflo(bq[i].y), bfhi(a[i].y) - lam * bfhi(bq[i].y),
                      bflo(a[i].z) - lam * bflo(bq[i].z), bfhi(a[i].z) - lam * bfhi(bq[i].z), bflo(a[i].w) - lam * bflo(bq[i].w), bfhi(a[i].w) - lam * bfhi(bq[i].w)};
        float ss = 0.f;
#pragma unroll
        for (int k = 0; k < 8; ++k) ss += o[k] * o[k];
        ss += __shfl_xor(ss, 1); ss += __shfl_xor(ss, 2); ss += __shfl_xor(ss, 4); ss += __shfl_xor(ss, 8);
        const float rs = rsqrtf(ss * (1.0f / 128.0f) + 1e-6f) * osc;
        v4u w; w.x = pk2(o[0] * rs * g0.x, o[1] * rs * g0.y); w.y = pk2(o[2] * rs * g0.z, o[3] * rs * g0.w); w.z = pk2(o[4] * rs * g1.x, o[5] * rs * g1.y); w.w = pk2(o[6] * rs * g1.z, o[7] * rs * g1.w);
        *(v4u*)((bf16*)(A.ws + WS_MIX) + (size_t)(row0 + i) * 1024 + 256 + h * 128 + e) = w; }
}
__device__ __forceinline__ void scomb_item(const Args& A, int l, int item, int lane, float lam, float osc) {
    const int rs_ = item >> 2, h = item & 3, b = rs_ >> 5, q = rs_ & 31, bh = b * 4 + h;
    const float* SPO = (const float*)(A.ws + WS_SPO); const float* SPM = (const float*)(A.ws + WS_SPM);
    float oc[2][2];
#pragma unroll
    for (int c = 0; c < 2; ++c) {
        typedef float f32x2t __attribute__((ext_vector_type(2)));
        f32x2t ml[8], ov[8];
#pragma unroll
        for (int s = 0; s < 8; ++s) { const size_t pi = ((size_t)(bh * 8 + s) * 2 + c) * 32 + q; ml[s] = *(const f32x2t*)(SPM + pi * 2); ov[s] = *(const f32x2t*)(SPO + pi * 128 + 2 * lane); }
        __builtin_amdgcn_sched_barrier(0);
        float M = ml[0].x;
#pragma unroll
        for (int s = 1; s < 8; ++s) M = fmaxf(M, ml[s].x);
        float Ls = 0.f, o0 = 0.f, o1 = 0.f;
#pragma unroll
        for (int s = 0; s < 8; ++s) { const float wgt = __builtin_amdgcn_exp2f(ml[s].x - M); Ls += wgt * ml[s].y; o0 += wgt * ov[s].x; o1 += wgt * ov[s].y; }
        const float il = 1.0f / Ls; oc[c][0] = o0 * il; oc[c][1] = o1 * il; }
    const float x0 = oc[0][0] - lam * oc[1][0], x1 = oc[0][1] - lam * oc[1][1];
    const float ss = wave_sum(x0 * x0 + x1 * x1); const float rs = rsqrtf(ss * (1.0f / 128.0f) + 1e-6f) * osc;
    const float* g = A.in[11] + l * 128 + 2 * lane;
    *(unsigned*)((bf16*)(A.ws + WS_MIX) + (size_t)(MP + rs_) * 1024 + 256 + h * 128 + 2 * lane) = pk2(x0 * rs * g[0], x1 * rs * g[1]);
}

__global__ void __launch_bounds__(NWAVES * 64, 2) mk_fwd(Args args) {
    extern __shared__ __attribute__((aligned(16))) unsigned char lds_raw[];
    LAS unsigned char* lds = (LAS unsigned char*)lds_raw;
    Frame F; F.tid = threadIdx.x; F.lane = F.tid & 63; F.wave = __builtin_amdgcn_readfirstlane(F.tid >> 6);
    F.G = gridDim.x; { const int bx = blockIdx.x; F.vcu = (F.G % 8 == 0) ? (bx % 8) * (F.G / 8) + bx / 8 : bx; }
    F.gw = F.vcu * NWAVES + F.wave; F.NGW = F.G * NWAVES;
    unsigned char* ws = args.ws;
    const int lo = args.ph_lo, hi = args.ph_hi;
#define IN(k) (lo <= (k) && (k) < hi)
#define SEAM(k) do { if (IN(k) && IN((k) + 1)) { xcd_barrier(bar); } } while (0)
    for (int u = F.tid; u < 64; u += NWAVES * 64) ((LAS unsigned*)(lds + MISC_OFF))[u] = 0u;
    __syncthreads();
    XcdBarrier bar; bar.bar = (unsigned*)ws; bar.x = 0; bar.st = nullptr;
    if (!MK_MULTI) bar = xcd_barrier_post((unsigned*)ws, (volatile LAS unsigned*)(lds + MISC_OFF) + 8);
    #ifndef REP_PRO
#define REP_PRO 1
#endif
#ifndef REP_INP
#define REP_INP 1
#endif
#ifndef REP_ATT
#define REP_ATT 1
#endif
#ifndef REP_MIX
#define REP_MIX 1
#endif
#ifndef REP_GU
#define REP_GU 1
#endif
    if (!MK_MULTI && lo < 0) cg::this_grid().sync();
    if (IN(0)) { for (int rep = 0; rep < REP_PRO; ++rep) { p0_prologue(F, args, lds); __syncthreads(); } }
    SEAM(0);
    for (int rep = 0; rep < REP_SYNC; ++rep) xcd_barrier(bar);
    float* X = args.out + O_Y;
    bf16* XB = (bf16*)(ws + WS_XB); float* SS = (float*)(ws + WS_SS);
#pragma unroll 1
    for (int l = 0; l < 2; ++l) {
        const int pb = 1 + 6 * l;
        if (IN(pb)) for (int rep = 0; rep < REP_INP; ++rep) {
            pg8::Gemm g{XB, (const bf16*)(ws + WS_WIN) + (size_t)l * INW * 1024, MT, INW, 1024}; pg8::StaticOrder S; S.init(MT, INW, F.G, (int)blockIdx.x);
            pg8::EpiInProj E{SS, (const float*)(ws + WS_TAB), (bf16*)(ws + WS_UP), (bf16*)(ws + WS_Q), (bf16*)(ws + WS_K), (bf16*)(ws + WS_V), (bf16*)(ws + WS_UC),
                args.out + O_KP + (size_t)l * 8 * 2048 * 512, args.out + O_KS + (size_t)l * 8 * 32 * 512, args.out + O_VP + (size_t)l * 8 * 2048 * 512, args.out + O_VS + (size_t)l * 8 * 32 * 512};
            pg8::gemm_phase<pg8::EpiInProj, pg8::StaticOrder, PG8_ALIGN, PG8_SP2>(lds, g, S, E);
            if (SLACK_W && rep == 0) { if (l == 0) slack_weights(F, args, lds, (MT / 256) * (INW / 256), WI_A, WI_B); else slack_weights(F, args, lds, (MT / 256) * (INW / 256), WI_C, WI_END); }
        }
        SEAM(pb);
        if (IN(pb + 1)) for (int rep = 0; rep < REP_ATT; ++rep) {
            const int bh = F.vcu >> 3, jj = F.vcu & 7, a = jj & 3, c = jj >> 2, b = bh >> 2, h = bh & 3;
            const attn_body::bf16* Qp = (const attn_body::bf16*)(ws + WS_Q); const attn_body::bf16* Kp = (const attn_body::bf16*)(ws + WS_K); const attn_body::bf16* Vp = (const attn_body::bf16*)(ws + WS_V);
            attn_body::bf16* Op = (attn_body::bf16*)(ws + WS_O4);
            const int spos = F.vcu % 5;
#pragma unroll 1
            for (int i = 0; i < 5; ++i) {
                if (i == spos) { sample_attn_unit(F, args, l, F.vcu >> 3, F.vcu & 7, lds); }
                else { const int k = i - (i > spos ? 1 : 0); const int vh = k >> 1, qb = (k & 1) ? 7 - a : a;
                    attn_body::attn_unit<8>(b, 2 * h + c, 2 * h + vh, qb, Qp, Kp, Vp, Op, h * 256 + c * 128 + vh * 64, (char*)lds_raw); __syncthreads(); }
            }
        }
        SEAM(pb + 1);
        if (IN(pb + 2)) for (int rep = 0; rep < REP_MIX; ++rep) {
            int mlane = F.lane; asm volatile("" : "+v"(mlane));
            const float lam = ((const float*)(ws + WS_LAM))[l]; const float osc = 1.0f - (0.8f - 0.6f * expf(-0.3f * (float)l));
            const bool heavy = (F.NGW == 2048) && ((F.gw & 63) == 0);
            const int lgw = (F.NGW == 2048) ? F.gw - ((F.gw + 63) >> 6) : F.gw, lng = (F.NGW == 2048) ? 2016 : F.NGW;
#pragma unroll 1
            for (int k = 0; k < 2; ++k) { if (k == 1 && !heavy) break; conv_item(args, l, k == 0 ? F.gw : MP / 8 + (F.gw >> 6), mlane); }
            if (!heavy) {
            for (int it = lgw; it < MT / 2; it += lng) pool_item(args, l, it, mlane);
            for (int it = lgw; it < MP / 4; it += lng) post_item(args, l, it * 4, mlane, lam, osc);
            for (int it = lgw; it < 1024; it += lng) scomb_item(args, l, it, mlane, lam, osc);
            }
        }
        SEAM(pb + 2);
#ifndef REP_OUT0
#define REP_OUT0 1
#endif
#ifndef REP_SYNC
#define REP_SYNC 0
#endif
#ifndef REP_FOLD
#define REP_FOLD 1
#endif
#ifndef REP_SLACK
#define REP_SLACK 1
#endif
#ifndef SLACK_W
#define SLACK_W 1
#endif
        if (IN(pb + 3)) for (int rep = 0; rep < (l == 0 ? REP_OUT0 : 1); ++rep) {
            pg8::Gemm g{(const bf16*)(ws + WS_MIX), (const bf16*)(ws + WS_WOUT) + (size_t)l * 1024 * 1024, MP, 1024, 1024}; pg8::StaticOrder S; S.init(MP, 1024, F.G, (int)blockIdx.x);
            pg8::EpiRes E{XB, SS, 0};
            pg8::gemm_phase<pg8::EpiRes, pg8::StaticOrder, PG8_ALIGN, PG8_SP2>(lds, g, S, E);
            sample_gemm_res<8>(F, (const bf16*)(ws + WS_MIX) + (size_t)MP * 1024, 1024, (const bf16*)(ws + WS_WOUT) + (size_t)l * 1024 * 1024, 1024, XB + (size_t)MP * 1024, SS, lds);
        }
        SEAM(pb + 3);
        if (IN(pb + 4)) for (int rep = 0; rep < REP_GU; ++rep) {
            pg8::Gemm g{XB, (const bf16*)(ws + WS_WGU) + (size_t)l * 2 * DFF * 1024, MT, 2 * DFF, 1024}; pg8::StaticOrder S; S.init(MT, 2 * DFF, F.G, (int)blockIdx.x);
            pg8::EpiSwiGLU E{(bf16*)(ws + WS_H), SS};
            pg8::gemm_phase<pg8::EpiSwiGLU, pg8::StaticOrder, PG8_ALIGN, PG8_SP2>(lds, g, S, E);
            if (SLACK_W && rep == 0 && l == 0) slack_weights(F, args, lds, (MT / 256) * (2 * DFF / 256), WI_B, WI_C);
        }
        SEAM(pb + 4);
#ifndef REP_DN
#define REP_DN 1
#endif
        if (IN(pb + 5)) for (int rep = 0; rep < REP_DN; ++rep) {
            pg8::Gemm g{(const bf16*)(ws + WS_H), (const bf16*)(ws + WS_WDN) + (size_t)l * 1024 * DFF, MP, 1024, DFF}; pg8::StaticOrder S; S.init(MP, 1024, F.G, (int)blockIdx.x);
            pg8::EpiRes E{XB, SS, rep < REP_DN - 1};
            pg8::gemm_phase<pg8::EpiRes, pg8::StaticOrder, PG8_ALIGN, PG8_SP2>(lds, g, S, E);
            if (rep == REP_DN - 1) sample_gemm_res<11>(F, (const bf16*)(ws + WS_H) + (size_t)MP * DFF, DFF, (const bf16*)(ws + WS_WDN) + (size_t)l * 1024 * DFF, DFF, XB + (size_t)MP * 1024, SS, lds);
        }
        SEAM(pb + 5);
    }
#ifndef REP_FIN
#define REP_FIN 1
#endif
    if (IN(13)) for (int rep = 0; rep < REP_FIN; ++rep) {
        const float* gf = args.in[21]; int flane = F.lane; asm volatile("" : "+v"(flane));
        for (int m0 = F.gw * 2; m0 < MT; m0 += F.NGW * 2) {
            v4u w[2][2];
#pragma unroll
            for (int q = 0; q < 2; ++q)
#pragma unroll
                for (int j = 0; j < 2; ++j) w[q][j] = *((const v4u*)(XB + (size_t)(m0 + q) * 1024) + flane + 64 * j);
            __builtin_amdgcn_sched_barrier(0);
#pragma unroll
            for (int q = 0; q < 2; ++q) { float v[2][8]; float s = 0.f;
#pragma unroll
                for (int j = 0; j < 2; ++j) { const v4u ww = w[q][j]; v[j][0] = bflo(ww.x); v[j][1] = bfhi(ww.x); v[j][2] = bflo(ww.y); v[j][3] = bfhi(ww.y); v[j][4] = bflo(ww.z); v[j][5] = bfhi(ww.z); v[j][6] = bflo(ww.w); v[j][7] = bfhi(ww.w);
#pragma unroll
                    for (int k = 0; k < 8; ++k) s += v[j][k] * v[j][k]; }
                const float r = rsqrtf(wave_sum(s) * (1.0f / 1024.0f) + 1e-6f);
#pragma unroll
                for (int j = 0; j < 2; ++j) { const f32x4 g0 = *((const f32x4*)gf + 2 * (flane + 64 * j)), g1 = *((const f32x4*)gf + 2 * (flane + 64 * j) + 1);
                    f32x4* yo = (f32x4*)(X + (size_t)(m0 + q) * 1024) + 2 * (flane + 64 * j);
                    yo[0] = (f32x4){v[j][0] * r * g0.x, v[j][1] * r * g0.y, v[j][2] * r * g0.z, v[j][3] * r * g0.w};
                    yo[1] = (f32x4){v[j][4] * r * g1.x, v[j][5] * r * g1.y, v[j][6] * r * g1.z, v[j][7] * r * g1.w}; } } }
    }
#undef IN
#undef SEAM
}

extern "C" void kernel_launch(void* const* d_in, const int* in_sizes, int n_in, void* d_out, int out_size, void* d_ws, size_t ws_size, hipStream_t stream) {
    static int grid = 0;
    if (grid == 0) {
        if (n_in != 22 || out_size != (int)O_END || ws_size < WS_END) { fprintf(stderr, "kernel_launch: unexpected shapes (n_in %d out %d ws %zu)\n", n_in, out_size, ws_size); grid = -1; return; }
        int dev = 0, cus = 0, per_cu = 0;
        hipGetDevice(&dev); hipDeviceGetAttribute(&cus, hipDeviceAttributeMultiprocessorCount, dev);
        if (hipFuncSetAttribute((const void*)mk_fwd, hipFuncAttributeMaxDynamicSharedMemorySize, LDS_BYTES) != hipSuccess) { fprintf(stderr, "kernel_launch: hipFuncSetAttribute failed\n"); grid = -1; return; }
        hipOccupancyMaxActiveBlocksPerMultiprocessor(&per_cu, (const void*)mk_fwd, NWAVES * 64, LDS_BYTES);
        (void)hipGetLastError();
        if (per_cu < 1) { fprintf(stderr, "kernel_launch: occupancy query says %d blocks per CU\n", per_cu); per_cu = 1; }
        grid = cus;
        if (grid > 256) grid = 256;
    }
    if (grid < 0) return;
    if (hipMemsetAsync(d_ws, 0, 65536, stream) != hipSuccess) { fprintf(stderr, "kernel_launch: memset failed\n"); return; }
    Args a{};
    for (int i = 0; i < 22; ++i) a.in[i] = (const float*)d_in[i];
    a.out = (float*)d_out; a.ws = (unsigned char*)d_ws;
#if MK_MULTI
    for (int p = 0; p < NPH; ++p) { a.ph_lo = p; a.ph_hi = p + 1; hipLaunchKernelGGL(mk_fwd, dim3(grid), dim3(NWAVES * 64), LDS_BYTES, stream, a); }
#else
    a.ph_lo = 0; a.ph_hi = NPH;
    void* kargs[] = {&a};
    hipError_t e = hipLaunchCooperativeKernel((const void*)mk_fwd, dim3(grid), dim3(NWAVES * 64), kargs, LDS_BYTES, stream);
    if (e != hipSuccess) fprintf(stderr, "kernel_launch: cooperative launch failed: %s (grid %d)\n", hipGetErrorString(e), grid);
#endif
}
```

```cpp
#define MK_MULTI 0
#include <hip/hip_runtime.h>
#include <hip/hip_cooperative_groups.h>
#include <cstdio>
#include <cstdint>
namespace cg = cooperative_groups;
namespace pg8 {
#define PG8_LAS __attribute__((address_space(3)))
typedef unsigned short bf16_t;
typedef short bf16x8 __attribute__((ext_vector_type(8)));
typedef float f32x4 __attribute__((ext_vector_type(4)));
typedef unsigned u32x4 __attribute__((ext_vector_type(4)));
constexpr int BM = 256, BK = 64, HALF = 128, HTB = HALF * BK * 2  , STAGE_BYTES = 8 * HTB, NXCD = 8, WGM = 4;

__host__ __device__ __forceinline__ int lds_byte(int r, int c) { const int st = (r >> 4) * 2 + (c >> 5), rr = r & 15, cc = c & 31, ob = rr * 64 + cc * 2; return st * 1024 + (ob ^ (((ob >> 9) & 1) << 5)); }
__host__ __device__ __forceinline__ void stage_rc(int b, int& R, int& C) { const int st = b / 1024, sb = b % 1024, swz = sb ^ (((sb >> 9) & 1) << 5); R = (st >> 1) * 16 + swz / 64; C = (st & 1) * 32 + (swz % 64) / 2; }
__host__ __device__ __forceinline__ int perm32(int rho) { const int n = rho >> 4, i = rho & 15; return 8 * (i >> 2) + 4 * n + (i & 3); }

struct Unit { int pm, pn; };
struct Gemm { const bf16_t* A; const bf16_t* Bt; int M, N, K; };

struct StaticOrder {
    int nM, nN, nwg, G, c;
    __host__ __device__ void init(int M, int N, int G_, int c_) { nM = M / BM; nN = N / BM; nwg = nM * nN; G = G_; c = c_; }
    __host__ __device__ bool next(int i, Unit& u) const {
        const long L = (long)i * G + c; if (L >= nwg) return false;
        int wgid = (int)L; { const int q = nwg / NXCD, r = nwg % NXCD, xcd = wgid % NXCD, off = wgid / NXCD; wgid = (xcd < r ? xcd * (q + 1) : r * (q + 1) + (xcd - r) * q) + off; }
        const int nig = WGM * nN, gid = wgid / nig, fm = gid * WGM, gsz = (nM - fm) < WGM ? (nM - fm) : WGM;
        u.pm = fm + ((wgid % nig) % gsz); u.pn = (wgid % nig) / gsz; return true;
    }
    __device__ __forceinline__ void a_ready(const Unit&) const {}
    __device__ __forceinline__ void done(const Unit&) const {}
};

__device__ __forceinline__ unsigned cvt_pk_bf16(float lo, float hi) { unsigned r; asm volatile("v_cvt_pk_bf16_f32 %0, %1, %2" : "=v"(r) : "v"(lo), "v"(hi)); return r; }
typedef float f32x2 __attribute__((ext_vector_type(2)));
template <class Epi, class Sched, bool ALIGN_EPI = false, bool SP2 = false>
__device__ __forceinline__ void gemm_phase(PG8_LAS unsigned char* lds, const Gemm g, const Sched& S, const Epi& E) {
    int tid_l = threadIdx.x; asm volatile("" : "+v"(tid_l));
    const int tid = tid_l, wid = __builtin_amdgcn_readfirstlane(tid >> 6), lane = tid & 63, wr = wid >> 2, wc = wid & 3, fr = lane & 15, fq = lane >> 4;
    const int K = g.K, nt = K / BK;
    unsigned voffA[2], voffB[2];
#pragma unroll
    for (int i = 0; i < 2; ++i) { int R, C; stage_rc(tid * 16 + i * 8192, R, C); const int Rb = Epi::PERM ? ((R & ~31) + perm32(R & 31)) : R;
        voffA[i] = (unsigned)(R * K + C) * 2u; voffB[i] = (unsigned)(Rb * K + C) * 2u; }
    const size_t kstep = (size_t)(BK * 2);
    const size_t hstep = (size_t)HALF * K * 2;
    const size_t tstep = 2 * hstep;
    const unsigned ldsw = (unsigned)wid * 1024u;
    const int aoff = lds_byte(wr * 64 + fr, fq * 8), boff = lds_byte(wc * 32 + fr, fq * 8);
#define PG8_SA(b, h) (((b) * 2 + (h)) * HTB)
#define PG8_SB(b, h) ((4 + (b) * 2 + (h)) * HTB)
#define PG8_STAGE(bufoff, gbase, voff) do { _Pragma("unroll") for (int _i = 0; _i < 2; ++_i) \
        __builtin_amdgcn_global_load_lds((const unsigned*)((const char*)(gbase) + (voff)[_i]), (PG8_LAS unsigned*)(lds + (bufoff) + ldsw + _i * 8192), 16, 0, 0); } while (0)
#define PG8_LDA(dst, b, h) do { _Pragma("unroll") for (int m = 0; m < 4; ++m) _Pragma("unroll") for (int k = 0; k < 2; ++k) dst[m][k] = *(const PG8_LAS bf16x8*)(lds + PG8_SA(b, h) + aoff + m * 2048 + k * 1024); } while (0)
#define PG8_LDB(dst, b, h) do { _Pragma("unroll") for (int n = 0; n < 2; ++n) _Pragma("unroll") for (int k = 0; k < 2; ++k) dst[n][k] = *(const PG8_LAS bf16x8*)(lds + PG8_SB(b, h) + boff + n * 2048 + k * 1024); } while (0)
#define PG8_MMA(ai, bj, At, Bt) do { __builtin_amdgcn_s_setprio(1); _Pragma("unroll") for (int m = 0; m < 4; ++m) _Pragma("unroll") for (int n = 0; n < 2; ++n) _Pragma("unroll") for (int k = 0; k < 2; ++k) \
        acc[ai][bj][m][n] = __builtin_amdgcn_mfma_f32_16x16x32_bf16(Bt[n][k], At[m][k], acc[ai][bj][m][n], 0, 0, 0); __builtin_amdgcn_s_setprio(0); } while (0)
#define PG8_WAIT_V(n) asm volatile("s_waitcnt vmcnt(" #n ")" ::: "memory")
#define PG8_WAIT_L(n) asm volatile("s_waitcnt lgkmcnt(" #n ")" ::: "memory")
#define PG8_BAR __builtin_amdgcn_s_barrier()
#define PG8_SCHED __builtin_amdgcn_sched_barrier(0)
    Unit cur, nxt; int ui = 0;
    if (!S.next(0, cur)) return;
    f32x4 acc[2][2][4][2];
#pragma unroll
    for (int a = 0; a < 2; ++a)
#pragma unroll
        for (int b = 0; b < 2; ++b)
#pragma unroll
            for (int m = 0; m < 4; ++m)
#pragma unroll
                for (int n = 0; n < 2; ++n) acc[a][b][m][n] = (f32x4){0.f, 0.f, 0.f, 0.f};
    bf16x8 At[4][2], B0[2][2], B1[2][2];
    const char* cA = (const char*)g.A + (size_t)cur.pm * tstep; const char* cB = (const char*)g.Bt + (size_t)cur.pn * tstep;
    S.a_ready(cur);
    if constexpr (SP2) {
        PG8_STAGE(PG8_SB(0, 0), cB, voffB); PG8_STAGE(PG8_SB(0, 1), cB + hstep, voffB); PG8_STAGE(PG8_SA(0, 0), cA, voffA); PG8_STAGE(PG8_SA(0, 1), cA + hstep, voffA);
        if (wr == 1) PG8_BAR;
        PG8_WAIT_V(2); PG8_BAR;
        PG8_STAGE(PG8_SB(1, 0), cB + kstep, voffB); PG8_STAGE(PG8_SA(1, 0), cA + kstep, voffA); PG8_STAGE(PG8_SB(1, 1), cB + hstep + kstep, voffB);
        PG8_WAIT_V(6); PG8_BAR;
    } else {
        PG8_STAGE(PG8_SB(0, 0), cB, voffB); PG8_STAGE(PG8_SA(0, 0), cA, voffA); PG8_STAGE(PG8_SB(0, 1), cB + hstep, voffB); PG8_STAGE(PG8_SA(0, 1), cA + hstep, voffA);
        if (wr == 1) PG8_BAR;
        PG8_WAIT_V(4); PG8_BAR;
        PG8_STAGE(PG8_SB(1, 0), cB + kstep, voffB); PG8_STAGE(PG8_SA(1, 0), cA + kstep, voffA); PG8_STAGE(PG8_SB(1, 1), cB + hstep + kstep, voffB);
        PG8_WAIT_V(6); PG8_BAR;
    }
    for (;;) {
        const bool has_next = S.next(ui + 1, nxt);
        const char* nA = has_next ? (const char*)g.A + (size_t)nxt.pm * tstep : cA; const char* nB = has_next ? (const char*)g.Bt + (size_t)nxt.pn * tstep : cB;
        for (int t = 0; t < nt; t += 2) {
            const bool last = (t == nt - 2);
            const char* a1 = cA + (size_t)(t + 1) * kstep;
            const char* a2 = last ? nA : cA + (size_t)(t + 2) * kstep; const char* b2 = last ? nB : cB + (size_t)(t + 2) * kstep;
            const char* a3 = a2 + kstep; const char* b3 = b2 + kstep;
            if (last && has_next) S.a_ready(nxt);
            if constexpr (SP2) {
            PG8_LDB(B0, 0, 0); PG8_LDB(B1, 0, 1); PG8_SCHED; PG8_LDA(At, 0, 0); PG8_STAGE(PG8_SA(1, 1), a1 + hstep, voffA);
            PG8_WAIT_V(8); PG8_WAIT_L(0); PG8_BAR; PG8_MMA(0, 0, At, B0); PG8_MMA(0, 1, At, B1); PG8_BAR; PG8_SCHED;
            PG8_LDA(At, 0, 1); PG8_STAGE(PG8_SB(0, 0), b2, voffB); PG8_STAGE(PG8_SB(0, 1), b2 + hstep, voffB); PG8_STAGE(PG8_SA(0, 0), a2, voffA);
            PG8_WAIT_V(8); PG8_WAIT_L(0); PG8_BAR; PG8_MMA(1, 0, At, B0); PG8_MMA(1, 1, At, B1); PG8_BAR; PG8_SCHED;
            PG8_LDB(B0, 1, 0); PG8_LDB(B1, 1, 1); PG8_SCHED; PG8_LDA(At, 1, 0); PG8_STAGE(PG8_SA(0, 1), a2 + hstep, voffA);
            PG8_WAIT_V(8); PG8_WAIT_L(0); PG8_BAR; PG8_MMA(0, 0, At, B0); PG8_MMA(0, 1, At, B1); PG8_BAR; PG8_SCHED;
            PG8_LDA(At, 1, 1); PG8_STAGE(PG8_SB(1, 0), b3, voffB); PG8_STAGE(PG8_SB(1, 1), b3 + hstep, voffB); PG8_STAGE(PG8_SA(1, 0), a3, voffA);
            PG8_WAIT_V(8); PG8_WAIT_L(0); PG8_BAR; PG8_MMA(1, 0, At, B0); PG8_MMA(1, 1, At, B1); PG8_BAR; PG8_SCHED;
            } else {
            PG8_LDB(B0, 0, 0); PG8_SCHED; PG8_LDA(At, 0, 0); PG8_STAGE(PG8_SA(1, 1), a1 + hstep, voffA);
            PG8_WAIT_L(8); PG8_BAR; PG8_WAIT_L(0); PG8_MMA(0, 0, At, B0); PG8_BAR; PG8_SCHED;
            PG8_LDB(B1, 0, 1); PG8_STAGE(PG8_SB(0, 0), b2, voffB);
            PG8_BAR; PG8_WAIT_L(0); PG8_MMA(0, 1, At, B1); PG8_BAR;
            PG8_LDA(At, 0, 1); PG8_STAGE(PG8_SA(0, 0), a2, voffA);
            PG8_BAR; PG8_WAIT_L(0); PG8_MMA(1, 0, At, B0); PG8_BAR; PG8_SCHED;
            PG8_STAGE(PG8_SB(0, 1), b2 + hstep, voffB);
            PG8_WAIT_V(6); PG8_BAR; PG8_MMA(1, 1, At, B1); PG8_BAR;
            PG8_LDB(B0, 1, 0); PG8_SCHED; PG8_LDA(At, 1, 0); PG8_STAGE(PG8_SA(0, 1), a2 + hstep, voffA);
            PG8_WAIT_L(8); PG8_BAR; PG8_WAIT_L(0); PG8_MMA(0, 0, At, B0); PG8_BAR; PG8_SCHED;
            PG8_LDB(B1, 1, 1); PG8_STAGE(PG8_SB(1, 0), b3, voffB);
            PG8_BAR; PG8_WAIT_L(0); PG8_MMA(0, 1, At, B1); PG8_BAR;
            PG8_LDA(At, 1, 1); PG8_STAGE(PG8_SA(1, 0), a3, voffA);
            PG8_BAR; PG8_WAIT_L(0); PG8_MMA(1, 0, At, B0); PG8_BAR; PG8_SCHED;
            PG8_STAGE(PG8_SB(1, 1), b3 + hstep, voffB);
            PG8_WAIT_V(6); PG8_BAR; PG8_MMA(1, 1, At, B1); PG8_BAR;
            }
        }
        if constexpr (ALIGN_EPI) { if (wr == 0) PG8_BAR; }
        if constexpr (!Epi::AFTER_DRAIN) { E(acc, cur, wr, wc, fr, fq); S.done(cur); }
        if (!has_next) break;
#pragma unroll
        for (int a = 0; a < 2; ++a)
#pragma unroll
            for (int b = 0; b < 2; ++b)
#pragma unroll
                for (int m = 0; m < 4; ++m)
#pragma unroll
                    for (int n = 0; n < 2; ++n) acc[a][b][m][n] = (f32x4){0.f, 0.f, 0.f, 0.f};
        cur = nxt; cA = nA; cB = nB; ++ui;
        if constexpr (ALIGN_EPI) { if (wr == 1) PG8_BAR; }
    }
    PG8_WAIT_V(0);
    if constexpr (!ALIGN_EPI) { if (wr == 0) PG8_BAR; }
    PG8_BAR;
    if constexpr (Epi::AFTER_DRAIN) { E.fused(acc, cur, wr, wc, fr, fq, lds, wid, lane); S.done(cur); }
#undef PG8_SA
#undef PG8_SB
#undef PG8_STAGE
#undef PG8_LDA
#undef PG8_LDB
#undef PG8_MMA
#undef PG8_WAIT_V
#undef PG8_WAIT_L
#undef PG8_BAR
#undef PG8_SCHED
}
}
#define PG8_SP2 true
#define PG8_ALIGN true
namespace pg8 {
constexpr int MT = 16640, MP = 16384;
constexpr float RMS_EPS = 1e-6f;
constexpr float QC2 = 0.125f * 1.4426950408889634f;
typedef unsigned u32x2 __attribute__((ext_vector_type(2)));
__device__ __forceinline__ float row_rs(const float* SS, int row, int fq) {
    float s = 0.f;
#pragma unroll
    for (int j = 0; j < 4; ++j) s += SS[(unsigned)(4 * fq + j) * MT + row];
    s += __shfl_xor(s, 16); s += __shfl_xor(s, 32);
    return rsqrtf(s * (1.0f / 1024.0f) + RMS_EPS);
}
__device__ __forceinline__ void rows_rs8(const float* SS, int row0, int fq, float (&r)[8]) {
    float s[8][4];
    if (row0 < MP) {
#pragma unroll
        for (int k = 0; k < 8; ++k)
#pragma unroll
            for (int j = 0; j < 4; ++j) s[k][j] = SS[(unsigned)(4 * fq + j) * MT + row0 + (k >> 2) * HALF + (k & 3) * 16];
    } else { const float* S2 = SS + 16 * MT + (row0 - MP);
#pragma unroll
        for (int h2 = 0; h2 < 2; ++h2) { float q[4][8];
            __builtin_amdgcn_sched_barrier(0);
#pragma unroll
            for (int k = 0; k < 4; ++k)
#pragma unroll
                for (int j = 0; j < 8; ++j) q[k][j] = S2[(unsigned)(8 * fq + j) * 256 + h2 * HALF + k * 16];
            __builtin_amdgcn_sched_barrier(0);
#pragma unroll
            for (int k = 0; k < 4; ++k)
#pragma unroll
                for (int j = 0; j < 4; ++j) s[h2 * 4 + k][j] = q[k][j] + q[k][j + 4]; }
    }
    __builtin_amdgcn_sched_barrier(0);
#pragma unroll
    for (int k = 0; k < 8; ++k) { float t = (s[k][0] + s[k][1]) + (s[k][2] + s[k][3]); t += __shfl_xor(t, 16); t += __shfl_xor(t, 32); r[k] = rsqrtf(t * (1.0f / 1024.0f) + RMS_EPS); }
    __builtin_amdgcn_sched_barrier(0);
}
__device__ __forceinline__ void store8(bf16_t* p, f32x4 a, f32x4 b) {
    u32x4 w; w.x = cvt_pk_bf16(a[0], a[1]); w.y = cvt_pk_bf16(a[2], a[3]); w.z = cvt_pk_bf16(b[0], b[1]); w.w = cvt_pk_bf16(b[2], b[3]);
    *(u32x4*)p = w;
}
__device__ __forceinline__ float sigm(float x) { return __builtin_amdgcn_rcpf(1.0f + __builtin_amdgcn_exp2f(-1.4426950408889634f * x)); }
__device__ __forceinline__ f32x4 sigm4(f32x4 x) { f32x4 r; r[0] = sigm(x[0]); r[1] = sigm(x[1]); r[2] = sigm(x[2]); r[3] = sigm(x[3]); return r; }

struct EpiRes {
    static constexpr bool PERM = true, AFTER_DRAIN = false;
    bf16_t* xb; float* SS; int dry;
    __device__ __forceinline__ void operator()(const f32x4 (&acc)[2][2][4][2], const Unit& u, int wr, int wc, int fr, int fq) const {
        const int col0 = u.pn * BM + wc * 32 + 8 * fq;
#pragma unroll
        for (int ai = 0; ai < 2; ++ai) {
            u32x4 xw[4][2];
#pragma unroll
            for (int m = 0; m < 4; ++m)
#pragma unroll
                for (int bj = 0; bj < 2; ++bj) xw[m][bj] = *(const u32x4*)(xb + (unsigned)(u.pm * BM + ai * HALF + wr * 64 + m * 16 + fr) * 1024 + col0 + bj * HALF);
            __builtin_amdgcn_sched_barrier(0);
#pragma unroll
            for (int m = 0; m < 4; ++m) {
                const int rl = ai * HALF + wr * 64 + m * 16 + fr;
                const unsigned goff = (unsigned)(u.pm * BM + rl) * 1024 + col0;
                float ss = 0.f;
#pragma unroll
                for (int bj = 0; bj < 2; ++bj) {
                    const u32x4 w = xw[m][bj];
                    f32x4 o0, o1;
                    o0[0] = __builtin_bit_cast(float, w.x << 16) + acc[ai][bj][m][0][0]; o0[1] = __builtin_bit_cast(float, w.x & 0xffff0000u) + acc[ai][bj][m][0][1];
                    o0[2] = __builtin_bit_cast(float, w.y << 16) + acc[ai][bj][m][0][2]; o0[3] = __builtin_bit_cast(float, w.y & 0xffff0000u) + acc[ai][bj][m][0][3];
                    o1[0] = __builtin_bit_cast(float, w.z << 16) + acc[ai][bj][m][1][0]; o1[1] = __builtin_bit_cast(float, w.z & 0xffff0000u) + acc[ai][bj][m][1][1];
                    o1[2] = __builtin_bit_cast(float, w.w << 16) + acc[ai][bj][m][1][2]; o1[3] = __builtin_bit_cast(float, w.w & 0xffff0000u) + acc[ai][bj][m][1][3];
                    if (!dry) store8(xb + goff + bj * HALF, o0, o1);
                    ss += (o0[0] * o0[0] + o0[1] * o0[1]) + (o0[2] * o0[2] + o0[3] * o0[3]) + (o1[0] * o1[0] + o1[1] * o1[1]) + (o1[2] * o1[2] + o1[3] * o1[3]);
                }
                ss += __shfl_xor(ss, 16); ss += __shfl_xor(ss, 32);
                if (fq == 0 && !dry) SS[(unsigned)(u.pn * 4 + wc) * MT + u.pm * BM + rl] = ss;
                if (dry) asm volatile("" :: "v"(ss));
            }
        }
    }
};
struct EpiSwiGLU {
    static constexpr bool PERM = true, AFTER_DRAIN = false;
    bf16_t* H; const float* SS;
    __device__ __forceinline__ void operator()(const f32x4 (&acc)[2][2][4][2], const Unit& u, int wr, int wc, int fr, int fq) const {
        const int row0 = u.pm * BM + wr * 64 + fr, col0 = u.pn * 128 + wc * 32 + 8 * fq;
        float r8[8]; rows_rs8(SS, row0, fq, r8);
#pragma unroll
        for (int ai = 0; ai < 2; ++ai)
#pragma unroll
            for (int m = 0; m < 4; ++m) {
                const int row = row0 + ai * HALF + m * 16; const float r = r8[ai * 4 + m];
                const f32x4 g0 = acc[ai][0][m][0] * r, g1 = acc[ai][0][m][1] * r, u0 = acc[ai][1][m][0] * r, u1 = acc[ai][1][m][1] * r;
                store8(H + (unsigned)row * 2816 + col0, g0 * sigm4(g0) * u0, g1 * sigm4(g1) * u1);
            }
    }
};
struct EpiInProj {
    static constexpr bool PERM = true, AFTER_DRAIN = false;
    const float* SS; const float* TAB; bf16_t *UP, *Q, *K, *V, *UC; float *kP, *kS, *vP, *vS;
    __device__ __forceinline__ void operator()(const f32x4 (&acc)[2][2][4][2], const Unit& u, int wr, int wc, int fr, int fq) const {
        const int pn = u.pn; const bool smp = (u.pm >= 64);
        const int row0 = u.pm * BM + wr * 64 + fr, cw = wc * 32 + 8 * fq;
        float r8[8]; rows_rs8(SS, row0, fq, r8);
        if (pn == 0) {
#pragma unroll
            for (int ai = 0; ai < 2; ++ai)
#pragma unroll
                for (int m = 0; m < 4; ++m) { const int row = row0 + ai * HALF + m * 16; const float r = r8[ai * 4 + m];
#pragma unroll
                    for (int bj = 0; bj < 2; ++bj) store8(UP + (unsigned)row * 256 + bj * HALF + cw, acc[ai][bj][m][0] * r, acc[ai][bj][m][1] * r); }
        } else if (pn <= 4) {
            const bool isq = pn <= 2; const int t2 = (pn - 1) & 1, j = 4 * (wc & 1) + fq;
#pragma unroll
            for (int ai = 0; ai < 2; ++ai) {
                f32x4 csv[4], snv[4];
#pragma unroll
                for (int m = 0; m < 4; ++m) { const int row = row0 + ai * HALF + m * 16; const int pos = smp ? 2048 + ((row - MP) & 31) : (row & 2047);
                    csv[m] = *(const f32x4*)(TAB + pos * 64 + 4 * j); snv[m] = *(const f32x4*)(TAB + pos * 64 + 32 + 4 * j); }
                __builtin_amdgcn_sched_barrier(0);
#pragma unroll
                for (int m = 0; m < 4; ++m) { const int row = row0 + ai * HALF + m * 16; const float r = r8[ai * 4 + m];
                    const f32x4 cs = csv[m], sn = snv[m];
#pragma unroll
                    for (int bj = 0; bj < 2; ++bj) { const int grp = t2 * 4 + bj * 2 + (wc >> 1);
                        const f32x4 x1 = acc[ai][bj][m][0] * r, x2 = acc[ai][bj][m][1] * r;
                        const f32x4 o1 = x1 * cs - x2 * sn, o2 = x2 * cs + x1 * sn;
                        const unsigned bo = (unsigned)row * 512 + grp * 64 + 32 * (wc & 1) + 8 * fq;
                        if (isq) store8(Q + bo, o1 * QC2, o2 * QC2);
                        else { store8(K + bo, o1, o2);
                            float* kf = (smp ? kS + (unsigned)(row - MP) * 512 : kP + (unsigned)row * 512) + grp * 64 + 4 * j;
                            *(f32x4*)kf = o1; *(f32x4*)(kf + 32) = o2; } } } }
        } else if (pn <= 6) {
#pragma unroll
            for (int ai = 0; ai < 2; ++ai)
#pragma unroll
                for (int m = 0; m < 4; ++m) { const int row = row0 + ai * HALF + m * 16; const float r = r8[ai * 4 + m];
#pragma unroll
                    for (int bj = 0; bj < 2; ++bj) { const int col = (pn - 5) * 256 + bj * HALF + cw;
                        const f32x4 v0 = acc[ai][bj][m][0] * r, v1 = acc[ai][bj][m][1] * r;
                        store8(V + (unsigned)row * 512 + col, v0, v1);
                        float* vf = (smp ? vS + (unsigned)(row - MP) * 512 : vP + (unsigned)row * 512) + col;
                        *(f32x4*)vf = v0; *(f32x4*)(vf + 4) = v1; } }
        } else {
            const int T = pn - 7;
#pragma unroll
            for (int ai = 0; ai < 2; ++ai)
#pragma unroll
                for (int m = 0; m < 4; ++m) { const int row = row0 + ai * HALF + m * 16; const float r = r8[ai * 4 + m];
                    const f32x4 a0 = acc[ai][0][m][0] * r, a1 = acc[ai][0][m][1] * r, b0 = acc[ai][1][m][0] * r, b1 = acc[ai][1][m][1] * r;
                    store8(UC + (unsigned)row * 256 + T * 128 + cw, a0 * sigm4(b0), a1 * sigm4(b1)); }
        }
    }
};
}
#include <hip/hip_bf16.h>
#include <cmath>
namespace attn_body {
using bf16=__hip_bfloat16;
using bf16x8=__attribute__((ext_vector_type(8)))short;
using s16x4=__attribute__((ext_vector_type(4)))short;
using f32x16=__attribute__((ext_vector_type(16)))float;
using u32x4=__attribute__((ext_vector_type(4)))unsigned;
constexpr int BATCH=8,NHEAD=8,SEQ=2048,D=64,DM=512;
constexpr int NW=8,QBLK=32,QB=QBLK*NW,KVBLK=64,NQB=SEQ/QB;
constexpr int ATTN_PITCH=DM, ATTN_UNIT_ROWS=QB;
__device__ __forceinline__ int crow(int r,int hi){return (r&3)+8*(r>>2)+4*hi;}
#define SBAR() __builtin_amdgcn_sched_barrier(0)
__device__ __forceinline__ void cmask(f32x16&p0,f32x16&p1,int jb,int wid){
  if(jb>(wid>>1)){ const float NEG=-INFINITY;
  #pragma unroll
  for(int r=0;r<16;++r){p0[r]=NEG;p1[r]=NEG;} }
}

constexpr int NSLOT=3, SLOTB=8192;
constexpr int LDS_K=0, LDS_V=NSLOT*SLOTB, LDS_WS=2*NSLOT*SLOTB, LDS_OST=LDS_WS+NW*64*4, LDS_BYTES=LDS_OST+NW*4096;
constexpr float C2=0.125f*1.4426950408889634f;
__device__ __forceinline__ void glds16(const void*gsrc,unsigned lds_dst){unsigned keep;
  asm volatile("s_mov_b32 %0, m0\n\ts_mov_b32 m0, %2\n\ts_nop 0\n\tglobal_load_lds_dwordx4 %1, off\n\ts_mov_b32 m0, %0":"=&s"(keep):"v"(gsrc),"s"(lds_dst):"memory");}
__device__ __forceinline__ float max3f(float a,float b,float c){float r;asm("v_max3_f32 %0, %1, %2, %3":"=v"(r):"v"(a),"v"(b),"v"(c));return r;}
__device__ __forceinline__ float max2f(float a,float b){float r;asm("v_max_f32_e32 %0, %1, %2":"=v"(r):"v"(a),"v"(b));return r;}
__device__ __forceinline__ float fadd_s(float a,float b){float r;asm("v_add_f32_e32 %0, %1, %2":"=v"(r):"v"(a),"v"(b));return r;}
__device__ __forceinline__ float fsub_s(float a,float b){float r;asm("v_sub_f32_e32 %0, %1, %2":"=v"(r):"v"(a),"v"(b));return r;}
typedef float f32x2_t __attribute__((ext_vector_type(2))); typedef __bf16 bf16x2_t __attribute__((ext_vector_type(2)));
__device__ __forceinline__ unsigned cvtpk_s(float lo,float hi){f32x2_t v={lo,hi};bf16x2_t b=__builtin_convertvector(v,bf16x2_t);return __builtin_bit_cast(unsigned,b);}
#define WAIT_BAR(N) asm volatile("s_waitcnt vmcnt(" #N ") lgkmcnt(0)\n\ts_barrier":::"memory")

__device__ __forceinline__ void qkt(f32x16&p0,f32x16&p1,const char*Kslot,const bf16x8*qr,const f32x16&negm,int r32,int hi){
  const char*kb=Kslot+hi*1024+r32*16;
  #pragma unroll
  for(int d0=0;d0<4;++d0){
    const bf16x8 b0=*reinterpret_cast<const bf16x8*>(kb+d0*2048);
    const bf16x8 b1=*reinterpret_cast<const bf16x8*>(kb+d0*2048+512);
    if(d0==0){p0=__builtin_amdgcn_mfma_f32_32x32x16_bf16(b0,qr[0],negm,0,0,0);p1=__builtin_amdgcn_mfma_f32_32x32x16_bf16(b1,qr[0],negm,0,0,0);}
    else{p0=__builtin_amdgcn_mfma_f32_32x32x16_bf16(b0,qr[d0],p0,0,0,0);p1=__builtin_amdgcn_mfma_f32_32x32x16_bf16(b1,qr[d0],p1,0,0,0);}}
}
typedef __attribute__((address_space(3))) const char* lds_cptr;
typedef short v4i16_t __attribute__((ext_vector_type(4)));
__device__ __forceinline__ void kload8(bf16x8*kf,lds_cptr kp){
  kf[0]=*(const __attribute__((address_space(3))) bf16x8*)(kp);      kf[1]=*(const __attribute__((address_space(3))) bf16x8*)(kp+512);
  kf[2]=*(const __attribute__((address_space(3))) bf16x8*)(kp+2048); kf[3]=*(const __attribute__((address_space(3))) bf16x8*)(kp+2560);
  kf[4]=*(const __attribute__((address_space(3))) bf16x8*)(kp+4096); kf[5]=*(const __attribute__((address_space(3))) bf16x8*)(kp+4608);
  kf[6]=*(const __attribute__((address_space(3))) bf16x8*)(kp+6144); kf[7]=*(const __attribute__((address_space(3))) bf16x8*)(kp+6656);
}
__device__ __forceinline__ void kload2(bf16x8*kf,lds_cptr kp,int j){ kf[2*j]=*(const __attribute__((address_space(3))) bf16x8*)(kp+j*2048); kf[2*j+1]=*(const __attribute__((address_space(3))) bf16x8*)(kp+j*2048+512); }
__device__ __forceinline__ s16x4 vtr(lds_cptr p){ return __builtin_bit_cast(s16x4,__builtin_amdgcn_ds_read_tr16_b64_v4i16((__attribute__((address_space(3))) v4i16_t*)p)); }
__device__ __forceinline__ float rowmax(const f32x16&p0,const f32x16&p1){
  float a=max3f(p0[0],p0[1],p1[0]),b=max3f(p0[2],p0[3],p1[1]);a=max3f(a,p1[2],p1[3]);
  #pragma unroll
  for(int r=4;r<16;r+=4){a=max3f(a,p0[r],p0[r+1]);b=max3f(b,p0[r+2],p0[r+3]);a=max3f(a,p1[r],p1[r+1]);b=max3f(b,p1[r+2],p1[r+3]);}
  const float m=max2f(a,b);
  auto rr=__builtin_amdgcn_permlane32_swap(__float_as_uint(m),__float_as_uint(m),false,false);
  return max2f(__uint_as_float(rr[0]),__uint_as_float(rr[1]));
}
__device__ __forceinline__ void pv(f32x16*o,int vb,bf16x8 pa0,bf16x8 pa1,bf16x8 pa2,bf16x8 pa3){
  #pragma unroll
  for(int d0=0;d0<2;++d0){s16x4 lo[4],hi[4];
    #pragma unroll
    for(int ks=0;ks<4;++ks){
      asm volatile("ds_read_b64_tr_b16 %0,%1 offset:%c2":"=&v"(lo[ks]):"v"(vb),"i"(d0*4096+ks*1024):"memory");
      asm volatile("ds_read_b64_tr_b16 %0,%1 offset:%c2":"=&v"(hi[ks]):"v"(vb),"i"(d0*4096+ks*1024+512):"memory");}
    asm volatile("s_waitcnt lgkmcnt(0)":::"memory");SBAR();
    #define PK(k) (bf16x8){lo[k][0],lo[k][1],lo[k][2],lo[k][3],hi[k][0],hi[k][1],hi[k][2],hi[k][3]}
    o[d0]=__builtin_amdgcn_mfma_f32_32x32x16_bf16(pa0,PK(0),o[d0],0,0,0);
    o[d0]=__builtin_amdgcn_mfma_f32_32x32x16_bf16(pa1,PK(1),o[d0],0,0,0);
    o[d0]=__builtin_amdgcn_mfma_f32_32x32x16_bf16(pa2,PK(2),o[d0],0,0,0);
    o[d0]=__builtin_amdgcn_mfma_f32_32x32x16_bf16(pa3,PK(3),o[d0],0,0,0);
    #undef PK
  }
}

#ifndef ATTN_STORE16
#define ATTN_STORE16(p,v) (*(u32x4*)(p)=(v))
#endif
template<int THRL> __device__ __forceinline__ void attn_unit(int b,int h,int hv,int qb,const bf16*Q,const bf16*__restrict__ K,const bf16*__restrict__ V,bf16*O,int ocol,char*shm){
  int tid_l=threadIdx.x; asm volatile("":"+v"(tid_l)); const int tid=tid_l,lane=tid&63,r32=lane&31,hi=lane>>5; const int wid=__builtin_amdgcn_readfirstlane(tid>>6);
  const long rowbase=(long)b*SEQ; const int q0=qb*QB;
  const bf16*Qw=Q+(rowbase+q0+wid*QBLK)*DM+h*D;
  const bf16*Kh=K+rowbase*DM+h*D,*Vh=V+rowbase*DM+hv*D;
  const unsigned lds0=(unsigned)(uintptr_t)shm;
  float*wsf=(float*)(shm+LDS_WS)+wid*64;
  const bf16*ksrc=Kh+(long)lane*DM+wid*8;
  const bf16*vsrc=Vh+(long)(16*(wid&3)+(lane>>2))*DM+(wid>>2)*32+(lane&3)*8;
  const unsigned kdst=lds0+LDS_K+wid*1024, vdst=lds0+LDS_V+wid*1024;
  #define DMA_K(t,slot) glds16(ksrc+(long)(t)*KVBLK*DM,(unsigned)__builtin_amdgcn_readfirstlane(kdst+(slot)))
  #define DMA_V(t,slot) glds16(vsrc+(long)(t)*KVBLK*DM,(unsigned)__builtin_amdgcn_readfirstlane(vdst+(slot)))
  const int vb0=(int)(lds0+LDS_V)+((lane>>4)&1)*32+(lane&3)*8+(4*hi+((lane&15)>>2))*64;
  const char*Kbase=shm+LDS_K; bf16x8 kf[8];
  const lds_cptr shm3=(lds_cptr)shm; const lds_cptr kp0=shm3+LDS_K+hi*1024+r32*16; const lds_cptr vp0=shm3+LDS_V+((lane>>4)&1)*32+(lane&3)*8+(4*hi+((lane&15)>>2))*64;
  const int NT=(q0+QB)/KVBLK;
  DMA_K(0,0);DMA_V(0,0);DMA_K(1,SLOTB);
  bf16x8 qr[4];
  #pragma unroll
  for(int d0=0;d0<4;++d0)qr[d0]=*reinterpret_cast<const bf16x8*>(&Qw[(long)r32*DM+d0*16+hi*8]);
  float mhat=0.f,l_reg=0.f;f32x16 o[2];o[0]=f32x16{};o[1]=f32x16{};f32x16 negm=f32x16{};asm volatile("":"+v"(negm));
  const int qrel=wid*QBLK+r32;
  #define CMASK(P0,P1,t) do{int jb_=(t)-(NT-4); if(jb_>=0)cmask(P0,P1,jb_,wid);}while(0)
  bool resc=false;
  #define START(P0,P1) do{ const float rm=rowmax(P0,P1); resc=false; \
    { const float dl=rm; mhat=fadd_s(mhat,dl); \
      _Pragma("unroll") for(int r=0;r<16;++r){P0[r]=fsub_s(P0[r],dl);P1[r]=fsub_s(P1[r],dl);} \
      _Pragma("unroll") for(int r=0;r<16;++r)negm[r]=-mhat; asm volatile("":"+v"(negm)); } \
    _Pragma("unroll") for(int r=0;r<16;++r)P0[r]=__builtin_amdgcn_exp2f(P0[r]); }while(0)
  #define RESC() do{ if(resc){ asm volatile("s_waitcnt lgkmcnt(0)":::"memory"); \
      _Pragma("unroll") for(int d_=0;d_<2;++d_) _Pragma("unroll") for(int r=0;r<16;++r)o[d_][r]*=wsf[crow(r,hi)]; } }while(0)
  f32x16 pA0,pA1,pB0,pB1;
  int sl_prev=0,sl_cur=0,sl_next=SLOTB;
  #define ROT() do{sl_prev=sl_cur;sl_cur=sl_next;sl_next=(sl_next==(NSLOT-1)*SLOTB)?0:sl_next+SLOTB;}while(0)
  DMA_K(2,2*SLOTB);
  WAIT_BAR(3);
  qkt(pA0,pA1,Kbase,qr,negm,r32,hi);asm volatile("s_nop 15\n\ts_nop 7":"+v"(pA0),"+v"(pA1));CMASK(pA0,pA1,0);
  START(pA0,pA1);
  _Pragma("unroll") for(int r=0;r<16;++r)pA1[r]=__builtin_amdgcn_exp2f(pA1[r]);
  WAIT_BAR(0);
  DMA_K(3,0);DMA_V(1,SLOTB);
  ROT();
  kload8(kf,kp0+sl_cur);
  WAIT_BAR(2);
  s16x4 vlo[8],vhi[8]; u32x4 pw0,pw1,pw2,pw3;
  #define PKW(P,B) cvtpk_s(P[B],P[B+1])
  #define PAF(k) __builtin_bit_cast(bf16x8,pw##k)
  #define VFR(i) (bf16x8){vlo[i][0],vlo[i][1],vlo[i][2],vlo[i][3],vhi[i][0],vhi[i][1],vhi[i][2],vhi[i][3]}
  #define PIN(x) asm volatile("":"+v"(x))
  #define MX3(a,b,c) __builtin_fmaxf(__builtin_fmaxf((a),(b)),(c))
  #define GAPA(MF,A0,A1,A2,A3,W0,W1,PW) do{ MF; sacc+=A0; sacc+=A1; sacc+=A2; sacc+=A3; PIN(sacc); W0; W1; PIN(PW); SBAR(); }while(0)
  #define EX(v) __builtin_amdgcn_exp2f(v)
  #define GAPB(MF,X,B) do{ MF; X[B]=EX(X[B]); X[B+1]=EX(X[B+1]); X[B+2]=EX(X[B+2]); X[B+3]=EX(X[B+3]); PIN(X); SBAR(); }while(0)
  #define VRD(i) do{ vlo[i]=vtr(vp_+(((i)>>2)*4096+((i)&3)*1024)); vhi[i]=vtr(vp_+(((i)>>2)*4096+((i)&3)*1024+512)); }while(0)
  #define KRD(G,j) do{ if(G){ kload2(kf,kp0+sl_next,j); SBAR(); } }while(0)
  #define STEP(C0,C1,P0,P1,t,GK,GV,GL) do{ SBAR(); \
    const lds_cptr vp_=vp0+sl_prev; \
    VRD(0); SBAR(); float sacc=(P0[0]+P0[1]); \
    GAPA(C0=__builtin_amdgcn_mfma_f32_32x32x16_bf16(kf[0],qr[0],negm,0,0,0), P0[2],P0[3],P0[4],P0[5],     pw0[0]=PKW(P0,0), pw0[1]=PKW(P0,2), pw0); \
    VRD(4); SBAR(); GAPA(C1=__builtin_amdgcn_mfma_f32_32x32x16_bf16(kf[1],qr[0],negm,0,0,0), P0[6],P0[7],P0[8],P0[9],     pw0[2]=PKW(P0,4), pw0[3]=PKW(P0,6), pw0); \
    VRD(1); SBAR(); GAPA(C0=__builtin_amdgcn_mfma_f32_32x32x16_bf16(kf[2],qr[1],C0,0,0,0),   P0[10],P0[11],P0[12],P0[13], pw1[0]=PKW(P0,8), pw1[1]=PKW(P0,10), pw1); \
    VRD(5); SBAR(); GAPA(C1=__builtin_amdgcn_mfma_f32_32x32x16_bf16(kf[3],qr[1],C1,0,0,0),   P0[14],P0[15],P1[0],P1[1],   pw1[2]=PKW(P0,12),pw1[3]=PKW(P0,14), pw1); \
    VRD(2); SBAR(); GAPA(C0=__builtin_amdgcn_mfma_f32_32x32x16_bf16(kf[4],qr[2],C0,0,0,0),   P1[2],P1[3],P1[4],P1[5],     pw2[0]=PKW(P1,0), pw2[1]=PKW(P1,2), pw2); \
    VRD(6); SBAR(); GAPA(C1=__builtin_amdgcn_mfma_f32_32x32x16_bf16(kf[5],qr[2],C1,0,0,0),   P1[6],P1[7],P1[8],P1[9],     pw2[2]=PKW(P1,4), pw2[3]=PKW(P1,6), pw2); \
    VRD(3); SBAR(); GAPA(C0=__builtin_amdgcn_mfma_f32_32x32x16_bf16(kf[6],qr[3],C0,0,0,0),   P1[10],P1[11],P1[12],P1[13], pw3[0]=PKW(P1,8), pw3[1]=PKW(P1,10), pw3); \
    VRD(7); SBAR(); GAPA(C1=__builtin_amdgcn_mfma_f32_32x32x16_bf16(kf[7],qr[3],C1,0,0,0),   P1[14],P1[15],0.f,0.f,       pw3[2]=PKW(P1,12),pw3[3]=PKW(P1,14), pw3); \
    l_reg+=sacc; \
    if(GK){DMA_K((t)+3,sl_cur);} if(GV){DMA_V((t)+1,sl_next);} \
    CMASK(C0,C1,t); \
    { float a=MX3(C0[0],C0[1],C1[0]),b=MX3(C0[2],C0[3],C1[1]); a=MX3(a,C1[2],C1[3]); \
      _Pragma("unroll") for(int r=4;r<16;r+=4){a=MX3(a,C0[r],C0[r+1]);b=MX3(b,C0[r+2],C0[r+3]);a=MX3(a,C1[r],C1[r+1]);b=MX3(b,C1[r+2],C1[r+3]);} \
      float rm=__builtin_fmaxf(a,b); { auto rr=__builtin_amdgcn_permlane32_swap(__float_as_uint(rm),__float_as_uint(rm),false,false); rm=__builtin_fmaxf(__uint_as_float(rr[0]),__uint_as_float(rr[1])); } \
      resc=false; \
      if(__builtin_expect(__any(rm>(float)THRL),0)){ const float dl=__builtin_fmaxf(rm,0.f); mhat+=dl; \
        _Pragma("unroll") for(int r=0;r<16;++r){C0[r]-=dl;C1[r]-=dl;} \
        _Pragma("unroll") for(int r=0;r<16;++r)negm[r]=-mhat; asm volatile("":"+v"(negm)); \
        const float f=__builtin_amdgcn_exp2f(-dl); l_reg*=f; if(hi==0)wsf[r32]=f; resc=true; } } \
    SBAR(); \
    GAPB(o[0]=__builtin_amdgcn_mfma_f32_32x32x16_bf16(PAF(0),VFR(0),o[0],0,0,0), C0,0); \
    GAPB(o[1]=__builtin_amdgcn_mfma_f32_32x32x16_bf16(PAF(0),VFR(4),o[1],0,0,0), C0,4); \
    KRD(GL,0); GAPB(o[0]=__builtin_amdgcn_mfma_f32_32x32x16_bf16(PAF(1),VFR(1),o[0],0,0,0), C0,8); \
    KRD(GL,1); GAPB(o[1]=__builtin_amdgcn_mfma_f32_32x32x16_bf16(PAF(1),VFR(5),o[1],0,0,0), C0,12); \
    KRD(GL,2); GAPB(o[0]=__builtin_amdgcn_mfma_f32_32x32x16_bf16(PAF(2),VFR(2),o[0],0,0,0), C1,0); \
    KRD(GL,3); GAPB(o[1]=__builtin_amdgcn_mfma_f32_32x32x16_bf16(PAF(2),VFR(6),o[1],0,0,0), C1,4); \
    GAPB(o[0]=__builtin_amdgcn_mfma_f32_32x32x16_bf16(PAF(3),VFR(3),o[0],0,0,0), C1,8); \
    GAPB(o[1]=__builtin_amdgcn_mfma_f32_32x32x16_bf16(PAF(3),VFR(7),o[1],0,0,0), C1,12); \
    }while(0)
  int t=1;
  #undef CMASK
  #define CMASK(P0,P1,t) do{}while(0)
  for(;t+5<NT;t+=2){
    STEP(pB0,pB1,pA0,pA1,t,true,true,true);     WAIT_BAR(2); RESC(); ROT();
    STEP(pA0,pA1,pB0,pB1,t+1,true,true,true);   WAIT_BAR(2); RESC(); ROT();
  }
  #undef CMASK
  #define CMASK(P0,P1,t) do{int jb_=(t)-(NT-4); if(jb_>=0)cmask(P0,P1,jb_,wid);}while(0)
  #define ENDW(tt) do{ if((tt)+3<NT){WAIT_BAR(2);} else if((tt)+2<NT){WAIT_BAR(1);} else {WAIT_BAR(0);} }while(0)
  for(;t+1<NT;t+=2){
    STEP(pB0,pB1,pA0,pA1,t,(t+3<NT),(t+1<NT),(t+1<NT));       ENDW(t);   RESC(); ROT();
    STEP(pA0,pA1,pB0,pB1,t+1,(t+4<NT),(t+2<NT),(t+2<NT));     ENDW(t+1); RESC(); ROT();
  }
  STEP(pB0,pB1,pA0,pA1,NT-1,false,false,false); RESC();
  { float sacc=pB0[0]+pB0[1]; _Pragma("unroll") for(int r=2;r<16;++r)sacc+=pB0[r]; _Pragma("unroll") for(int r=0;r<16;++r)sacc+=pB1[r]; l_reg+=sacc;
    pw0=(u32x4){PKW(pB0,0),PKW(pB0,2),PKW(pB0,4),PKW(pB0,6)};pw1=(u32x4){PKW(pB0,8),PKW(pB0,10),PKW(pB0,12),PKW(pB0,14)};pw2=(u32x4){PKW(pB1,0),PKW(pB1,2),PKW(pB1,4),PKW(pB1,6)};pw3=(u32x4){PKW(pB1,8),PKW(pB1,10),PKW(pB1,12),PKW(pB1,14)};
    SBAR(); pv(o,vb0+sl_cur,PAF(0),PAF(1),PAF(2),PAF(3)); }
  #undef PKW
  #undef PAF
  #undef VFR
  #undef PIN
  #undef MX3
  #undef GAPA
  #undef GAPB
  #undef EX
  #undef VRD
  #undef KRD
  #undef STEP
  #undef ENDW
  {auto rr=__builtin_amdgcn_permlane32_swap(__float_as_uint(l_reg),__float_as_uint(l_reg),false,false);l_reg=__uint_as_float(rr[0])+__uint_as_float(rr[1]);}
  if(hi==0)wsf[32+r32]=l_reg;asm volatile("s_waitcnt lgkmcnt(0)":::"memory");
  float rli[16];
  #pragma unroll
  for(int r=0;r<16;++r)rli[r]=__builtin_amdgcn_rcpf(wsf[32+crow(r,hi)]);
  bf16*Ow=O+(rowbase+q0+wid*QBLK)*1024+ocol;
  { bf16*stg=(bf16*)(shm+LDS_OST)+wid*2048;
    #pragma unroll
    for(int r=0;r<16;++r){const int orow=crow(r,hi);
      #pragma unroll
      for(int d0=0;d0<2;++d0)stg[orow*64+d0*32+r32]=__float2bfloat16(o[d0][r]*rli[r]);}
    asm volatile("s_waitcnt lgkmcnt(0)":::"memory");
    #pragma unroll
    for(int i=0;i<4;++i){const int row=i*8+(lane>>3),ch=lane&7; const u32x4 v=*(const u32x4*)(stg+row*64+ch*8); ATTN_STORE16(Ow+(long)row*1024+ch*8,v);} }
  asm volatile("s_waitcnt lgkmcnt(0)\n\ts_barrier":::"memory");
  #undef DMA_K
  #undef DMA_V
  #undef CMASK
  #undef START
  #undef RESC
  #undef ROT
}
constexpr int ATTN_LDS_BYTES=LDS_BYTES;
#undef SBAR
#undef WAIT_BAR
}
#ifndef MK_MULTI
#define MK_MULTI 0
#endif
#ifndef REP_SYNC
#define REP_SYNC 0
#endif
#ifndef REP_FOLD
#define REP_FOLD 1
#endif
#ifndef REP_SLACK
#define REP_SLACK 1
#endif
#ifndef SLACK_W
#define SLACK_W 1
#endif
constexpr int NWAVES = 8, NPH = 14;
constexpr int MT = pg8::MT, MP = pg8::MP, DM_ = 1024, INW = 2304, DFF = 2816;
constexpr size_t MiB = 1u << 20;
constexpr size_t WS_TAB = 1 * MiB;
constexpr size_t WS_LAM = 2 * MiB;
constexpr size_t WS_SS = 3 * MiB;
constexpr size_t WS_WIN = 5 * MiB, WS_WOUT = 14 * MiB, WS_WGU = 18 * MiB, WS_WDN = 40 * MiB;
constexpr size_t WS_XB = 52 * MiB;
constexpr size_t WS_SPO = 86 * MiB;
constexpr size_t WS_SPM = 95 * MiB;
constexpr size_t WS_Q = 96 * MiB, WS_K = 113 * MiB, WS_V = 130 * MiB, WS_UP = 147 * MiB, WS_UC = 156 * MiB, WS_O4 = 165 * MiB, WS_MIX = 197 * MiB;
constexpr size_t WS_H = 96 * MiB;
constexpr size_t WS_END = 230 * MiB;
static_assert(WS_H + (size_t)MT * DFF * 2 <= WS_MIX && WS_MIX + (size_t)MT * 1024 * 2 <= WS_END, "ws map");
constexpr size_t O_Y = 0, O_KP = 17039360, O_VP = 33816576, O_PP = 50593792, O_CP = 50655232, O_KS = 50778112, O_VS = 51040256, O_PS = 51302400, O_CS = 51363840, O_END = 51486720;
constexpr int LDS_BYTES = 147456;

#define LAS __attribute__((address_space(3)))
typedef unsigned short bf16;
typedef unsigned v4u __attribute__((ext_vector_type(4)));
typedef unsigned v2u __attribute__((ext_vector_type(2)));
typedef float f32x4 __attribute__((ext_vector_type(4)));
typedef float f32x16 __attribute__((ext_vector_type(16)));
typedef short bf16x8 __attribute__((ext_vector_type(8)));
__device__ __forceinline__ unsigned f2bf(float f) { unsigned u = __builtin_bit_cast(unsigned, f); return (u + 0x7fffu + ((u >> 16) & 1u)) >> 16; }
__device__ __forceinline__ unsigned pk2(float lo, float hi) { return f2bf(lo) | (f2bf(hi) << 16); }
__device__ __forceinline__ float bflo(unsigned w) { return __builtin_bit_cast(float, w << 16); }
__device__ __forceinline__ float bfhi(unsigned w) { return __builtin_bit_cast(float, w & 0xffff0000u); }
__device__ __forceinline__ float wave_sum(float v) {
#pragma unroll
    for (int o = 1; o < 64; o <<= 1) v += __shfl_xor(v, o);
    return v;
}
struct Args { const float* in[22]; float* out; unsigned char* ws; int ph_lo, ph_hi; };
struct Frame { int tid, lane, wave, vcu, G, gw, NGW; };

#define XB_TMO      128
#define XB_XCNT(j)  (256  + 64 * (j))
#define XB_XSUB(j)  (1280 + 64 * (j))
#define XB_XGEN(j)  (2304 + 64 * (j))
#define XB_TOP      3328
#define XB_TOPGEN   3392
#define XCD_BAR_WORDS 3456
#define XB_SPIN_CAP (1u << 18)

__device__ __forceinline__ unsigned xb_ld(unsigned* p)              { return __hip_atomic_load(p, __ATOMIC_RELAXED, __HIP_MEMORY_SCOPE_AGENT); }
__device__ __forceinline__ unsigned xb_add(unsigned* p, unsigned v) { return __hip_atomic_fetch_add(p, v, __ATOMIC_RELAXED, __HIP_MEMORY_SCOPE_AGENT); }
__device__ __forceinline__ unsigned xb_xcc_id() { return (unsigned)__builtin_amdgcn_s_getreg((3 << 11) | 20) & 0xFu; }
#define XB_SPIN(cond, bar) do { unsigned _sp = 0; while (cond) { __builtin_amdgcn_s_sleep(1); \
    if ((++_sp & 255u) == 0u) { if (xb_ld(&(bar)[XB_TMO])) break; if (_sp > XB_SPIN_CAP) { atomicAdd(&(bar)[XB_TMO], 1u); break; } } } } while (0)

struct XcdBarrier {
    unsigned* bar; unsigned x;
    volatile LAS unsigned* st;
};

__device__ __forceinline__ XcdBarrier xcd_barrier_post(unsigned* bar, volatile LAS unsigned* st) {
    XcdBarrier b; b.bar = bar; b.x = xb_xcc_id(); b.st = st;
    if (threadIdx.x == 0) (void)xb_add(&bar[XB_XCNT(b.x)], 1u);
    return b;
}
__device__ __forceinline__ void xcd_barrier_complete(unsigned* bar, unsigned x, unsigned& nloc, unsigned& nx) {
    const unsigned G = gridDim.x * gridDim.y * gridDim.z;
    unsigned sum, cnt, mine, sp = 0u;
    for (;;) {
        sum = 0u; cnt = 0u; mine = 0u;
#pragma unroll
        for (unsigned j = 0; j < 16; ++j) { const unsigned c = xb_ld(&bar[XB_XCNT(j)]); sum += c; cnt += (c > 0u) ? 1u : 0u; mine = (j == x) ? c : mine; }
        if (sum == G) break;
        __builtin_amdgcn_s_sleep(1);
        if ((++sp & 255u) == 0u) { if (xb_ld(&bar[XB_TMO])) break; if (sp > XB_SPIN_CAP) { atomicAdd(&bar[XB_TMO], 1u); break; } }
    }
    nloc = mine > 0u ? mine : 1u; nx = cnt > 0u ? cnt : 1u;
}

__device__ __forceinline__ void xcd_barrier(const XcdBarrier& b) {
    asm volatile("s_waitcnt vmcnt(0)" ::: "memory");
    __syncthreads();
    if (threadIdx.x == 0) {
        unsigned* bar = b.bar;
        __builtin_amdgcn_s_waitcnt(0);
        unsigned nloc = b.st[0], nx = b.st[1];
        if (nloc == 0u) { xcd_barrier_complete(bar, b.x, nloc, nx); b.st[0] = nloc; b.st[1] = nx; }
        const unsigned old = xb_add(&bar[XB_XSUB(b.x)], 1u);
        const unsigned gen = old / nloc;
        if (old + 1u == (gen + 1u) * nloc) {
            __builtin_amdgcn_fence(__ATOMIC_RELEASE, "agent");
            asm volatile("s_waitcnt vmcnt(0)" ::: "memory");
            const unsigned og = xb_add(&bar[XB_TOP], 1u);
            const unsigned tg = og / nx;
            if (og + 1u == (tg + 1u) * nx) xb_add(&bar[XB_TOPGEN], 1u);
            else XB_SPIN(xb_ld(&bar[XB_TOPGEN]) == tg, bar);
            __builtin_amdgcn_fence(__ATOMIC_ACQUIRE, "agent");
            xb_add(&bar[XB_XGEN(b.x)], 1u);
            asm volatile("s_waitcnt vmcnt(0)" ::: "memory");
        } else {
            XB_SPIN(xb_ld(&bar[XB_XGEN(b.x)]) == gen, bar);
            __builtin_amdgcn_fence(__ATOMIC_ACQUIRE, "agent");
            asm volatile("s_waitcnt vmcnt(0)" ::: "memory");
        }
    }
    __syncthreads();
}

constexpr int MISC_OFF = 147200;
__device__ __forceinline__ int perm_in(int n) {
    if (n < 256) return n;
    if (n < 1280) { const int p = n & 63, j = p >> 3, nn = (p >> 2) & 1, i = p & 3; return (n & ~63) + 32 * nn + 4 * j + i; }
    if (n < 1792) return n;
    const int x = n - 1792, T = x >> 8, bj = (x >> 7) & 1, cc = x & 127; return 1792 + 256 * bj + 128 * T + cc;
}
__device__ __forceinline__ int perm_gu(int n) { const int T = n >> 8, bj = (n >> 7) & 1, cc = n & 127; return 2816 * bj + 128 * T + cc; }
template <int MODE> __device__ __forceinline__ void transpose_item(const float* W, int ldw, const float* gk, bf16* WT, int ldwt, int koff, int nblk, LAS float* scr, int item, int lane) {
    (void)scr;
    const int kb = item / nblk, nb = item % nblk, k0 = 64 * kb, np = 64 * nb + lane;
    const int src = (MODE == 1) ? perm_in(np) : (MODE == 2) ? perm_gu(np) : np;
    const float* wp = W + (size_t)k0 * ldw + src;
    float v[64];
#pragma unroll
    for (int t = 0; t < 64; ++t) v[t] = wp[(size_t)t * ldw];
    __builtin_amdgcn_sched_barrier(0);
    bf16* op = WT + (size_t)np * ldwt + koff + k0;
#pragma unroll
    for (int kc = 0; kc < 8; ++kc) {
        float g[8];
#pragma unroll
        for (int t = 0; t < 8; ++t) g[t] = gk ? gk[k0 + 8 * kc + t] : 1.0f;
        v4u o; o.x = pg8::cvt_pk_bf16(v[8 * kc] * g[0], v[8 * kc + 1] * g[1]); o.y = pg8::cvt_pk_bf16(v[8 * kc + 2] * g[2], v[8 * kc + 3] * g[3]);
        o.z = pg8::cvt_pk_bf16(v[8 * kc + 4] * g[4], v[8 * kc + 5] * g[5]); o.w = pg8::cvt_pk_bf16(v[8 * kc + 6] * g[6], v[8 * kc + 7] * g[7]);
        *(v4u*)(op + 8 * kc) = o; }
}
__device__ __forceinline__ void fold_item(const float* pool_w, const float* pool_scale, const float* conv_pw, const float* w_out, bf16* WT, LAS float* scr, int item, int lane) {
    const int kb = item >> 4, nb = item & 15, n = nb * 64 + lane;
    float acc[8];
#pragma unroll
    for (int i = 0; i < 8; ++i) acc[i] = 0.f;
    int k0, D, rb;
    if (kb < 32) { k0 = kb * 8; D = 64; const int g = k0 >> 6; rb = 64 * g; const float ps = pool_scale[64 * g + lane];
        float pw[8];
#pragma unroll
        for (int i = 0; i < 8; ++i) pw[i] = pool_w[(size_t)(g * 64 + ((k0 + i) & 63)) * 64 + lane];
        __builtin_amdgcn_sched_barrier(0);
#pragma unroll
        for (int i = 0; i < 8; ++i) scr[i * 64 + lane] = pw[i] * ps;
    } else { k0 = 768 + (kb - 32) * 8; D = 256; rb = 768;
        f32x4 cw[8];
#pragma unroll
        for (int i = 0; i < 8; ++i) cw[i] = *(const f32x4*)(conv_pw + (size_t)(k0 - 768 + i) * 256 + 4 * lane);
        __builtin_amdgcn_sched_barrier(0);
#pragma unroll
        for (int i = 0; i < 8; ++i) *(LAS f32x4*)(scr + i * 256 + 4 * lane) = cw[i];
    }
    asm volatile("s_waitcnt lgkmcnt(0)" ::: "memory");
    const float* wp = w_out + (size_t)rb * 1024 + n;
#pragma unroll 1
    for (int d = 0; d < D; d += 32) {
        float wv[32];
#pragma unroll
        for (int q = 0; q < 32; ++q) wv[q] = wp[(size_t)(d + q) * 1024];
        __builtin_amdgcn_sched_barrier(0);
#pragma unroll
        for (int q = 0; q < 32; q += 4)
#pragma unroll
            for (int i = 0; i < 8; ++i) { const f32x4 cf = *(const LAS f32x4*)(scr + i * D + d + q); acc[i] += (cf.x * wv[q] + cf.y * wv[q + 1]) + (cf.z * wv[q + 2] + cf.w * wv[q + 3]); }
        __builtin_amdgcn_sched_barrier(0);
    }
    asm volatile("s_waitcnt lgkmcnt(0)" ::: "memory");
    v4u o; o.x = pk2(acc[0], acc[1]); o.y = pk2(acc[2], acc[3]); o.z = pk2(acc[4], acc[5]); o.w = pk2(acc[6], acc[7]);
    *(v4u*)(WT + (size_t)n * 1024 + k0) = o;
}
constexpr int WI_A = 576, WI_B = 3840, WI_C = 5568, WI_END = 7680;
__device__ __forceinline__ void wi_in(const Args& A, LAS float* scr, int lane, int l, int it) { transpose_item<1>(A.in[7] + (size_t)l * 1024 * INW, INW, A.in[6] + l * 1024, (bf16*)(A.ws + WS_WIN) + (size_t)l * INW * 1024, 1024, 0, INW / 64, scr, it, lane); }
__device__ __forceinline__ void wi_gu(const Args& A, LAS float* scr, int lane, int l, int it) { transpose_item<2>(A.in[19] + (size_t)l * 1024 * 2 * DFF, 2 * DFF, A.in[18] + l * 1024, (bf16*)(A.ws + WS_WGU) + (size_t)l * 2 * DFF * 1024, 1024, 0, 2 * DFF / 64, scr, it, lane); }
__device__ __forceinline__ void wi_dn(const Args& A, LAS float* scr, int lane, int l, int it) { transpose_item<0>(A.in[20] + (size_t)l * DFF * 1024, 1024, nullptr, (bf16*)(A.ws + WS_WDN) + (size_t)l * 1024 * DFF, DFF, 0, 1024 / 64, scr, it, lane); }
__device__ __forceinline__ void wi_mid(const Args& A, LAS float* scr, int lane, int l, int it) { transpose_item<0>(A.in[17] + (size_t)l * 1024 * 1024 + 256 * 1024, 1024, nullptr, (bf16*)(A.ws + WS_WOUT) + (size_t)l * 1024 * 1024, 1024, 256, 1024 / 64, scr, it, lane); }
__device__ __forceinline__ void wi_fold(const Args& A, LAS float* scr, int lane, int l, int it) { fold_item(A.in[8] + (size_t)l * 4 * 64 * 64, A.in[9] + l * 256, A.in[16] + (size_t)l * 256 * 256, A.in[17] + (size_t)l * 1024 * 1024, (bf16*)(A.ws + WS_WOUT) + (size_t)l * 1024 * 1024, scr, it, lane); }
__device__ __forceinline__ void weight_items(const Args& A, LAS float* scr, int lane, int first, int last, int w0, int nw) {
#pragma unroll 1
    for (int idx = first + w0; idx < last; idx += nw) {
        if (idx < WI_A) wi_in(A, scr, lane, 0, idx);
        else if (idx < WI_B) { const int a = idx - WI_A; if (a < 1408) wi_gu(A, scr, lane, 0, a); else if (a < 2112) wi_dn(A, scr, lane, 0, a - 1408); else if (a < 2240) wi_mid(A, scr, lane, 0, a - 2112); else wi_fold(A, scr, lane, 0, a - 2240); }
        else if (idx < WI_C) { const int b2 = idx - WI_B; if (b2 < 576) wi_in(A, scr, lane, 1, b2); else if (b2 < 704) wi_mid(A, scr, lane, 1, b2 - 576); else wi_fold(A, scr, lane, 1, b2 - 704); }
        else { const int c2 = idx - WI_C; if (c2 < 1408) wi_gu(A, scr, lane, 1, c2); else wi_dn(A, scr, lane, 1, c2 - 1408); }
    }
}
__device__ __forceinline__ void slack_weights(const Frame& F, const Args& A, LAS unsigned char* lds, int nwg, int first, int last) {
    const int rounds = (nwg + F.G - 1) / F.G, nfull = nwg - (rounds - 1) * F.G, c = (int)blockIdx.x;
    int sl = F.lane; asm volatile("" : "+v"(sl));
    LAS float* scr = (LAS float*)(lds + F.wave * 16640);
    if (nfull >= F.G) weight_items(A, scr, sl, first, last, F.gw, F.NGW);
    else if (c >= nfull) weight_items(A, scr, sl, first, last, (c - nfull) * NWAVES + F.wave, (F.G - nfull) * NWAVES);
    __syncthreads();
}
__device__ __forceinline__ void p0_prologue(const Frame& F, const Args& A, LAS unsigned char* lds) {
    unsigned char* ws = A.ws;
    LAS float* scr = (LAS float*)(lds + F.wave * 16640);
    int lane_l = F.lane; asm volatile("" : "+v"(lane_l)); const int gw = F.gw, NGW = F.NGW, lane = lane_l;
    weight_items(A, scr, lane, 0, SLACK_W ? WI_A : WI_END, gw, NGW);
    { bf16* XB = (bf16*)(ws + WS_XB); float* SS = (float*)(ws + WS_SS);
      for (int m0 = gw * 2; m0 < MT; m0 += NGW * 2) {
        f32x4 v[2][4];
#pragma unroll
        for (int q = 0; q < 2; ++q) { const int m = m0 + q; const float* xr = (m < MP) ? A.in[0] + (size_t)m * 1024 : A.in[1] + (size_t)(m - MP) * 1024;
#pragma unroll
            for (int j = 0; j < 4; ++j) v[q][j] = *((const f32x4*)xr + lane + 64 * j); }
        __builtin_amdgcn_sched_barrier(0);
#pragma unroll
        for (int q = 0; q < 2; ++q) { const int m = m0 + q; float s = 0.f;
#pragma unroll
            for (int j = 0; j < 4; ++j) { const f32x4 w = v[q][j]; s += (w.x * w.x + w.y * w.y) + (w.z * w.z + w.w * w.w);
                v2u o; o.x = pk2(w.x, w.y); o.y = pk2(w.z, w.w); *((v2u*)(XB + (size_t)m * 1024) + lane + 64 * j) = o; }
            s = wave_sum(s);
            if (lane < 16) SS[(size_t)lane * MT + m] = (lane == 0) ? s : 0.f;
            if (m >= MP && lane < 32) SS[(size_t)16 * MT + lane * 256 + (m - MP)] = (lane == 0) ? s : 0.f; }
      } }
    { float* TAB = (float*)(ws + WS_TAB);
      for (int i = gw * 64 + lane; i < 2080 * 32; i += NGW * 64) { const int pos = i >> 5, f = i & 31;
        const float inv = powf(10000.0f, -(float)f / 32.0f); const float ang = (float)pos * inv; float sv, cv; sincosf(ang, &sv, &cv);
        TAB[pos * 64 + f] = cv; TAB[pos * 64 + 32 + f] = sv; } }
    if (gw < 2) { const float* lq = A.in[10] + gw * 256; const float a = wave_sum(lq[lane] * lq[64 + lane]), b = wave_sum(lq[128 + lane] * lq[192 + lane]);
        const float lam_init = 0.8f - 0.6f * expf(-0.3f * (float)gw);
        if (lane == 0) ((float*)(ws + WS_LAM))[gw] = expf(a) - expf(b) + lam_init; }
}

__device__ __forceinline__ int crow(int r, int hi) { return (r & 3) + 8 * (r >> 2) + 4 * hi; }
__device__ __forceinline__ void sample_attn_unit(const Frame& F, const Args& A, int l, int bh, int split, LAS unsigned char* lds) {
    int lane_l = F.lane; asm volatile("" : "+v"(lane_l)); const int b = bh >> 2, h = bh & 3, lane = lane_l, wid = F.wave, r32 = lane & 31, hi = lane >> 5;
    LAS unsigned short* PL = (LAS unsigned short*)lds;
    LAS float* OX = (LAS float*)(lds + 20480);
    LAS float* MB = (LAS float*)(lds + 40960);
    LAS float* LB = MB + 256;
    const bool last = (split == 7), two = last && (wid == 7);
    const int eb = wid & 3, kh = wid >> 2, nks = (last && kh == 1) ? 10 : 8;
    const size_t cro = ((size_t)(l * 8 + b) * 2048 + split * 256) * 512 + h * 128, nro = ((size_t)(l * 8 + b) * 32) * 512 + h * 128;
    const float* Kc = A.in[2] + cro; const float* Vc = A.in[3] + cro;
    const float* Kn = A.out + O_KS + nro; const float* Vn = A.out + O_VS + nro;
    const bf16* Qrow = (const bf16*)(A.ws + WS_Q) + (size_t)(MP + b * 32 + r32) * 512 + h * 128;
    bf16x8 vfr[10];
    { float t[10][8];
#pragma unroll
      for (int ks = 0; ks < 10; ++ks)
#pragma unroll
        for (int j = 0; j < 8; ++j) { const float* vp = (ks < 8) ? Vc + (size_t)(128 * kh + 16 * ks + 8 * hi + j) * 512 : Vn + (size_t)(16 * (ks - 8) + 8 * hi + j) * 512;
            t[ks][j] = (ks < nks) ? vp[32 * eb + r32] : 0.f; }
      __builtin_amdgcn_sched_barrier(0);
#pragma unroll
      for (int ks = 0; ks < 10; ++ks) { v4u w; w.x = pk2(t[ks][0], t[ks][1]); w.y = pk2(t[ks][2], t[ks][3]); w.z = pk2(t[ks][4], t[ks][5]); w.w = pk2(t[ks][6], t[ks][7]); vfr[ks] = __builtin_bit_cast(bf16x8, w); }
      __builtin_amdgcn_sched_barrier(0); }
    float* SPO = (float*)(A.ws + WS_SPO); float* SPM = (float*)(A.ws + WS_SPM);
    for (int c = 0; c < 2; ++c) {
        f32x16 s[2]; s[0] = f32x16{}; s[1] = f32x16{};
        bf16x8 qf[4];
        { v2u q0[4], q1[4]; f32x4 ka[2][4], kb[2][4];
#pragma unroll
          for (int d0 = 0; d0 < 4; ++d0) { const bf16* qp = Qrow + c * 64 + 32 * (d0 & 1) + 16 * hi + 4 * (d0 >> 1); q0[d0] = *(const v2u*)qp; q1[d0] = *(const v2u*)(qp + 8);
              const float* kp = Kc + (size_t)(32 * wid + r32) * 512 + c * 64 + 16 * d0 + 8 * hi; ka[0][d0] = *(const f32x4*)kp; kb[0][d0] = *(const f32x4*)(kp + 4);
              const float* kn = Kn + (size_t)r32 * 512 + c * 64 + 16 * d0 + 8 * hi;
              ka[1][d0] = two ? *(const f32x4*)kn : (f32x4){0.f, 0.f, 0.f, 0.f}; kb[1][d0] = two ? *(const f32x4*)(kn + 4) : (f32x4){0.f, 0.f, 0.f, 0.f}; }
          __builtin_amdgcn_sched_barrier(0);
#pragma unroll
          for (int d0 = 0; d0 < 4; ++d0) { v4u qw; qw.x = q0[d0].x; qw.y = q0[d0].y; qw.z = q1[d0].x; qw.w = q1[d0].y; qf[d0] = __builtin_bit_cast(bf16x8, qw); }
#pragma unroll
          for (int ch = 0; ch < 2; ++ch) if (ch == 0 || two) {
#pragma unroll
              for (int d0 = 0; d0 < 4; ++d0) { v4u kw; kw.x = pk2(ka[ch][d0].x, ka[ch][d0].y); kw.y = pk2(ka[ch][d0].z, ka[ch][d0].w); kw.z = pk2(kb[ch][d0].x, kb[ch][d0].y); kw.w = pk2(kb[ch][d0].z, kb[ch][d0].w);
                  s[ch] = __builtin_amdgcn_mfma_f32_32x32x16_bf16(__builtin_bit_cast(bf16x8, kw), qf[d0], s[ch], 0, 0, 0); } } }
        float m = s[0][0];
#pragma unroll
        for (int r = 1; r < 16; ++r) m = fmaxf(m, s[0][r]);
        if (two) {
#pragma unroll
            for (int r = 0; r < 16; ++r) m = fmaxf(m, s[1][r]); }
        m = fmaxf(m, __shfl_xor(m, 32));
        if (hi == 0) MB[wid * 32 + r32] = m;
        __syncthreads();
        float M = MB[r32];
#pragma unroll
        for (int w = 1; w < 8; ++w) M = fmaxf(M, MB[w * 32 + r32]);
        float lsum = 0.f;
#pragma unroll
        for (int ch = 0; ch < 2; ++ch) if (ch == 0 || two) {
#pragma unroll
            for (int r = 0; r < 16; ++r) { s[ch][r] = __builtin_amdgcn_exp2f(s[ch][r] - M); lsum += s[ch][r]; }
            const int kbase = (ch == 0) ? 32 * wid : 256;
#pragma unroll
            for (int t = 0; t < 4; ++t) { v2u w; w.x = pk2(s[ch][4 * t], s[ch][4 * t + 1]); w.y = pk2(s[ch][4 * t + 2], s[ch][4 * t + 3]);
                *(LAS v2u*)(PL + r32 * 296 + kbase + 8 * t + 4 * hi) = w; } }
        lsum += __shfl_xor(lsum, 32);
        if (hi == 0) LB[wid * 32 + r32] = lsum;
        __syncthreads();
        f32x16 o = {};
#pragma unroll
        for (int ks = 0; ks < 10; ++ks) if (ks < nks) {
            const int key0 = (ks < 8) ? 128 * kh + 16 * ks : 256 + 16 * (ks - 8);
            const bf16x8 pf = *(const LAS bf16x8*)(PL + r32 * 296 + key0 + 8 * hi);
            o = __builtin_amdgcn_mfma_f32_32x32x16_bf16(vfr[ks], pf, o, 0, 0, 0); }
        if (kh == 1) {
#pragma unroll
            for (int r = 0; r < 16; ++r) OX[eb * 1024 + r * 64 + lane] = o[r]; }
        __syncthreads();
        if (kh == 0) { const size_t pi = ((size_t)(bh * 8 + split) * 2 + c) * 32 + r32;
#pragma unroll
            for (int t = 0; t < 4; ++t) { f32x4 v; v.x = o[4 * t] + OX[eb * 1024 + (4 * t) * 64 + lane]; v.y = o[4 * t + 1] + OX[eb * 1024 + (4 * t + 1) * 64 + lane];
                v.z = o[4 * t + 2] + OX[eb * 1024 + (4 * t + 2) * 64 + lane]; v.w = o[4 * t + 3] + OX[eb * 1024 + (4 * t + 3) * 64 + lane];
                *(f32x4*)(SPO + pi * 128 + 32 * eb + 8 * t + 4 * hi) = v; }
            if (wid == 0 && hi == 0) { float Lq = LB[r32];
#pragma unroll
                for (int w = 1; w < 8; ++w) Lq += LB[w * 32 + r32];
                SPM[pi * 2] = M; SPM[pi * 2 + 1] = Lq; } }
    }
    __syncthreads();
}

template <int NB> __device__ __forceinline__ void sample_gemm_res(const Frame& F, const bf16* Arows, int lda, const bf16* Bt, int K, bf16* XBs, float* SS, LAS unsigned char* lds) {
    int lane_l = F.lane; asm volatile("" : "+v"(lane_l));
    const int lane = lane_l, ks = F.wave, r32 = lane & 31, hi = lane >> 5, rt = F.vcu >> 5, ct = F.vcu & 31;
    const int Kw = K >> 3, nst = Kw >> 4;
    const bf16* ap = Arows + (size_t)(32 * rt + r32) * lda + ks * Kw + 8 * hi;
    const bf16* bp = Bt + (size_t)(32 * ct + r32) * K + ks * Kw + 8 * hi;
    f32x16 acc = {};
#pragma unroll 1
    for (int s0 = 0; s0 < nst; s0 += NB) {
        bf16x8 a[NB], b[NB];
#pragma unroll
        for (int i = 0; i < NB; ++i) { a[i] = *(const bf16x8*)(ap + 16 * (s0 + i)); b[i] = *(const bf16x8*)(bp + 16 * (s0 + i)); }
        __builtin_amdgcn_sched_barrier(0);
#pragma unroll
        for (int i = 0; i < NB; ++i) acc = __builtin_amdgcn_mfma_f32_32x32x16_bf16(a[i], b[i], acc, 0, 0, 0);
        __builtin_amdgcn_sched_barrier(0);
    }
    LAS float* RED = (LAS float*)lds;
    LAS float* SSQ = (LAS float*)(lds + 32768);
    if (ks > 0) {
#pragma unroll
        for (int r = 0; r < 16; ++r) RED[(ks - 1) * 1024 + r * 64 + lane] = acc[r]; }
    __syncthreads();
    if (ks == 0) {
        float v[16]; unsigned xo[16];
#pragma unroll
        for (int r = 0; r < 16; ++r) { float t = acc[r];
#pragma unroll
            for (int w = 0; w < 7; ++w) t += RED[w * 1024 + r * 64 + lane];
            v[r] = t; xo[r] = (unsigned)XBs[(unsigned)(32 * rt + crow(r, hi)) * 1024 + 32 * ct + r32]; }
        __builtin_amdgcn_sched_barrier(0);
#pragma unroll
        for (int r = 0; r < 16; ++r) { const float x = v[r] + bflo(xo[r]);
            XBs[(unsigned)(32 * rt + crow(r, hi)) * 1024 + 32 * ct + r32] = (bf16)f2bf(x);
            SSQ[crow(r, hi) * 33 + r32] = x * x; }
    }
    __syncthreads();
    if (ks == 0 && lane < 32) { float s = 0.f;
#pragma unroll
        for (int c2 = 0; c2 < 32; ++c2) s += SSQ[lane * 33 + c2];
        SS[(size_t)16 * MT + ct * 256 + 32 * rt + lane] = s; }
    __syncthreads();
}

__device__ __forceinline__ void conv_item_fast(const Args& A, int l, int item, int lane) {
    const int row0 = item * 8; const bool smp = row0 >= MP;
    const int b = smp ? (row0 - MP) >> 5 : row0 >> 11, t0 = smp ? (row0 - MP) & 31 : row0 & 2047, L = smp ? 32 : 2048;
    const bf16* UC = (const bf16*)(A.ws + WS_UC) + (size_t)(row0 - t0) * 256 + 4 * lane;
    const float* dw = A.in[12] + (size_t)l * 31 * 256 + 4 * lane;
    v2u P[38];
#pragma unroll
    for (int s = 0; s < 38; ++s) { const int tt = t0 - 30 + s; P[s] = (v2u){0u, 0u}; if (tt >= 0) P[s] = *(const v2u*)(UC + (size_t)tt * 256); }
    f32x4 acc[8];
#pragma unroll
    for (int i = 0; i < 8; ++i) acc[i] = (f32x4){0.f, 0.f, 0.f, 0.f};
    f32x4 R[8];
#pragma unroll
    for (int i = 0; i < 7; ++i) { const v2u w = P[i]; R[i] = (f32x4){bflo(w.x), bfhi(w.x), bflo(w.y), bfhi(w.y)}; }
#pragma unroll
    for (int j = 0; j < 31; ++j) { const f32x4 wv = *(const f32x4*)(dw + j * 256);
        { const v2u w = P[7 + j]; R[7] = (f32x4){bflo(w.x), bfhi(w.x), bflo(w.y), bfhi(w.y)}; }
#pragma unroll
        for (int i = 0; i < 8; ++i) acc[i] += wv * R[i];
#pragma unroll
        for (int i = 0; i < 7; ++i) R[i] = R[i + 1];
        __builtin_amdgcn_sched_barrier(0); }
    if (t0 + 7 >= L - 30) { float* cout = A.out + (smp ? O_CS : O_CP) + ((size_t)(l * 8 + b) * 30) * 256 + 4 * lane;
#pragma unroll
        for (int i = 0; i < 8; ++i) { const int tq = t0 + i; const v2u w = P[30 + i]; if (tq >= L - 30) *(f32x4*)(cout + (size_t)(tq - (L - 30)) * 256) = (f32x4){bflo(w.x), bfhi(w.x), bflo(w.y), bfhi(w.y)}; } }
    const f32x4 bias = *(const f32x4*)(A.in[13] + l * 256 + 4 * lane), lg = *(const f32x4*)(A.in[14] + l * 256 + 4 * lane), lb = *(const f32x4*)(A.in[15] + l * 256 + 4 * lane);
    bf16* MIX = (bf16*)(A.ws + WS_MIX) + (size_t)row0 * 1024 + 768 + 4 * lane;
#pragma unroll
    for (int i = 0; i < 8; ++i) { f32x4 y = acc[i] + bias;
        const float mu = wave_sum((y.x + y.y) + (y.z + y.w)) * (1.0f / 256.0f); y = y - mu;
        const float var = wave_sum((y.x * y.x + y.y * y.y) + (y.z * y.z + y.w * y.w)) * (1.0f / 256.0f);
        const float rs = rsqrtf(var + 1e-6f); y = y * rs * lg + lb; y = y * pg8::sigm4(y);
        v2u o; o.x = pk2(y.x, y.y); o.y = pk2(y.z, y.w); *(v2u*)(MIX + (size_t)i * 1024) = o; }
}
__device__ __forceinline__ void conv_item(const Args& A, int l, int item, int lane) {
    const int row0 = item * 8; const bool smp = row0 >= MP;
    const int b = smp ? (row0 - MP) >> 5 : row0 >> 11, t0 = smp ? (row0 - MP) & 31 : row0 & 2047, L = smp ? 32 : 2048;
    const bf16* UC = (const bf16*)(A.ws + WS_UC) + (size_t)(row0 - t0) * 256 + 4 * lane;
    const float* hist = A.in[5] + ((size_t)(l * 8 + b) * 30) * 256 + 4 * lane;
    const float* dw = A.in[12] + (size_t)l * 31 * 256 + 4 * lane;
    f32x4 acc[8], R[8];
#pragma unroll
    for (int i = 0; i < 8; ++i) acc[i] = (f32x4){0.f, 0.f, 0.f, 0.f};
    float* cout = A.out + (smp ? O_CS : O_CP) + ((size_t)(l * 8 + b) * 30) * 256 + 4 * lane;
#define CONV_ROW(dst, tt_) do { const int tt = (tt_); const int ttc = tt < 0 ? 0 : tt; \
        const v2u w_ = *(const v2u*)(UC + (size_t)ttc * 256); f32x4 rv_ = (f32x4){bflo(w_.x), bfhi(w_.x), bflo(w_.y), bfhi(w_.y)}; \
        if (tt < 0) rv_ = (f32x4){0.f, 0.f, 0.f, 0.f}; dst = rv_; } while (0)
#define CONV_HIST(dst, tt_) do { const int tt = (tt_); int hr = 30 + tt; hr = hr < 0 ? 0 : (hr > 29 ? 29 : hr); const f32x4 hv_ = *(const f32x4*)(hist + (size_t)hr * 256); if (tt < 0) dst = hv_; } while (0)
#pragma unroll
    for (int i = 0; i < 7; ++i) CONV_ROW(R[i], t0 - 30 + i);
    if (smp) {
#pragma unroll
        for (int i = 0; i < 7; ++i) CONV_HIST(R[i], t0 - 30 + i); }
#pragma unroll 1
    for (int jb = 0; jb < 32; jb += 8) {
        f32x4 N[8], Wt[8];
#pragma unroll
        for (int jj = 0; jj < 8; ++jj) { const int j = jb + jj; int tt2 = t0 - 23 + j; if (tt2 > L - 1) tt2 = L - 1; CONV_ROW(N[jj], tt2);
            const int jc = j < 31 ? j : 30; Wt[jj] = *(const f32x4*)(dw + jc * 256); if (j >= 31) Wt[jj] = (f32x4){0.f, 0.f, 0.f, 0.f}; }
        if (smp && t0 - 23 + jb < 0) {
#pragma unroll
            for (int jj = 0; jj < 8; ++jj) CONV_HIST(N[jj], t0 - 23 + jb + jj); }
        __builtin_amdgcn_sched_barrier(0);
#pragma unroll
        for (int jj = 0; jj < 8; ++jj) { const int j = jb + jj; R[7] = N[jj];
            if (j >= 23 && j < 31) { const int tq = t0 + (j - 23); if (tq >= L - 30) *(f32x4*)(cout + (size_t)(tq - (L - 30)) * 256) = R[7]; }
#pragma unroll
            for (int i = 0; i < 8; ++i) acc[i] += Wt[jj] * R[i];
#pragma unroll
            for (int i = 0; i < 7; ++i) R[i] = R[i + 1]; }
    }
#undef CONV_HIST
#undef CONV_ROW
    const f32x4 bias = *(const f32x4*)(A.in[13] + l * 256 + 4 * lane), lg = *(const f32x4*)(A.in[14] + l * 256 + 4 * lane), lb = *(const f32x4*)(A.in[15] + l * 256 + 4 * lane);
    bf16* MIX = (bf16*)(A.ws + WS_MIX) + (size_t)row0 * 1024 + 768 + 4 * lane;
#pragma unroll
    for (int i = 0; i < 8; ++i) { f32x4 y = acc[i] + bias;
        const float mu = wave_sum((y.x + y.y) + (y.z + y.w)) * (1.0f / 256.0f); y = y - mu;
        const float var = wave_sum((y.x * y.x + y.y * y.y) + (y.z * y.z + y.w * y.w)) * (1.0f / 256.0f);
        const float rs = rsqrtf(var + 1e-6f); y = y * rs * lg + lb; y = y * pg8::sigm4(y);
        v2u o; o.x = pk2(y.x, y.y); o.y = pk2(y.z, y.w); *(v2u*)(MIX + (size_t)i * 1024) = o; }
}
__device__ __forceinline__ void pool_item(const Args& A, int l, int item, int lane) {
    const int row = item * 2 + (lane >> 5), c0 = (lane & 31) * 8, g = c0 >> 6, w = 2 << g;
    const bool smp = row >= MP; const int b = smp ? (row - MP) >> 5 : row >> 11, t = smp ? (row - MP) & 31 : row & 2047, L = smp ? 32 : 2048;
    const bf16* UP = (const bf16*)(A.ws + WS_UP) + (size_t)(row - t) * 256 + c0;
    const float* hist = A.in[4] + ((size_t)(l * 8 + b) * 15) * 256 + c0;
    float sum[8], own[8];
    v4u pv[16];
#pragma unroll
    for (int jj = 0; jj < 16; ++jj) { const int tt = t - jj; pv[jj] = (v4u){0u, 0u, 0u, 0u}; if (jj < w && tt >= 0) pv[jj] = *(const v4u*)(UP + (size_t)tt * 256); }
    __builtin_amdgcn_sched_barrier(0);
#pragma unroll
    for (int i = 0; i < 8; ++i) sum[i] = 0.f;
#pragma unroll
    for (int jj = 0; jj < 16; ++jj) { const v4u v = pv[jj];
        const float fv[8] = {bflo(v.x), bfhi(v.x), bflo(v.y), bfhi(v.y), bflo(v.z), bfhi(v.z), bflo(v.w), bfhi(v.w)};
#pragma unroll
        for (int i = 0; i < 8; ++i) { sum[i] += fv[i]; if (jj == 0) own[i] = fv[i]; } }
    if (smp && t < w - 1) { for (int jj = t + 1; jj < w; ++jj) { const int tt = t - jj;
            const f32x4 a = *(const f32x4*)(hist + (size_t)(15 + tt) * 256), bq = *(const f32x4*)(hist + (size_t)(15 + tt) * 256 + 4);
            sum[0] += a.x; sum[1] += a.y; sum[2] += a.z; sum[3] += a.w; sum[4] += bq.x; sum[5] += bq.y; sum[6] += bq.z; sum[7] += bq.w; } }
    const int cnt = smp ? w : ((t + 1 < w) ? t + 1 : w); const float ic = 1.0f / (float)cnt;
    v4u o; o.x = pk2(sum[0] * ic - own[0], sum[1] * ic - own[1]); o.y = pk2(sum[2] * ic - own[2], sum[3] * ic - own[3]);
    o.z = pk2(sum[4] * ic - own[4], sum[5] * ic - own[5]); o.w = pk2(sum[6] * ic - own[6], sum[7] * ic - own[7]);
    *(v4u*)((bf16*)(A.ws + WS_MIX) + (size_t)row * 1024 + c0) = o;
    if (t >= L - 15) { float* po = A.out + (smp ? O_PS : O_PP) + ((size_t)(l * 8 + b) * 15 + (t - (L - 15))) * 256 + c0;
        *(f32x4*)po = (f32x4){own[0], own[1], own[2], own[3]}; *(f32x4*)(po + 4) = (f32x4){own[4], own[5], own[6], own[7]}; }
}
__device__ __forceinline__ void post_item(const Args& A, int l, int row0, int lane, float lam, float osc) {
    const int h = lane >> 4, e = (lane & 15) * 8;
    const bf16* O4 = (const bf16*)(A.ws + WS_O4) + (size_t)row0 * 1024 + h * 256 + e;
    v4u a[4], bq[4];
#pragma unroll
    for (int i = 0; i < 4; ++i) { a[i] = *(const v4u*)(O4 + (size_t)i * 1024); bq[i] = *(const v4u*)(O4 + (size_t)i * 1024 + 128); }
    __builtin_amdgcn_sched_barrier(0);
    const f32x4 g0 = *(const f32x4*)(A.in[11] + l * 128 + e), g1 = *(const f32x4*)(A.in[11] + l * 128 + e + 4);
#pragma unroll
    for (int i = 0; i < 4; ++i) {
        float o[8] = {bflo(a[i].x) - lam * bflo(bq[i].x), bfhi(a[i].x) - lam * bfhi(bq[i].x), bflo(a[i].y) - lam * bflo(bq[i].y), bfhi(a[i].y) - lam * bfhi(bq[i].y),
                      bflo(a[i].z) - lam * bflo(bq[i].z), bfhi(a[i].z) - lam * bfhi(bq[i].z), bflo(a[i].w) - lam * bflo(bq[i].w), bfhi(a[i].w) - lam * bfhi(bq[i].w)};
        float ss = 0.f;
#pragma unroll
        for (int k = 0; k < 8; ++k) ss += o[k] * o[k];
        ss += __shfl_xor(ss, 1); ss += __shfl_xor(ss, 2); ss += __shfl_xor(ss, 4); ss += __shfl_xor(ss, 8);
        const float rs = rsqrtf(ss * (1.0f / 128.0f) + 1e-6f) * osc;
        v4u w; w.x = pk2(o[0] * rs * g0.x, o[1] * rs * g0.y); w.y = pk2(o[2] * rs * g0.z, o[3] * rs * g0.w); w.z = pk2(o[4] * rs * g1.x, o[5] * rs * g1.y); w.w = pk2(o[6] * rs * g1.z, o[7] * rs * g1.w);
        *(v4u*)((bf16*)(A.ws + WS_MIX) + (size_t)(row0 + i) * 1024 + 256 + h * 128 + e) = w; }
}
__device__ __forceinline__ void scomb_item(const Args& A, int l, int item, int lane, float lam, float osc) {
    const int rs_ = item >> 2, h = item & 3, b = rs_ >> 5, q = rs_ & 31, bh = b * 4 + h;
    const float* SPO = (const float*)(A.ws + WS_SPO); const float* SPM = (const float*)(A.ws + WS_SPM);
    float oc[2][2];
#pragma unroll
    for (int c = 0; c < 2; ++c) {
        typedef float f32x2t __attribute__((ext_vector_type(2)));
        f32x2t ml[8], ov[8];
#pragma unroll
        for (int s = 0; s < 8; ++s) { const size_t pi = ((size_t)(bh * 8 + s) * 2 + c) * 32 + q; ml[s] = *(const f32x2t*)(SPM + pi * 2); ov[s] = *(const f32x2t*)(SPO + pi * 128 + 2 * lane); }
        __builtin_amdgcn_sched_barrier(0);
        float M = ml[0].x;
#pragma unroll
        for (int s = 1; s < 8; ++s) M = fmaxf(M, ml[s].x);
        float Ls = 0.f, o0 = 0.f, o1 = 0.f;
#pragma unroll
        for (int s = 0; s < 8; ++s) { const float wgt = __builtin_amdgcn_exp2f(ml[s].x - M); Ls += wgt * ml[s].y; o0 += wgt * ov[s].x; o1 += wgt * ov[s].y; }
        const float il = 1.0f / Ls; oc[c][0] = o0 * il; oc[c][1] = o1 * il; }
    const float x0 = oc[0][0] - lam * oc[1][0], x1 = oc[0][1] - lam * oc[1][1];
    const float ss = wave_sum(x0 * x0 + x1 * x1); const float rs = rsqrtf(ss * (1.0f / 128.0f) + 1e-6f) * osc;
    const float* g = A.in[11] + l * 128 + 2 * lane;
    *(unsigned*)((bf16*)(A.ws + WS_MIX) + (size_t)(MP + rs_) * 1024 + 256 + h * 128 + 2 * lane) = pk2(x0 * rs * g[0], x1 * rs * g[1]);
}

__global__ void __launch_bounds__(NWAVES * 64, 2) mk_fwd(Args args) {
    extern __shared__ __attribute__((aligned(16))) unsigned char lds_raw[];
    LAS unsigned char* lds = (LAS unsigned char*)lds_raw;
    Frame F; F.tid = threadIdx.x; F.lane = F.tid & 63; F.wave = __builtin_amdgcn_readfirstlane(F.tid >> 6);
    F.G = gridDim.x; { const int bx = blockIdx.x; F.vcu = (F.G % 8 == 0) ? (bx % 8) * (F.G / 8) + bx / 8 : bx; }
    F.gw = F.vcu * NWAVES + F.wave; F.NGW = F.G * NWAVES;
    unsigned char* ws = args.ws;
    const int lo = args.ph_lo, hi = args.ph_hi;
#define IN(k) (lo <= (k) && (k) < hi)
#define SEAM(k) do { if (IN(k) && IN((k) + 1)) { xcd_barrier(bar); } } while (0)
    for (int u = F.tid; u < 64; u += NWAVES * 64) ((LAS unsigned*)(lds + MISC_OFF))[u] = 0u;
    __syncthreads();
    XcdBarrier bar; bar.bar = (unsigned*)ws; bar.x = 0; bar.st = nullptr;
    if (!MK_MULTI) bar = xcd_barrier_post((unsigned*)ws, (volatile LAS unsigned*)(lds + MISC_OFF) + 8);
    #ifndef REP_PRO
#define REP_PRO 1
#endif
#ifndef REP_INP
#define REP_INP 1
#endif
#ifndef REP_ATT
#define REP_ATT 1
#endif
#ifndef REP_MIX
#define REP_MIX 1
#endif
#ifndef REP_GU
#define REP_GU 1
#endif
    if (!MK_MULTI && lo < 0) cg::this_grid().sync();
    if (IN(0)) { for (int rep = 0; rep < REP_PRO; ++rep) { p0_prologue(F, args, lds); __syncthreads(); } }
    SEAM(0);
    for (int rep = 0; rep < REP_SYNC; ++rep) xcd_barrier(bar);
    float* X = args.out + O_Y;
    bf16* XB = (bf16*)(ws + WS_XB); float* SS = (float*)(ws + WS_SS);
#pragma unroll 1
    for (int l = 0; l < 2; ++l) {
        const int pb = 1 + 6 * l;
        if (IN(pb)) for (int rep = 0; rep < REP_INP; ++rep) {
            pg8::Gemm g{XB, (const bf16*)(ws + WS_WIN) + (size_t)l * INW * 1024, MT, INW, 1024}; pg8::StaticOrder S; S.init(MT, INW, F.G, (int)blockIdx.x);
            pg8::EpiInProj E{SS, (const float*)(ws + WS_TAB), (bf16*)(ws + WS_UP), (bf16*)(ws + WS_Q), (bf16*)(ws + WS_K), (bf16*)(ws + WS_V), (bf16*)(ws + WS_UC),
                args.out + O_KP + (size_t)l * 8 * 2048 * 512, args.out + O_KS + (size_t)l * 8 * 32 * 512, args.out + O_VP + (size_t)l * 8 * 2048 * 512, args.out + O_VS + (size_t)l * 8 * 32 * 512};
            pg8::gemm_phase<pg8::EpiInProj, pg8::StaticOrder, PG8_ALIGN, PG8_SP2>(lds, g, S, E);
            if (SLACK_W && rep == 0) { if (l == 0) slack_weights(F, args, lds, (MT / 256) * (INW / 256), WI_A, WI_B); else slack_weights(F, args, lds, (MT / 256) * (INW / 256), WI_C, WI_END); }
        }
        SEAM(pb);
        if (IN(pb + 1)) for (int rep = 0; rep < REP_ATT; ++rep) {
            const int bh = F.vcu >> 3, jj = F.vcu & 7, a = jj & 3, c = jj >> 2, b = bh >> 2, h = bh & 3;
            const attn_body::bf16* Qp = (const attn_body::bf16*)(ws + WS_Q); const attn_body::bf16* Kp = (const attn_body::bf16*)(ws + WS_K); const attn_body::bf16* Vp = (const attn_body::bf16*)(ws + WS_V);
            attn_body::bf16* Op = (attn_body::bf16*)(ws + WS_O4);
            const int spos = F.vcu % 5;
#pragma unroll 1
            for (int i = 0; i < 5; ++i) {
                if (i == spos) { sample_attn_unit(F, args, l, F.vcu >> 3, F.vcu & 7, lds); }
                else { const int k = i - (i > spos ? 1 : 0); const int vh = k >> 1, qb = (k & 1) ? 7 - a : a;
                    attn_body::attn_unit<8>(b, 2 * h + c, 2 * h + vh, qb, Qp, Kp, Vp, Op, h * 256 + c * 128 + vh * 64, (char*)lds_raw); __syncthreads(); }
            }
        }
        SEAM(pb + 1);
        if (IN(pb + 2)) for (int rep = 0; rep < REP_MIX; ++rep) {
            int mlane = F.lane; asm volatile("" : "+v"(mlane));
            const float lam = ((const float*)(ws + WS_LAM))[l]; const float osc = 1.0f - (0.8f - 0.6f * expf(-0.3f * (float)l));
            const bool heavy = (F.NGW == 2048) && ((F.gw & 63) == 0);
            const int lgw = (F.NGW == 2048) ? F.gw - ((F.gw + 63) >> 6) : F.gw, lng = (F.NGW == 2048) ? 2016 : F.NGW;
#pragma unroll 1
            for (int k = 0; k < 2; ++k) { if (k == 1 && !heavy) break; conv_item(args, l, k == 0 ? F.gw : MP / 8 + (F.gw >> 6), mlane); }
            if (!heavy) {
            for (int it = lgw; it < MT / 2; it += lng) pool_item(args, l, it, mlane);
            for (int it = lgw; it < MP / 4; it += lng) post_item(args, l, it * 4, mlane, lam, osc);
            for (int it = lgw; it < 1024; it += lng) scomb_item(args, l, it, mlane, lam, osc);
            }
        }
        SEAM(pb + 2);
#ifndef REP_OUT0
#define REP_OUT0 1
#endif
#ifndef REP_SYNC
#define REP_SYNC 0
#endif
#ifndef REP_FOLD
#define REP_FOLD 1
#endif
#ifndef REP_SLACK
#define REP_SLACK 1
#endif
#ifndef SLACK_W
#define SLACK_W 1
#endif
        if (IN(pb + 3)) for (int rep = 0; rep < (l == 0 ? REP_OUT0 : 1); ++rep) {
            pg8::Gemm g{(const bf16*)(ws + WS_MIX), (const bf16*)(ws + WS_WOUT) + (size_t)l * 1024 * 1024, MP, 1024, 1024}; pg8::StaticOrder S; S.init(MP, 1024, F.G, (int)blockIdx.x);
            pg8::EpiRes E{XB, SS, 0};
            pg8::gemm_phase<pg8::EpiRes, pg8::StaticOrder, PG8_ALIGN, PG8_SP2>(lds, g, S, E);
            sample_gemm_res<8>(F, (const bf16*)(ws + WS_MIX) + (size_t)MP * 1024, 1024, (const bf16*)(ws + WS_WOUT) + (size_t)l * 1024 * 1024, 1024, XB + (size_t)MP * 1024, SS, lds);
        }
        SEAM(pb + 3);
        if (IN(pb + 4)) for (int rep = 0; rep < REP_GU; ++rep) {
            pg8::Gemm g{XB, (const bf16*)(ws + WS_WGU) + (size_t)l * 2 * DFF * 1024, MT, 2 * DFF, 1024}; pg8::StaticOrder S; S.init(MT, 2 * DFF, F.G, (int)blockIdx.x);
            pg8::EpiSwiGLU E{(bf16*)(ws + WS_H), SS};
            pg8::gemm_phase<pg8::EpiSwiGLU, pg8::StaticOrder, PG8_ALIGN, PG8_SP2>(lds, g, S, E);
            if (SLACK_W && rep == 0 && l == 0) slack_weights(F, args, lds, (MT / 256) * (2 * DFF / 256), WI_B, WI_C);
        }
        SEAM(pb + 4);
#ifndef REP_DN
#define REP_DN 1
#endif
        if (IN(pb + 5)) for (int rep = 0; rep < REP_DN; ++rep) {
            pg8::Gemm g{(const bf16*)(ws + WS_H), (const bf16*)(ws + WS_WDN) + (size_t)l * 1024 * DFF, MP, 1024, DFF}; pg8::StaticOrder S; S.init(MP, 1024, F.G, (int)blockIdx.x);
            pg8::EpiRes E{XB, SS, rep < REP_DN - 1};
            pg8::gemm_phase<pg8::EpiRes, pg8::StaticOrder, PG8_ALIGN, PG8_SP2>(lds, g, S, E);
            if (rep == REP_DN - 1) sample_gemm_res<11>(F, (const bf16*)(ws + WS_H) + (size_t)MP * DFF, DFF, (const bf16*)(ws + WS_WDN) + (size_t)l * 1024 * DFF, DFF, XB + (size_t)MP * 1024, SS, lds);
        }
        SEAM(pb + 5);
    }
#ifndef REP_FIN
#define REP_FIN 1
#endif
    if (IN(13)) for (int rep = 0; rep < REP_FIN; ++rep) {
        const float* gf = args.in[21]; int flane = F.lane; asm volatile("" : "+v"(flane));
        for (int m0 = F.gw * 2; m0 < MT; m0 += F.NGW * 2) {
            v4u w[2][2];
#pragma unroll
            for (int q = 0; q < 2; ++q)
#pragma unroll
                for (int j = 0; j < 2; ++j) w[q][j] = *((const v4u*)(XB + (size_t)(m0 + q) * 1024) + flane + 64 * j);
            __builtin_amdgcn_sched_barrier(0);
#pragma unroll
            for (int q = 0; q < 2; ++q) { float v[2][8]; float s = 0.f;
#pragma unroll
                for (int j = 0; j < 2; ++j) { const v4u ww = w[q][j]; v[j][0] = bflo(ww.x); v[j][1] = bfhi(ww.x); v[j][2] = bflo(ww.y); v[j][3] = bfhi(ww.y); v[j][4] = bflo(ww.z); v[j][5] = bfhi(ww.z); v[j][6] = bflo(ww.w); v[j][7] = bfhi(ww.w);
#pragma unroll
                    for (int k = 0; k < 8; ++k) s += v[j][k] * v[j][k]; }
                const float r = rsqrtf(wave_sum(s) * (1.0f / 1024.0f) + 1e-6f);
#pragma unroll
                for (int j = 0; j < 2; ++j) { const f32x4 g0 = *((const f32x4*)gf + 2 * (flane + 64 * j)), g1 = *((const f32x4*)gf + 2 * (flane + 64 * j) + 1);
                    f32x4* yo = (f32x4*)(X + (size_t)(m0 + q) * 1024) + 2 * (flane + 64 * j);
                    yo[0] = (f32x4){v[j][0] * r * g0.x, v[j][1] * r * g0.y, v[j][2] * r * g0.z, v[j][3] * r * g0.w};
                    yo[1] = (f32x4){v[j][4] * r * g1.x, v[j][5] * r * g1.y, v[j][6] * r * g1.z, v[j][7] * r * g1.w}; } } }
    }
#undef IN
#undef SEAM
}

extern "C" void kernel_launch(void* const* d_in, const int* in_sizes, int n_in, void* d_out, int out_size, void* d_ws, size_t ws_size, hipStream_t stream) {
    static int grid = 0;
    if (grid == 0) {
        if (n_in != 22 || out_size != (int)O_END || ws_size < WS_END) { fprintf(stderr, "kernel_launch: unexpected shapes (n_in %d out %d ws %zu)\n", n_in, out_size, ws_size); grid = -1; return; }
        int dev = 0, cus = 0, per_cu = 0;
        hipGetDevice(&dev); hipDeviceGetAttribute(&cus, hipDeviceAttributeMultiprocessorCount, dev);
        if (hipFuncSetAttribute((const void*)mk_fwd, hipFuncAttributeMaxDynamicSharedMemorySize, LDS_BYTES) != hipSuccess) { fprintf(stderr, "kernel_launch: hipFuncSetAttribute failed\n"); grid = -1; return; }
        hipOccupancyMaxActiveBlocksPerMultiprocessor(&per_cu, (const void*)mk_fwd, NWAVES * 64, LDS_BYTES);
        (void)hipGetLastError();
        if (per_cu < 1) { fprintf(stderr, "kernel_launch: occupancy query says %d blocks per CU\n", per_cu); per_cu = 1; }
        grid = cus;
        if (grid > 256) grid = 256;
    }
    if (grid < 0) return;
    if (hipMemsetAsync(d_ws, 0, 65536, stream) != hipSuccess) { fprintf(stderr, "kernel_launch: memset failed\n"); return; }
    Args a{};
    for (int i = 0; i < 22; ++i) a.in[i] = (const float*)d_in[i];
    a.out = (float*)d_out; a.ws = (unsigned char*)d_ws;
#if MK_MULTI
    for (int p = 0; p < NPH; ++p) { a.ph_lo = p; a.ph_hi = p + 1; hipLaunchKernelGGL(mk_fwd, dim3(grid), dim3(NWAVES * 64), LDS_BYTES, stream, a); }
#else
    a.ph_lo = 0; a.ph_hi = NPH;
    void* kargs[] = {&a};
    hipError_t e = hipLaunchCooperativeKernel((const void*)mk_fwd, dim3(grid), dim3(NWAVES * 64), kargs, LDS_BYTES, stream);
    if (e != hipSuccess) fprintf(stderr, "kernel_launch: cooperative launch failed: %s (grid %d)\n", hipGetErrorString(e), grid);
#endif
}
```

```cpp
#define MK_MULTI 0
#include <hip/hip_runtime.h>
#include <hip/hip_cooperative_groups.h>
#include <cstdio>
#include <cstdint>
namespace cg = cooperative_groups;
namespace pg8 {
#define PG8_LAS __attribute__((address_space(3)))
typedef unsigned short bf16_t;
typedef short bf16x8 __attribute__((ext_vector_type(8)));
typedef float f32x4 __attribute__((ext_vector_type(4)));
typedef unsigned u32x4 __attribute__((ext_vector_type(4)));
constexpr int BM = 256, BK = 64, HALF = 128, HTB = HALF * BK * 2  , STAGE_BYTES = 8 * HTB, NXCD = 8, WGM = 4;

__host__ __device__ __forceinline__ int lds_byte(int r, int c) { const int st = (r >> 4) * 2 + (c >> 5), rr = r & 15, cc = c & 31, ob = rr * 64 + cc * 2; return st * 1024 + (ob ^ (((ob >> 9) & 1) << 5)); }
__host__ __device__ __forceinline__ void stage_rc(int b, int& R, int& C) { const int st = b / 1024, sb = b % 1024, swz = sb ^ (((sb >> 9) & 1) << 5); R = (st >> 1) * 16 + swz / 64; C = (st & 1) * 32 + (swz % 64) / 2; }
__host__ __device__ __forceinline__ int perm32(int rho) { const int n = rho >> 4, i = rho & 15; return 8 * (i >> 2) + 4 * n + (i & 3); }

struct Unit { int pm, pn; };
struct Gemm { const bf16_t* A; const bf16_t* Bt; int M, N, K; };

struct StaticOrder {
    int nM, nN, nwg, G, c;
    __host__ __device__ void init(int M, int N, int G_, int c_) { nM = M / BM; nN = N / BM; nwg = nM * nN; G = G_; c = c_; }
    __host__ __device__ bool next(int i, Unit& u) const {
        const long L = (long)i * G + c; if (L >= nwg) return false;
        int wgid = (int)L; { const int q = nwg / NXCD, r = nwg % NXCD, xcd = wgid % NXCD, off = wgid / NXCD; wgid = (xcd < r ? xcd * (q + 1) : r * (q + 1) + (xcd - r) * q) + off; }
        const int nig = WGM * nN, gid = wgid / nig, fm = gid * WGM, gsz = (nM - fm) < WGM ? (nM - fm) : WGM;
        u.pm = fm + ((wgid % nig) % gsz); u.pn = (wgid % nig) / gsz; return true;
    }
    __device__ __forceinline__ void a_ready(const Unit&) const {}
    __device__ __forceinline__ void done(const Unit&) const {}
};

__device__ __forceinline__ unsigned cvt_pk_bf16(float lo, float hi) { unsigned r; asm volatile("v_cvt_pk_bf16_f32 %0, %1, %2" : "=v"(r) : "v"(lo), "v"(hi)); return r; }
typedef float f32x2 __attribute__((ext_vector_type(2)));
template <class Epi, class Sched, bool ALIGN_EPI = false, bool SP2 = false>
__device__ __forceinline__ void gemm_phase(PG8_LAS unsigned char* lds, const Gemm g, const Sched& S, const Epi& E) {
    int tid_l = threadIdx.x; asm volatile("" : "+v"(tid_l));
    const int tid = tid_l, wid = __builtin_amdgcn_readfirstlane(tid >> 6), lane = tid & 63, wr = wid >> 2, wc = wid & 3, fr = lane & 15, fq = lane >> 4;
    const int K = g.K, nt = K / BK;
    unsigned voffA[2], voffB[2];
#pragma unroll
    for (int i = 0; i < 2; ++i) { int R, C; stage_rc(tid * 16 + i * 8192, R, C); const int Rb = Epi::PERM ? ((R & ~31) + perm32(R & 31)) : R;
        voffA[i] = (unsigned)(R * K + C) * 2u; voffB[i] = (unsigned)(Rb * K + C) * 2u; }
    const size_t kstep = (size_t)(BK * 2);
    const size_t hstep = (size_t)HALF * K * 2;
    const size_t tstep = 2 * hstep;
    const unsigned ldsw = (unsigned)wid * 1024u;
    const int aoff = lds_byte(wr * 64 + fr, fq * 8), boff = lds_byte(wc * 32 + fr, fq * 8);
#define PG8_SA(b, h) (((b) * 2 + (h)) * HTB)
#define PG8_SB(b, h) ((4 + (b) * 2 + (h)) * HTB)
#define PG8_STAGE(bufoff, gbase, voff) do { _Pragma("unroll") for (int _i = 0; _i < 2; ++_i) \
        __builtin_amdgcn_global_load_lds((const unsigned*)((const char*)(gbase) + (voff)[_i]), (PG8_LAS unsigned*)(lds + (bufoff) + ldsw + _i * 8192), 16, 0, 0); } while (0)
#define PG8_LDA(dst, b, h) do { _Pragma("unroll") for (int m = 0; m < 4; ++m) _Pragma("unroll") for (int k = 0; k < 2; ++k) dst[m][k] = *(const PG8_LAS bf16x8*)(lds + PG8_SA(b, h) + aoff + m * 2048 + k * 1024); } while (0)
#define PG8_LDB(dst, b, h) do { _Pragma("unroll") for (int n = 0; n < 2; ++n) _Pragma("unroll") for (int k = 0; k < 2; ++k) dst[n][k] = *(const PG8_LAS bf16x8*)(lds + PG8_SB(b, h) + boff + n * 2048 + k * 1024); } while (0)
#define PG8_MMA(ai, bj, At, Bt) do { __builtin_amdgcn_s_setprio(1); _Pragma("unroll") for (int m = 0; m < 4; ++m) _Pragma("unroll") for (int n = 0; n < 2; ++n) _Pragma("unroll") for (int k = 0; k < 2; ++k) \
        acc[ai][bj][m][n] = __builtin_amdgcn_mfma_f32_16x16x32_bf16(Bt[n][k], At[m][k], acc[ai][bj][m][n], 0, 0, 0); __builtin_amdgcn_s_setprio(0); } while (0)
#define PG8_WAIT_V(n) asm volatile("s_waitcnt vmcnt(" #n ")" ::: "memory")
#define PG8_WAIT_L(n) asm volatile("s_waitcnt lgkmcnt(" #n ")" ::: "memory")
#define PG8_BAR __builtin_amdgcn_s_barrier()
#define PG8_SCHED __builtin_amdgcn_sched_barrier(0)
    Unit cur, nxt; int ui = 0;
    if (!S.next(0, cur)) return;
    f32x4 acc[2][2][4][2];
#pragma unroll
    for (int a = 0; a < 2; ++a)
#pragma unroll
        for (int b = 0; b < 2; ++b)
#pragma unroll
            for (int m = 0; m < 4; ++m)
#pragma unroll
                for (int n = 0; n < 2; ++n) acc[a][b][m][n] = (f32x4){0.f, 0.f, 0.f, 0.f};
    bf16x8 At[4][2], B0[2][2], B1[2][2];
    const char* cA = (const char*)g.A + (size_t)cur.pm * tstep; const char* cB = (const char*)g.Bt + (size_t)cur.pn * tstep;
    S.a_ready(cur);
    if constexpr (SP2) {
        PG8_STAGE(PG8_SB(0, 0), cB, voffB); PG8_STAGE(PG8_SB(0, 1), cB + hstep, voffB); PG8_STAGE(PG8_SA(0, 0), cA, voffA); PG8_STAGE(PG8_SA(0, 1), cA + hstep, voffA);
        if (wr == 1) PG8_BAR;
        PG8_WAIT_V(2); PG8_BAR;
        PG8_STAGE(PG8_SB(1, 0), cB + kstep, voffB); PG8_STAGE(PG8_SA(1, 0), cA + kstep, voffA); PG8_STAGE(PG8_SB(1, 1), cB + hstep + kstep, voffB);
        PG8_WAIT_V(6); PG8_BAR;
    } else {
        PG8_STAGE(PG8_SB(0, 0), cB, voffB); PG8_STAGE(PG8_SA(0, 0), cA, voffA); PG8_STAGE(PG8_SB(0, 1), cB + hstep, voffB); PG8_STAGE(PG8_SA(0, 1), cA + hstep, voffA);
        if (wr == 1) PG8_BAR;
        PG8_WAIT_V(4); PG8_BAR;
        PG8_STAGE(PG8_SB(1, 0), cB + kstep, voffB); PG8_STAGE(PG8_SA(1, 0), cA + kstep, voffA); PG8_STAGE(PG8_SB(1, 1), cB + hstep + kstep, voffB);
        PG8_WAIT_V(6); PG8_BAR;
    }
    for (;;) {
        const bool has_next = S.next(ui + 1, nxt);
        const char* nA = has_next ? (const char*)g.A + (size_t)nxt.pm * tstep : cA; const char* nB = has_next ? (const char*)g.Bt + (size_t)nxt.pn * tstep : cB;
        for (int t = 0; t < nt; t += 2) {
            const bool last = (t == nt - 2);
            const char* a1 = cA + (size_t)(t + 1) * kstep;
            const char* a2 = last ? nA : cA + (size_t)(t + 2) * kstep; const char* b2 = last ? nB : cB + (size_t)(t + 2) * kstep;
            const char* a3 = a2 + kstep; const char* b3 = b2 + kstep;
            if (last && has_next) S.a_ready(nxt);
            if constexpr (SP2) {
            PG8_LDB(B0, 0, 0); PG8_LDB(B1, 0, 1); PG8_SCHED; PG8_LDA(At, 0, 0); PG8_STAGE(PG8_SA(1, 1), a1 + hstep, voffA);
            PG8_WAIT_V(8); PG8_WAIT_L(0); PG8_BAR; PG8_MMA(0, 0, At, B0); PG8_MMA(0, 1, At, B1); PG8_BAR; PG8_SCHED;
            PG8_LDA(At, 0, 1); PG8_STAGE(PG8_SB(0, 0), b2, voffB); PG8_STAGE(PG8_SB(0, 1), b2 + hstep, voffB); PG8_STAGE(PG8_SA(0, 0), a2, voffA);
            PG8_WAIT_V(8); PG8_WAIT_L(0); PG8_BAR; PG8_MMA(1, 0, At, B0); PG8_MMA(1, 1, At, B1); PG8_BAR; PG8_SCHED;
            PG8_LDB(B0, 1, 0); PG8_LDB(B1, 1, 1); PG8_SCHED; PG8_LDA(At, 1, 0); PG8_STAGE(PG8_SA(0, 1), a2 + hstep, voffA);
            PG8_WAIT_V(8); PG8_WAIT_L(0); PG8_BAR; PG8_MMA(0, 0, At, B0); PG8_MMA(0, 1, At, B1); PG8_BAR; PG8_SCHED;
            PG8_LDA(At, 1, 1); PG8_STAGE(PG8_SB(1, 0), b3, voffB); PG8_STAGE(PG8_SB(1, 1), b3 + hstep, voffB); PG8_STAGE(PG8_SA(1, 0), a3, voffA);
            PG8_WAIT_V(8); PG8_WAIT_L(0); PG8_BAR; PG8_MMA(1, 0, At, B0); PG8_MMA(1, 1, At, B1); PG8_BAR; PG8_SCHED;
            } else {
            PG8_LDB(B0, 0, 0); PG8_SCHED; PG8_LDA(At, 0, 0); PG8_STAGE(PG8_SA(1, 1), a1 + hstep, voffA);
            PG8_WAIT_L(8); PG8_BAR; PG8_WAIT_L(0); PG8_MMA(0, 0, At, B0); PG8_BAR; PG8_SCHED;
            PG8_LDB(B1, 0, 1); PG8_STAGE(PG8_SB(0, 0), b2, voffB);
            PG8_BAR; PG8_WAIT_L(0); PG8_MMA(0, 1, At, B1); PG8_BAR;
            PG8_LDA(At, 0, 1); PG8_STAGE(PG8_SA(0, 0), a2, voffA);
            PG8_BAR; PG8_WAIT_L(0); PG8_MMA(1, 0, At, B0); PG8_BAR; PG8_SCHED;
            PG8_STAGE(PG8_SB(0, 1), b2 + hstep, voffB);
            PG8_WAIT_V(6); PG8_BAR; PG8_MMA(1, 1, At, B1); PG8_BAR;
            PG8_LDB(B0, 1, 0); PG8_SCHED; PG8_LDA(At, 1, 0); PG8_STAGE(PG8_SA(0, 1), a2 + hstep, voffA);
            PG8_WAIT_L(8); PG8_BAR; PG8_WAIT_L(0); PG8_MMA(0, 0, At, B0); PG8_BAR; PG8_SCHED;
            PG8_LDB(B1, 1, 1); PG8_STAGE(PG8_SB(1, 0), b3, voffB);
            PG8_BAR; PG8_WAIT_L(0); PG8_MMA(0, 1, At, B1); PG8_BAR;
            PG8_LDA(At, 1, 1); PG8_STAGE(PG8_SA(1, 0), a3, voffA);
            PG8_BAR; PG8_WAIT_L(0); PG8_MMA(1, 0, At, B0); PG8_BAR; PG8_SCHED;
            PG8_STAGE(PG8_SB(1, 1), b3 + hstep, voffB);
            PG8_WAIT_V(6); PG8_BAR; PG8_MMA(1, 1, At, B1); PG8_BAR;
            }
        }
        if constexpr (ALIGN_EPI) { if (wr == 0) PG8_BAR; }
        if constexpr (!Epi::AFTER_DRAIN) { E(acc, cur, wr, wc, fr, fq); S.done(cur); }
        if (!has_next) break;
#pragma unroll
        for (int a = 0; a < 2; ++a)
#pragma unroll
            for (int b = 0; b < 2; ++b)
#pragma unroll
                for (int m = 0; m < 4; ++m)
#pragma unroll
                    for (int n = 0; n < 2; ++n) acc[a][b][m][n] = (f32x4){0.f, 0.f, 0.f, 0.f};
        cur = nxt; cA = nA; cB = nB; ++ui;
        if constexpr (ALIGN_EPI) { if (wr == 1) PG8_BAR; }
    }
    PG8_WAIT_V(0);
    if constexpr (!ALIGN_EPI) { if (wr == 0) PG8_BAR; }
    PG8_BAR;
    if constexpr (Epi::AFTER_DRAIN) { E.fused(acc, cur, wr, wc, fr, fq, lds, wid, lane); S.done(cur); }
#undef PG8_SA
#undef PG8_SB
#undef PG8_STAGE
#undef PG8_LDA
#undef PG8_LDB
#undef PG8_MMA
#undef PG8_WAIT_V
#undef PG8_WAIT_L
#undef PG8_BAR
#undef PG8_SCHED
}
}
#define PG8_SP2 true
#define PG8_ALIGN true
namespace pg8 {
constexpr int MT = 16640, MP = 16384;
constexpr float RMS_EPS = 1e-6f;
constexpr float QC2 = 0.125f * 1.4426950408889634f;
typedef unsigned u32x2 __attribute__((ext_vector_type(2)));
__device__ __forceinline__ float row_rs(const float* SS, int row, int fq) {
    float s = 0.f;
#pragma unroll
    for (int j = 0; j < 4; ++j) s += SS[(unsigned)(4 * fq + j) * MT + row];
    s += __shfl_xor(s, 16); s += __shfl_xor(s, 32);
    return rsqrtf(s * (1.0f / 1024.0f) + RMS_EPS);
}
__device__ __forceinline__ void rows_rs8(const float* SS, int row0, int fq, float (&r)[8]) {
    float s[8][4];
    if (row0 < MP) {
#pragma unroll
        for (int k = 0; k < 8; ++k)
#pragma unroll
            for (int j = 0; j < 4; ++j) s[k][j] = SS[(unsigned)(4 * fq + j) * MT + row0 + (k >> 2) * HALF + (k & 3) * 16];
    } else { const float* S2 = SS + 16 * MT + (row0 - MP);
#pragma unroll
        for (int h2 = 0; h2 < 2; ++h2) { float q[4][8];
            __builtin_amdgcn_sched_barrier(0);
#pragma unroll
            for (int k = 0; k < 4; ++k)
#pragma unroll
                for (int j = 0; j < 8; ++j) q[k][j] = S2[(unsigned)(8 * fq + j) * 256 + h2 * HALF + k * 16];
            __builtin_amdgcn_sched_barrier(0);
#pragma unroll
            for (int k = 0; k < 4; ++k)
#pragma unroll
                for (int j = 0; j < 4; ++j) s[h2 * 4 + k][j] = q[k][j] + q[k][j + 4]; }
    }
    __builtin_amdgcn_sched_barrier(0);
#pragma unroll
    for (int k = 0; k < 8; ++k) { float t = (s[k][0] + s[k][1]) + (s[k][2] + s[k][3]); t += __shfl_xor(t, 16); t += __shfl_xor(t, 32); r[k] = rsqrtf(t * (1.0f / 1024.0f) + RMS_EPS); }
    __builtin_amdgcn_sched_barrier(0);
}
__device__ __forceinline__ void store8(bf16_t* p, f32x4 a, f32x4 b) {
    u32x4 w; w.x = cvt_pk_bf16(a[0], a[1]); w.y = cvt_pk_bf16(a[2], a[3]); w.z = cvt_pk_bf16(b[0], b[1]); w.w = cvt_pk_bf16(b[2], b[3]);
    *(u32x4*)p = w;
}
__device__ __forceinline__ float sigm(float x) { return __builtin_amdgcn_rcpf(1.0f + __builtin_amdgcn_exp2f(-1.4426950408889634f * x)); }
__device__ __forceinline__ f32x4 sigm4(f32x4 x) { f32x4 r; r[0] = sigm(x[0]); r[1] = sigm(x[1]); r[2] = sigm(x[2]); r[3] = sigm(x[3]); return r; }

struct EpiRes {
    static constexpr bool PERM = true, AFTER_DRAIN = false;
    bf16_t* xb; float* SS; int dry;
    __device__ __forceinline__ void operator()(const f32x4 (&acc)[2][2][4][2], const Unit& u, int wr, int wc, int fr, int fq) const {
        const int col0 = u.pn * BM + wc * 32 + 8 * fq;
#pragma unroll
        for (int ai = 0; ai < 2; ++ai) {
            u32x4 xw[4][2];
#pragma unroll
            for (int m = 0; m < 4; ++m)
#pragma unroll
                for (int bj = 0; bj < 2; ++bj) xw[m][bj] = *(const u32x4*)(xb + (unsigned)(u.pm * BM + ai * HALF + wr * 64 + m * 16 + fr) * 1024 + col0 + bj * HALF);
            __builtin_amdgcn_sched_barrier(0);
#pragma unroll
            for (int m = 0; m < 4; ++m) {
                const int rl = ai * HALF + wr * 64 + m * 16 + fr;
                const unsigned goff = (unsigned)(u.pm * BM + rl) * 1024 + col0;
                float ss = 0.f;
#pragma unroll
                for (int bj = 0; bj < 2; ++bj) {
                    const u32x4 w = xw[m][bj];
                    f32x4 o0, o1;
                    o0[0] = __builtin_bit_cast(float, w.x << 16) + acc[ai][bj][m][0][0]; o0[1] = __builtin_bit_cast(float, w.x & 0xffff0000u) + acc[ai][bj][m][0][1];
                    o0[2] = __builtin_bit_cast(float, w.y << 16) + acc[ai][bj][m][0][2]; o0[3] = __builtin_bit_cast(float, w.y & 0xffff0000u) + acc[ai][bj][m][0][3];
                    o1[0] = __builtin_bit_cast(float, w.z << 16) + acc[ai][bj][m][1][0]; o1[1] = __builtin_bit_cast(float, w.z & 0xffff0000u) + acc[ai][bj][m][1][1];
                    o1[2] = __builtin_bit_cast(float, w.w << 16) + acc[ai][bj][m][1][2]; o1[3] = __builtin_bit_cast(float, w.w & 0xffff0000u) + acc[ai][bj][m][1][3];
                    if (!dry) store8(xb + goff + bj * HALF, o0, o1);
                    ss += (o0[0] * o0[0] + o0[1] * o0[1]) + (o0[2] * o0[2] + o0[3] * o0[3]) + (o1[0] * o1[0] + o1[1] * o1[1]) + (o1[2] * o1[2] + o1[3] * o1[3]);
                }
                ss += __shfl_xor(ss, 16); ss += __shfl_xor(ss, 32);
                if (fq == 0 && !dry) SS[(unsigned)(u.pn * 4 + wc) * MT + u.pm * BM + rl] = ss;
                if (dry) asm volatile("" :: "v"(ss));
            }
        }
    }
};
struct EpiSwiGLU {
    static constexpr bool PERM = true, AFTER_DRAIN = false;
    bf16_t* H; const float* SS;
    __device__ __forceinline__ void operator()(const f32x4 (&acc)[2][2][4][2], const Unit& u, int wr, int wc, int fr, int fq) const {
        const int row0 = u.pm * BM + wr * 64 + fr, col0 = u.pn * 128 + wc * 32 + 8 * fq;
        float r8[8]; rows_rs8(SS, row0, fq, r8);
#pragma unroll
        for (int ai = 0; ai < 2; ++ai)
#pragma unroll
            for (int m = 0; m < 4; ++m) {
                const int row = row0 + ai * HALF + m * 16; const float r = r8[ai * 4 + m];
                const f32x4 g0 = acc[ai][0][m][0] * r, g1 = acc[ai][0][m][1] * r, u0 = acc[ai][1][m][0] * r, u1 = acc[ai][1][m][1] * r;
                store8(H + (unsigned)row * 2816 + col0, g0 * sigm4(g0) * u0, g1 * sigm4(g1) * u1);
            }
    }
};
struct EpiInProj {
    static constexpr bool PERM = true, AFTER_DRAIN = false;
    const float* SS; const float* TAB; bf16_t *UP, *Q, *K, *V, *UC; float *kP, *kS, *vP, *vS;
    __device__ __forceinline__ void operator()(const f32x4 (&acc)[2][2][4][2], const Unit& u, int wr, int wc, int fr, int fq) const {
        const int pn = u.pn; const bool smp = (u.pm >= 64);
        const int row0 = u.pm * BM + wr * 64 + fr, cw = wc * 32 + 8 * fq;
        float r8[8]; rows_rs8(SS, row0, fq, r8);
        if (pn == 0) {
#pragma unroll
            for (int ai = 0; ai < 2; ++ai)
#pragma unroll
                for (int m = 0; m < 4; ++m) { const int row = row0 + ai * HALF + m * 16; const float r = r8[ai * 4 + m];
#pragma unroll
                    for (int bj = 0; bj < 2; ++bj) store8(UP + (unsigned)row * 256 + bj * HALF + cw, acc[ai][bj][m][0] * r, acc[ai][bj][m][1] * r); }
        } else if (pn <= 4) {
            const bool isq = pn <= 2; const int t2 = (pn - 1) & 1, j = 4 * (wc & 1) + fq;
#pragma unroll
            for (int ai = 0; ai < 2; ++ai) {
                f32x4 csv[4], snv[4];
#pragma unroll
                for (int m = 0; m < 4; ++m) { const int row = row0 + ai * HALF + m * 16; const int pos = smp ? 2048 + ((row - MP) & 31) : (row & 2047);
                    csv[m] = *(const f32x4*)(TAB + pos * 64 + 4 * j); snv[m] = *(const f32x4*)(TAB + pos * 64 + 32 + 4 * j); }
                __builtin_amdgcn_sched_barrier(0);
#pragma unroll
                for (int m = 0; m < 4; ++m) { const int row = row0 + ai * HALF + m * 16; const float r = r8[ai * 4 + m];
                    const f32x4 cs = csv[m], sn = snv[m];
#pragma unroll
                    for (int bj = 0; bj < 2; ++bj) { const int grp = t2 * 4 + bj * 2 + (wc >> 1);
                        const f32x4 x1 = acc[ai][bj][m][0] * r, x2 = acc[ai][bj][m][1] * r;
                        const f32x4 o1 = x1 * cs - x2 * sn, o2 = x2 * cs + x1 * sn;
                        const unsigned bo = (unsigned)row * 512 + grp * 64 + 32 * (wc & 1) + 8 * fq;
                        if (isq) store8(Q + bo, o1 * QC2, o2 * QC2);
                        else { store8(K + bo, o1, o2);
                            float* kf = (smp ? kS + (unsigned)(row - MP) * 512 : kP + (unsigned)row * 512) + grp * 64 + 4 * j;
                            *(f32x4*)kf = o1; *(f32x4*)(kf + 32) = o2; } } } }
        } else if (pn <= 6) {
#pragma unroll
            for (int ai = 0; ai < 2; ++ai)
#pragma unroll
                for (int m = 0; m < 4; ++m) { const int row = row0 + ai * HALF + m * 16; const float r = r8[ai * 4 + m];
#pragma unroll
                    for (int bj = 0; bj < 2; ++bj) { const int col = (pn - 5) * 256 + bj * HALF + cw;
                        const f32x4 v0 = acc[ai][bj][m][0] * r, v1 = acc[ai][bj][m][1] * r;
                        store8(V + (unsigned)row * 512 + col, v0, v1);
                        float* vf = (smp ? vS + (unsigned)(row - MP) * 512 : vP + (unsigned)row * 512) + col;
                        *(f32x4*)vf = v0; *(f32x4*)(vf + 4) = v1; } }
        } else {
            const int T = pn - 7;
#pragma unroll
            for (int ai = 0; ai < 2; ++ai)
#pragma unroll
                for (int m = 0; m < 4; ++m) { const int row = row0 + ai * HALF + m * 16; const float r = r8[ai * 4 + m];
                    const f32x4 a0 = acc[ai][0][m][0] * r, a1 = acc[ai][0][m][1] * r, b0 = acc[ai][1][m][0] * r, b1 = acc[ai][1][m][1] * r;
                    store8(UC + (unsigned)row * 256 + T * 128 + cw, a0 * sigm4(b0), a1 * sigm4(b1)); }
        }
    }
};
}
#include <hip/hip_bf16.h>
#include <cmath>
namespace attn_body {
using bf16=__hip_bfloat16;
using bf16x8=__attribute__((ext_vector_type(8)))short;
using s16x4=__attribute__((ext_vector_type(4)))short;
using f32x16=__attribute__((ext_vector_type(16)))float;
using u32x4=__attribute__((ext_vector_type(4)))unsigned;
constexpr int BATCH=8,NHEAD=8,SEQ=2048,D=64,DM=512;
constexpr int NW=8,QBLK=32,QB=QBLK*NW,KVBLK=64,NQB=SEQ/QB;
constexpr int ATTN_PITCH=DM, ATTN_UNIT_ROWS=QB;
__device__ __forceinline__ int crow(int r,int hi){return (r&3)+8*(r>>2)+4*hi;}
#define SBAR() __builtin_amdgcn_sched_barrier(0)
__device__ __forceinline__ void cmask(f32x16&p0,f32x16&p1,int jb,int wid){
  if(jb>(wid>>1)){ const float NEG=-INFINITY;
  #pragma unroll
  for(int r=0;r<16;++r){p0[r]=NEG;p1[r]=NEG;} }
}

constexpr int NSLOT=3, SLOTB=8192;
constexpr int LDS_K=0, LDS_V=NSLOT*SLOTB, LDS_WS=2*NSLOT*SLOTB, LDS_OST=LDS_WS+NW*64*4, LDS_BYTES=LDS_OST+NW*4096;
constexpr float C2=0.125f*1.4426950408889634f;
__device__ __forceinline__ void glds16(const void*gsrc,unsigned lds_dst){unsigned keep;
  asm volatile("s_mov_b32 %0, m0\n\ts_mov_b32 m0, %2\n\ts_nop 0\n\tglobal_load_lds_dwordx4 %1, off\n\ts_mov_b32 m0, %0":"=&s"(keep):"v"(gsrc),"s"(lds_dst):"memory");}
__device__ __forceinline__ float max3f(float a,float b,float c){float r;asm("v_max3_f32 %0, %1, %2, %3":"=v"(r):"v"(a),"v"(b),"v"(c));return r;}
__device__ __forceinline__ float max2f(float a,float b){float r;asm("v_max_f32_e32 %0, %1, %2":"=v"(r):"v"(a),"v"(b));return r;}
__device__ __forceinline__ float fadd_s(float a,float b){float r;asm("v_add_f32_e32 %0, %1, %2":"=v"(r):"v"(a),"v"(b));return r;}
__device__ __forceinline__ float fsub_s(float a,float b){float r;asm("v_sub_f32_e32 %0, %1, %2":"=v"(r):"v"(a),"v"(b));return r;}
typedef float f32x2_t __attribute__((ext_vector_type(2))); typedef __bf16 bf16x2_t __attribute__((ext_vector_type(2)));
__device__ __forceinline__ unsigned cvtpk_s(float lo,float hi){f32x2_t v={lo,hi};bf16x2_t b=__builtin_convertvector(v,bf16x2_t);return __builtin_bit_cast(unsigned,b);}
#define WAIT_BAR(N) asm volatile("s_waitcnt vmcnt(" #N ") lgkmcnt(0)\n\ts_barrier":::"memory")

__device__ __forceinline__ void qkt(f32x16&p0,f32x16&p1,const char*Kslot,const bf16x8*qr,const f32x16&negm,int r32,int hi){
  const char*kb=Kslot+hi*1024+r32*16;
  #pragma unroll
  for(int d0=0;d0<4;++d0){
    const bf16x8 b0=*reinterpret_cast<const bf16x8*>(kb+d0*2048);
    const bf16x8 b1=*reinterpret_cast<const bf16x8*>(kb+d0*2048+512);
    if(d0==0){p0=__builtin_amdgcn_mfma_f32_32x32x16_bf16(b0,qr[0],negm,0,0,0);p1=__builtin_amdgcn_mfma_f32_32x32x16_bf16(b1,qr[0],negm,0,0,0);}
    else{p0=__builtin_amdgcn_mfma_f32_32x32x16_bf16(b0,qr[d0],p0,0,0,0);p1=__builtin_amdgcn_mfma_f32_32x32x16_bf16(b1,qr[d0],p1,0,0,0);}}
}
typedef __attribute__((address_space(3))) const char* lds_cptr;
typedef short v4i16_t __attribute__((ext_vector_type(4)));
__device__ __forceinline__ void kload8(bf16x8*kf,lds_cptr kp){
  kf[0]=*(const __attribute__((address_space(3))) bf16x8*)(kp);      kf[1]=*(const __attribute__((address_space(3))) bf16x8*)(kp+512);
  kf[2]=*(const __attribute__((address_space(3))) bf16x8*)(kp+2048); kf[3]=*(const __attribute__((address_space(3))) bf16x8*)(kp+2560);
  kf[4]=*(const __attribute__((address_space(3))) bf16x8*)(kp+4096); kf[5]=*(const __attribute__((address_space(3))) bf16x8*)(kp+4608);
  kf[6]=*(const __attribute__((address_space(3))) bf16x8*)(kp+6144); kf[7]=*(const __attribute__((address_space(3))) bf16x8*)(kp+6656);
}
__device__ __forceinline__ void kload2(bf16x8*kf,lds_cptr kp,int j){ kf[2*j]=*(const __attribute__((address_space(3))) bf16x8*)(kp+j*2048); kf[2*j+1]=*(const __attribute__((address_space(3))) bf16x8*)(kp+j*2048+512); }
__device__ __forceinline__ s16x4 vtr(lds_cptr p){ return __builtin_bit_cast(s16x4,__builtin_amdgcn_ds_read_tr16_b64_v4i16((__attribute__((address_space(3))) v4i16_t*)p)); }
__device__ __forceinline__ float rowmax(const f32x16&p0,const f32x16&p1){
  float a=max3f(p0[0],p0[1],p1[0]),b=max3f(p0[2],p0[3],p1[1]);a=max3f(a,p1[2],p1[3]);
  #pragma unroll
  for(int r=4;r<16;r+=4){a=max3f(a,p0[r],p0[r+1]);b=max3f(b,p0[r+2],p0[r+3]);a=max3f(a,p1[r],p1[r+1]);b=max3f(b,p1[r+2],p1[r+3]);}
  const float m=max2f(a,b);
  auto rr=__builtin_amdgcn_permlane32_swap(__float_as_uint(m),__float_as_uint(m),false,false);
  return max2f(__uint_as_float(rr[0]),__uint_as_float(rr[1]));
}
__device__ __forceinline__ void pv(f32x16*o,int vb,bf16x8 pa0,bf16x8 pa1,bf16x8 pa2,bf16x8 pa3){
  #pragma unroll
  for(int d0=0;d0<2;++d0){s16x4 lo[4],hi[4];
    #pragma unroll
    for(int ks=0;ks<4;++ks){
      asm volatile("ds_read_b64_tr_b16 %0,%1 offset:%c2":"=&v"(lo[ks]):"v"(vb),"i"(d0*4096+ks*1024):"memory");
      asm volatile("ds_read_b64_tr_b16 %0,%1 offset:%c2":"=&v"(hi[ks]):"v"(vb),"i"(d0*4096+ks*1024+512):"memory");}
    asm volatile("s_waitcnt lgkmcnt(0)":::"memory");SBAR();
    #define PK(k) (bf16x8){lo[k][0],lo[k][1],lo[k][2],lo[k][3],hi[k][0],hi[k][1],hi[k][2],hi[k][3]}
    o[d0]=__builtin_amdgcn_mfma_f32_32x32x16_bf16(pa0,PK(0),o[d0],0,0,0);
    o[d0]=__builtin_amdgcn_mfma_f32_32x32x16_bf16(pa1,PK(1),o[d0],0,0,0);
    o[d0]=__builtin_amdgcn_mfma_f32_32x32x16_bf16(pa2,PK(2),o[d0],0,0,0);
    o[d0]=__builtin_amdgcn_mfma_f32_32x32x16_bf16(pa3,PK(3),o[d0],0,0,0);
    #undef PK
  }
}

#ifndef ATTN_STORE16
#define ATTN_STORE16(p,v) (*(u32x4*)(p)=(v))
#endif
template<int THRL> __device__ __forceinline__ void attn_unit(int b,int h,int hv,int qb,const bf16*Q,const bf16*__restrict__ K,const bf16*__restrict__ V,bf16*O,int ocol,char*shm){
  int tid_l=threadIdx.x; asm volatile("":"+v"(tid_l)); const int tid=tid_l,lane=tid&63,r32=lane&31,hi=lane>>5; const int wid=__builtin_amdgcn_readfirstlane(tid>>6);
  const long rowbase=(long)b*SEQ; const int q0=qb*QB;
  const bf16*Qw=Q+(rowbase+q0+wid*QBLK)*DM+h*D;
  const bf16*Kh=K+rowbase*DM+h*D,*Vh=V+rowbase*DM+hv*D;
  const unsigned lds0=(unsigned)(uintptr_t)shm;
  float*wsf=(float*)(shm+LDS_WS)+wid*64;
  const bf16*ksrc=Kh+(long)lane*DM+wid*8;
  const bf16*vsrc=Vh+(long)(16*(wid&3)+(lane>>2))*DM+(wid>>2)*32+(lane&3)*8;
  const unsigned kdst=lds0+LDS_K+wid*1024, vdst=lds0+LDS_V+wid*1024;
  #define DMA_K(t,slot) glds16(ksrc+(long)(t)*KVBLK*DM,(unsigned)__builtin_amdgcn_readfirstlane(kdst+(slot)))
  #define DMA_V(t,slot) glds16(vsrc+(long)(t)*KVBLK*DM,(unsigned)__builtin_amdgcn_readfirstlane(vdst+(slot)))
  const int vb0=(int)(lds0+LDS_V)+((lane>>4)&1)*32+(lane&3)*8+(4*hi+((lane&15)>>2))*64;
  const char*Kbase=shm+LDS_K; bf16x8 kf[8];
  const lds_cptr shm3=(lds_cptr)shm; const lds_cptr kp0=shm3+LDS_K+hi*1024+r32*16; const lds_cptr vp0=shm3+LDS_V+((lane>>4)&1)*32+(lane&3)*8+(4*hi+((lane&15)>>2))*64;
  const int NT=(q0+QB)/KVBLK;
  DMA_K(0,0);DMA_V(0,0);DMA_K(1,SLOTB);
  bf16x8 qr[4];
  #pragma unroll
  for(int d0=0;d0<4;++d0)qr[d0]=*reinterpret_cast<const bf16x8*>(&Qw[(long)r32*DM+d0*16+hi*8]);
  float mhat=0.f,l_reg=0.f;f32x16 o[2];o[0]=f32x16{};o[1]=f32x16{};f32x16 negm=f32x16{};asm volatile("":"+v"(negm));
  const int qrel=wid*QBLK+r32;
  #define CMASK(P0,P1,t) do{int jb_=(t)-(NT-4); if(jb_>=0)cmask(P0,P1,jb_,wid);}while(0)
  bool resc=false;
  #define START(P0,P1) do{ const float rm=rowmax(P0,P1); resc=false; \
    { const float dl=rm; mhat=fadd_s(mhat,dl); \
      _Pragma("unroll") for(int r=0;r<16;++r){P0[r]=fsub_s(P0[r],dl);P1[r]=fsub_s(P1[r],dl);} \
      _Pragma("unroll") for(int r=0;r<16;++r)negm[r]=-mhat; asm volatile("":"+v"(negm)); } \
    _Pragma("unroll") for(int r=0;r<16;++r)P0[r]=__builtin_amdgcn_exp2f(P0[r]); }while(0)
  #define RESC() do{ if(resc){ asm volatile("s_waitcnt lgkmcnt(0)":::"memory"); \
      _Pragma("unroll") for(int d_=0;d_<2;++d_) _Pragma("unroll") for(int r=0;r<16;++r)o[d_][r]*=wsf[crow(r,hi)]; } }while(0)
  f32x16 pA0,pA1,pB0,pB1;
  int sl_prev=0,sl_cur=0,sl_next=SLOTB;
  #define ROT() do{sl_prev=sl_cur;sl_cur=sl_next;sl_next=(sl_next==(NSLOT-1)*SLOTB)?0:sl_next+SLOTB;}while(0)
  DMA_K(2,2*SLOTB);
  WAIT_BAR(3);
  qkt(pA0,pA1,Kbase,qr,negm,r32,hi);asm volatile("s_nop 15\n\ts_nop 7":"+v"(pA0),"+v"(pA1));CMASK(pA0,pA1,0);
  START(pA0,pA1);
  _Pragma("unroll") for(int r=0;r<16;++r)pA1[r]=__builtin_amdgcn_exp2f(pA1[r]);
  WAIT_BAR(0);
  DMA_K(3,0);DMA_V(1,SLOTB);
  ROT();
  kload8(kf,kp0+sl_cur);
  WAIT_BAR(2);
  s16x4 vlo[8],vhi[8]; u32x4 pw0,pw1,pw2,pw3;
  #define PKW(P,B) cvtpk_s(P[B],P[B+1])
  #define PAF(k) __builtin_bit_cast(bf16x8,pw##k)
  #define VFR(i) (bf16x8){vlo[i][0],vlo[i][1],vlo[i][2],vlo[i][3],vhi[i][0],vhi[i][1],vhi[i][2],vhi[i][3]}
  #define PIN(x) asm volatile("":"+v"(x))
  #define MX3(a,b,c) __builtin_fmaxf(__builtin_fmaxf((a),(b)),(c))
  #define GAPA(MF,A0,A1,A2,A3,W0,W1,PW) do{ MF; sacc+=A0; sacc+=A1; sacc+=A2; sacc+=A3; PIN(sacc); W0; W1; PIN(PW); SBAR(); }while(0)
  #define EX(v) __builtin_amdgcn_exp2f(v)
  #define GAPB(MF,X,B) do{ MF; X[B]=EX(X[B]); X[B+1]=EX(X[B+1]); X[B+2]=EX(X[B+2]); X[B+3]=EX(X[B+3]); PIN(X); SBAR(); }while(0)
  #define VRD(i) do{ vlo[i]=vtr(vp_+(((i)>>2)*4096+((i)&3)*1024)); vhi[i]=vtr(vp_+(((i)>>2)*4096+((i)&3)*1024+512)); }while(0)
  #define KRD(G,j) do{ if(G){ kload2(kf,kp0+sl_next,j); SBAR(); } }while(0)
  #define STEP(C0,C1,P0,P1,t,GK,GV,GL) do{ SBAR(); \
    const lds_cptr vp_=vp0+sl_prev; \
    VRD(0); SBAR(); float sacc=(P0[0]+P0[1]); \
    GAPA(C0=__builtin_amdgcn_mfma_f32_32x32x16_bf16(kf[0],qr[0],negm,0,0,0), P0[2],P0[3],P0[4],P0[5],     pw0[0]=PKW(P0,0), pw0[1]=PKW(P0,2), pw0); \
    VRD(4); SBAR(); GAPA(C1=__builtin_amdgcn_mfma_f32_32x32x16_bf16(kf[1],qr[0],negm,0,0,0), P0[6],P0[7],P0[8],P0[9],     pw0[2]=PKW(P0,4), pw0[3]=PKW(P0,6), pw0); \
    VRD(1); SBAR(); GAPA(C0=__builtin_amdgcn_mfma_f32_32x32x16_bf16(kf[2],qr[1],C0,0,0,0),   P0[10],P0[11],P0[12],P0[13], pw1[0]=PKW(P0,8), pw1[1]=PKW(P0,10), pw1); \
    VRD(5); SBAR(); GAPA(C1=__builtin_amdgcn_mfma_f32_32x32x16_bf16(kf[3],qr[1],C1,0,0,0),   P0[14],P0[15],P1[0],P1[1],   pw1[2]=PKW(P0,12),pw1[3]=PKW(P0,14), pw1); \
    VRD(2); SBAR(); GAPA(C0=__builtin_amdgcn_mfma_f32_32x32x16_bf16(kf[4],qr[2],C0,0,0,0),   P1[2],P1[3],P1[4],P1[5],     pw2[0]=PKW(P1,0), pw2[1]=PKW(P1,2), pw2); \
    VRD(6); SBAR(); GAPA(C1=__builtin_amdgcn_mfma_f32_32x32x16_bf16(kf[5],qr[2],C1,0,0,0),   P1[6],P1[7],P1[8],P1[9],     pw2[2]=PKW(P1,4), pw2[3]=PKW(P1,6), pw2); \
    VRD(3); SBAR(); GAPA(C0=__builtin_amdgcn_mfma_f32_32x32x16_bf16(kf[6],qr[3],C0,0,0,0),   P1[10],P1[11],P1[12],P1[13], pw3[0]=PKW(P1,8), pw3[1]=PKW(P1,10), pw3); \
    VRD(7); SBAR(); GAPA(C1=__builtin_amdgcn_mfma_f32_32x32x16_bf16(kf[7],qr[3],C1,0,0,0),   P1[14],P1[15],0.f,0.f,       pw3[2]=PKW(P1,12),pw3[3]=PKW(P1,14), pw3); \
    l_reg+=sacc; \
    if(GK){DMA_K((t)+3,sl_cur);} if(GV){DMA_V((t)+1,sl_next);} \
    CMASK(C0,C1,t); \
    { float a=MX3(C0[0],C0[1],C1[0]),b=MX3(C0[2],C0[3],C1[1]); a=MX3(a,C1[2],C1[3]); \
      _Pragma("unroll") for(int r=4;r<16;r+=4){a=MX3(a,C0[r],C0[r+1]);b=MX3(b,C0[r+2],C0[r+3]);a=MX3(a,C1[r],C1[r+1]);b=MX3(b,C1[r+2],C1[r+3]);} \
      float rm=__builtin_fmaxf(a,b); { auto rr=__builtin_amdgcn_permlane32_swap(__float_as_uint(rm),__float_as_uint(rm),false,false); rm=__builtin_fmaxf(__uint_as_float(rr[0]),__uint_as_float(rr[1])); } \
      resc=false; \
      if(__builtin_expect(__any(rm>(float)THRL),0)){ const float dl=__builtin_fmaxf(rm,0.f); mhat+=dl; \
        _Pragma("unroll") for(int r=0;r<16;++r){C0[r]-=dl;C1[r]-=dl;} \
        _Pragma("unroll") for(int r=0;r<16;++r)negm[r]=-mhat; asm volatile("":"+v"(negm)); \
        const float f=__builtin_amdgcn_exp2f(-dl); l_reg*=f; if(hi==0)wsf[r32]=f; resc=true; } } \
    SBAR(); \
    GAPB(o[0]=__builtin_amdgcn_mfma_f32_32x32x16_bf16(PAF(0),VFR(0),o[0],0,0,0), C0,0); \
    GAPB(o[1]=__builtin_amdgcn_mfma_f32_32x32x16_bf16(PAF(0),VFR(4),o[1],0,0,0), C0,4); \
    KRD(GL,0); GAPB(o[0]=__builtin_amdgcn_mfma_f32_32x32x16_bf16(PAF(1),VFR(1),o[0],0,0,0), C0,8); \
    KRD(GL,1); GAPB(o[1]=__builtin_amdgcn_mfma_f32_32x32x16_bf16(PAF(1),VFR(5),o[1],0,0,0), C0,12); \
    KRD(GL,2); GAPB(o[0]=__builtin_amdgcn_mfma_f32_32x32x16_bf16(PAF(2),VFR(2),o[0],0,0,0), C1,0); \
    KRD(GL,3); GAPB(o[1]=__builtin_amdgcn_mfma_f32_32x32x16_bf16(PAF(2),VFR(6),o[1],0,0,0), C1,4); \
    GAPB(o[0]=__builtin_amdgcn_mfma_f32_32x32x16_bf16(PAF(3),VFR(3),o[0],0,0,0), C1,8); \
    GAPB(o[1]=__builtin_amdgcn_mfma_f32_32x32x16_bf16(PAF(3),VFR(7),o[1],0,0,0), C1,12); \
    }while(0)
  int t=1;
  #undef CMASK
  #define CMASK(P0,P1,t) do{}while(0)
  for(;t+5<NT;t+=2){
    STEP(pB0,pB1,pA0,pA1,t,true,true,true);     WAIT_BAR(2); RESC(); ROT();
    STEP(pA0,pA1,pB0,pB1,t+1,true,true,true);   WAIT_BAR(2); RESC(); ROT();
  }
  #undef CMASK
  #define CMASK(P0,P1,t) do{int jb_=(t)-(NT-4); if(jb_>=0)cmask(P0,P1,jb_,wid);}while(0)
  #define ENDW(tt) do{ if((tt)+3<NT){WAIT_BAR(2);} else if((tt)+2<NT){WAIT_BAR(1);} else {WAIT_BAR(0);} }while(0)
  for(;t+1<NT;t+=2){
    STEP(pB0,pB1,pA0,pA1,t,(t+3<NT),(t+1<NT),(t+1<NT));       ENDW(t);   RESC(); ROT();
    STEP(pA0,pA1,pB0,pB1,t+1,(t+4<NT),(t+2<NT),(t+2<NT));     ENDW(t+1); RESC(); ROT();
  }
  STEP(pB0,pB1,pA0,pA1,NT-1,false,false,false); RESC();
  { float sacc=pB0[0]+pB0[1]; _Pragma("unroll") for(int r=2;r<16;++r)sacc+=pB0[r]; _Pragma("unroll") for(int r=0;r<16;++r)sacc+=pB1[r]; l_reg+=sacc;
    pw0=(u32x4){PKW(pB0,0),PKW(pB0,2),PKW(pB0,4),PKW(pB0,6)};pw1=(u32x4){PKW(pB0,8),PKW(pB0,10),PKW(pB0,12),PKW(pB0,14)};pw2=(u32x4){PKW(pB1,0),PKW(pB1,2),PKW(pB1,4),PKW(pB1,6)};pw3=(u32x4){PKW(pB1,8),PKW(pB1,10),PKW(pB1,12),PKW(pB1,14)};
    SBAR(); pv(o,vb0+sl_cur,PAF(0),PAF(1),PAF(2),PAF(3)); }
  #undef PKW
  #undef PAF
  #undef VFR
  #undef PIN
  #undef MX3
  #undef GAPA
  #undef GAPB
  #undef EX
  #undef VRD
  #undef KRD
  #undef STEP
  #undef ENDW
  {auto rr=__builtin_amdgcn_permlane32_swap(__float_as_uint(l_reg),__float_as_uint(l_reg),false,false);l_reg=__uint_as_float(rr[0])+__uint_as_float(rr[1]);}
  if(hi==0)wsf[32+r32]=l_reg;asm volatile("s_waitcnt lgkmcnt(0)":::"memory");
  float rli[16];
  #pragma unroll
  for(int r=0;r<16;++r)rli[r]=__builtin_amdgcn_rcpf(wsf[32+crow(r,hi)]);
  bf16*Ow=O+(rowbase+q0+wid*QBLK)*1024+ocol;
  { bf16*stg=(bf16*)(shm+LDS_OST)+wid*2048;
    #pragma unroll
    for(int r=0;r<16;++r){const int orow=crow(r,hi);
      #pragma unroll
      for(int d0=0;d0<2;++d0)stg[orow*64+d0*32+r32]=__float2bfloat16(o[d0][r]*rli[r]);}
    asm volatile("s_waitcnt lgkmcnt(0)":::"memory");
    #pragma unroll
    for(int i=0;i<4;++i){const int row=i*8+(lane>>3),ch=lane&7; const u32x4 v=*(const u32x4*)(stg+row*64+ch*8); ATTN_STORE16(Ow+(long)row*1024+ch*8,v);} }
  asm volatile("s_waitcnt lgkmcnt(0)\n\ts_barrier":::"memory");
  #undef DMA_K
  #undef DMA_V
  #undef CMASK
  #undef START
  #undef RESC
  #undef ROT
}
constexpr int ATTN_LDS_BYTES=LDS_BYTES;
#undef SBAR
#undef WAIT_BAR
}
#ifndef MK_MULTI
#define MK_MULTI 0
#endif
#ifndef REP_SYNC
#define REP_SYNC 0
#endif
#ifndef REP_FOLD
#define REP_FOLD 1
#endif
#ifndef REP_SLACK
#define REP_SLACK 1
#endif
#ifndef SLACK_W
#define SLACK_W 1
#endif
constexpr int NWAVES = 8, NPH = 14;
constexpr int MT = pg8::MT, MP = pg8::MP, DM_ = 1024, INW = 2304, DFF = 2816;
constexpr size_t MiB = 1u << 20;
constexpr size_t WS_TAB = 1 * MiB;
constexpr size_t WS_LAM = 2 * MiB;
constexpr size_t WS_SS = 3 * MiB;
constexpr size_t WS_WIN = 5 * MiB, WS_WOUT = 14 * MiB, WS_WGU = 18 * MiB, WS_WDN = 40 * MiB;
constexpr size_t WS_XB = 52 * MiB;
constexpr size_t WS_SPO = 86 * MiB;
constexpr size_t WS_SPM = 95 * MiB;
constexpr size_t WS_Q = 96 * MiB, WS_K = 113 * MiB, WS_V = 130 * MiB, WS_UP = 147 * MiB, WS_UC = 156 * MiB, WS_O4 = 165 * MiB, WS_MIX = 197 * MiB;
constexpr size_t WS_H = 96 * MiB;
constexpr size_t WS_END = 230 * MiB;
static_assert(WS_H + (size_t)MT * DFF * 2 <= WS_MIX && WS_MIX + (size_t)MT * 1024 * 2 <= WS_END, "ws map");
constexpr size_t O_Y = 0, O_KP = 17039360, O_VP = 33816576, O_PP = 50593792, O_CP = 50655232, O_KS = 50778112, O_VS = 51040256, O_PS = 51302400, O_CS = 51363840, O_END = 51486720;
constexpr int LDS_BYTES = 147456;

#define LAS __attribute__((address_space(3)))
typedef unsigned short bf16;
typedef unsigned v4u __attribute__((ext_vector_type(4)));
typedef unsigned v2u __attribute__((ext_vector_type(2)));
typedef float f32x4 __attribute__((ext_vector_type(4)));
typedef float f32x16 __attribute__((ext_vector_type(16)));
typedef short bf16x8 __attribute__((ext_vector_type(8)));
__device__ __forceinline__ unsigned f2bf(float f) { unsigned u = __builtin_bit_cast(unsigned, f); return (u + 0x7fffu + ((u >> 16) & 1u)) >> 16; }
__device__ __forceinline__ unsigned pk2(float lo, float hi) { return f2bf(lo) | (f2bf(hi) << 16); }
__device__ __forceinline__ float bflo(unsigned w) { return __builtin_bit_cast(float, w << 16); }
__device__ __forceinline__ float bfhi(unsigned w) { return __builtin_bit_cast(float, w & 0xffff0000u); }
__device__ __forceinline__ float wave_sum(float v) {
#pragma unroll
    for (int o = 1; o < 64; o <<= 1) v += __shfl_xor(v, o);
    return v;
}
struct Args { const float* in[22]; float* out; unsigned char* ws; int ph_lo, ph_hi; };
struct Frame { int tid, lane, wave, vcu, G, gw, NGW; };

#define XB_TMO      128
#define XB_XCNT(j)  (256  + 64 * (j))
#define XB_XSUB(j)  (1280 + 64 * (j))
#define XB_XGEN(j)  (2304 + 64 * (j))
#define XB_TOP      3328
#define XB_TOPGEN   3392
#define XCD_BAR_WORDS 3456
#define XB_SPIN_CAP (1u << 18)

__device__ __forceinline__ unsigned xb_ld(unsigned* p)              { return __hip_atomic_load(p, __ATOMIC_RELAXED, __HIP_MEMORY_SCOPE_AGENT); }
__device__ __forceinline__ unsigned xb_add(unsigned* p, unsigned v) { return __hip_atomic_fetch_add(p, v, __ATOMIC_RELAXED, __HIP_MEMORY_SCOPE_AGENT); }
__device__ __forceinline__ unsigned xb_xcc_id() { return (unsigned)__builtin_amdgcn_s_getreg((3 << 11) | 20) & 0xFu; }
#define XB_SPIN(cond, bar) do { unsigned _sp = 0; while (cond) { __builtin_amdgcn_s_sleep(1); \
    if ((++_sp & 255u) == 0u) { if (xb_ld(&(bar)[XB_TMO])) break; if (_sp > XB_SPIN_CAP) { atomicAdd(&(bar)[XB_TMO], 1u); break; } } } } while (0)

struct XcdBarrier {
    unsigned* bar; unsigned x;
    volatile LAS unsigned* st;
};

__device__ __forceinline__ XcdBarrier xcd_barrier_post(unsigned* bar, volatile LAS unsigned* st) {
    XcdBarrier b; b.bar = bar; b.x = xb_xcc_id(); b.st = st;
    if (threadIdx.x == 0) (void)xb_add(&bar[XB_XCNT(b.x)], 1u);
    return b;
}
__device__ __forceinline__ void xcd_barrier_complete(unsigned* bar, unsigned x, unsigned& nloc, unsigned& nx) {
    const unsigned G = gridDim.x * gridDim.y * gridDim.z;
    unsigned sum, cnt, mine, sp = 0u;
    for (;;) {
        sum = 0u; cnt = 0u; mine = 0u;
#pragma unroll
        for (unsigned j = 0; j < 16; ++j) { const unsigned c = xb_ld(&bar[XB_XCNT(j)]); sum += c; cnt += (c > 0u) ? 1u : 0u; mine = (j == x) ? c : mine; }
        if (sum == G) break;
        __builtin_amdgcn_s_sleep(1);
        if ((++sp & 255u) == 0u) { if (xb_ld(&bar[XB_TMO])) break; if (sp > XB_SPIN_CAP) { atomicAdd(&bar[XB_TMO], 1u); break; } }
    }
    nloc = mine > 0u ? mine : 1u; nx = cnt > 0u ? cnt : 1u;
}

__device__ __forceinline__ void xcd_barrier(const XcdBarrier& b) {
    asm volatile("s_waitcnt vmcnt(0)" ::: "memory");
    __syncthreads();
    if (threadIdx.x == 0) {
        unsigned* bar = b.bar;
        __builtin_amdgcn_s_waitcnt(0);
        unsigned nloc = b.st[0], nx = b.st[1];
        if (nloc == 0u) { xcd_barrier_complete(bar, b.x, nloc, nx); b.st[0] = nloc; b.st[1] = nx; }
        const unsigned old = xb_add(&bar[XB_XSUB(b.x)], 1u);
        const unsigned gen = old / nloc;
        if (old + 1u == (gen + 1u) * nloc) {
            __builtin_amdgcn_fence(__ATOMIC_RELEASE, "agent");
            asm volatile("s_waitcnt vmcnt(0)" ::: "memory");
            const unsigned og = xb_add(&bar[XB_TOP], 1u);
            const unsigned tg = og / nx;
            if (og + 1u == (tg + 1u) * nx) xb_add(&bar[XB_TOPGEN], 1u);
            else XB_SPIN(xb_ld(&bar[XB_TOPGEN]) == tg, bar);
            __builtin_amdgcn_fence(__ATOMIC_ACQUIRE, "agent");
            xb_add(&bar[XB_XGEN(b.x)], 1u);
            asm volatile("s_waitcnt vmcnt(0)" ::: "memory");
        } else {
            XB_SPIN(xb_ld(&bar[XB_XGEN(b.x)]) == gen, bar);
            __builtin_amdgcn_fence(__ATOMIC_ACQUIRE, "agent");
            asm volatile("s_waitcnt vmcnt(0)" ::: "memory");
        }
    }
    __syncthreads();
}

constexpr int MISC_OFF = 147200;
__device__ __forceinline__ int perm_in(int n) {
    if (n < 256) return n;
    if (n < 1280) { const int p = n & 63, j = p >> 3, nn = (p >> 2) & 1, i = p & 3; return (n & ~63) + 32 * nn + 4 * j + i; }
    if (n < 1792) return n;
    const int x = n - 1792, T = x >> 8, bj = (x >> 7) & 1, cc = x & 127; return 1792 + 256 * bj + 128 * T + cc;
}
__device__ __forceinline__ int perm_gu(int n) { const int T = n >> 8, bj = (n >> 7) & 1, cc = n & 127; return 2816 * bj + 128 * T + cc; }
template <int MODE> __device__ __forceinline__ void transpose_item(const float* W, int ldw, const float* gk, bf16* WT, int ldwt, int koff, int nblk, LAS float* scr, int item, int lane) {
    (void)scr;
    const int kb = item / nblk, nb = item % nblk, k0 = 64 * kb, np = 64 * nb + lane;
    const int src = (MODE == 1) ? perm_in(np) : (MODE == 2) ? perm_gu(np) : np;
    const float* wp = W + (size_t)k0 * ldw + src;
    float v[64];
#pragma unroll
    for (int t = 0; t < 64; ++t) v[t] = wp[(size_t)t * ldw];
    __builtin_amdgcn_sched_barrier(0);
    bf16* op = WT + (size_t)np * ldwt + koff + k0;
#pragma unroll
    for (int kc = 0; kc < 8; ++kc) {
        float g[8];
#pragma unroll
        for (int t = 0; t < 8; ++t) g[t] = gk ? gk[k0 + 8 * kc + t] : 1.0f;
        v4u o; o.x = pg8::cvt_pk_bf16(v[8 * kc] * g[0], v[8 * kc + 1] * g[1]); o.y = pg8::cvt_pk_bf16(v[8 * kc + 2] * g[2], v[8 * kc + 3] * g[3]);
        o.z = pg8::cvt_pk_bf16(v[8 * kc + 4] * g[4], v[8 * kc + 5] * g[5]); o.w = pg8::cvt_pk_bf16(v[8 * kc + 6] * g[6], v[8 * kc + 7] * g[7]);
        *(v4u*)(op + 8 * kc) = o; }
}
__device__ __forceinline__ void fold_item(const float* pool_w, const float* pool_scale, const float* conv_pw, const float* w_out, bf16* WT, LAS float* scr, int item, int lane) {
    const int kb = item >> 4, nb = item & 15, n = nb * 64 + lane;
    float acc[8];
#pragma unroll
    for (int i = 0; i < 8; ++i) acc[i] = 0.f;
    int k0, D, rb;
    if (kb < 32) { k0 = kb * 8; D = 64; const int g = k0 >> 6; rb = 64 * g; const float ps = pool_scale[64 * g + lane];
        float pw[8];
#pragma unroll
        for (int i = 0; i < 8; ++i) pw[i] = pool_w[(size_t)(g * 64 + ((k0 + i) & 63)) * 64 + lane];
        __builtin_amdgcn_sched_barrier(0);
#pragma unroll
        for (int i = 0; i < 8; ++i) scr[i * 64 + lane] = pw[i] * ps;
    } else { k0 = 768 + (kb - 32) * 8; D = 256; rb = 768;
        f32x4 cw[8];
#pragma unroll
        for (int i = 0; i < 8; ++i) cw[i] = *(const f32x4*)(conv_pw + (size_t)(k0 - 768 + i) * 256 + 4 * lane);
        __builtin_amdgcn_sched_barrier(0);
#pragma unroll
        for (int i = 0; i < 8; ++i) *(LAS f32x4*)(scr + i * 256 + 4 * lane) = cw[i];
    }
    asm volatile("s_waitcnt lgkmcnt(0)" ::: "memory");
    const float* wp = w_out + (size_t)rb * 1024 + n;
#pragma unroll 1
    for (int d = 0; d < D; d += 32) {
        float wv[32];
#pragma unroll
        for (int q = 0; q < 32; ++q) wv[q] = wp[(size_t)(d + q) * 1024];
        __builtin_amdgcn_sched_barrier(0);
#pragma unroll
        for (int q = 0; q < 32; q += 4)
#pragma unroll
            for (int i = 0; i < 8; ++i) { const f32x4 cf = *(const LAS f32x4*)(scr + i * D + d + q); acc[i] += (cf.x * wv[q] + cf.y * wv[q + 1]) + (cf.z * wv[q + 2] + cf.w * wv[q + 3]); }
        __builtin_amdgcn_sched_barrier(0);
    }
    asm volatile("s_waitcnt lgkmcnt(0)" ::: "memory");
    v4u o; o.x = pk2(acc[0], acc[1]); o.y = pk2(acc[2], acc[3]); o.z = pk2(acc[4], acc[5]); o.w = pk2(acc[6], acc[7]);
    *(v4u*)(WT + (size_t)n * 1024 + k0) = o;
}
constexpr int WI_A = 576, WI_B = 3840, WI_C = 5568, WI_END = 7680;
__device__ __forceinline__ void wi_in(const Args& A, LAS float* scr, int lane, int l, int it) { transpose_item<1>(A.in[7] + (size_t)l * 1024 * INW, INW, A.in[6] + l * 1024, (bf16*)(A.ws + WS_WIN) + (size_t)l * INW * 1024, 1024, 0, INW / 64, scr, it, lane); }
__device__ __forceinline__ void wi_gu(const Args& A, LAS float* scr, int lane, int l, int it) { transpose_item<2>(A.in[19] + (size_t)l * 1024 * 2 * DFF, 2 * DFF, A.in[18] + l * 1024, (bf16*)(A.ws + WS_WGU) + (size_t)l * 2 * DFF * 1024, 1024, 0, 2 * DFF / 64, scr, it, lane); }
__device__ __forceinline__ void wi_dn(const Args& A, LAS float* scr, int lane, int l, int it) { transpose_item<0>(A.in[20] + (size_t)l * DFF * 1024, 1024, nullptr, (bf16*)(A.ws + WS_WDN) + (size_t)l * 1024 * DFF, DFF, 0, 1024 / 64, scr, it, lane); }
__device__ __forceinline__ void wi_mid(const Args& A, LAS float* scr, int lane, int l, int it) { transpose_item<0>(A.in[17] + (size_t)l * 1024 * 1024 + 256 * 1024, 1024, nullptr, (bf16*)(A.ws + WS_WOUT) + (size_t)l * 1024 * 1024, 1024, 256, 1024 / 64, scr, it, lane); }
__device__ __forceinline__ void wi_fold(const Args& A, LAS float* scr, int lane, int l, int it) { fold_item(A.in[8] + (size_t)l * 4 * 64 * 64, A.in[9] + l * 256, A.in[16] + (size_t)l * 256 * 256, A.in[17] + (size_t)l * 1024 * 1024, (bf16*)(A.ws + WS_WOUT) + (size_t)l * 1024 * 1024, scr, it, lane); }
__device__ __forceinline__ void weight_items(const Args& A, LAS float* scr, int lane, int first, int last, int w0, int nw) {
#pragma unroll 1
    for (int idx = first + w0; idx < last; idx += nw) {
        if (idx < WI_A) wi_in(A, scr, lane, 0, idx);
        else if (idx < WI_B) { const int a = idx - WI_A; if (a < 1408) wi_gu(A, scr, lane, 0, a); else if (a < 2112) wi_dn(A, scr, lane, 0, a - 1408); else if (a < 2240) wi_mid(A, scr, lane, 0, a - 2112); else wi_fold(A, scr, lane, 0, a - 2240); }
        else if (idx < WI_C) { const int b2 = idx - WI_B; if (b2 < 576) wi_in(A, scr, lane, 1, b2); else if (b2 < 704) wi_mid(A, scr, lane, 1, b2 - 576); else wi_fold(A, scr, lane, 1, b2 - 704); }
        else { const int c2 = idx - WI_C; if (c2 < 1408) wi_gu(A, scr, lane, 1, c2); else wi_dn(A, scr, lane, 1, c2 - 1408); }
    }
}
__device__ __forceinline__ void slack_weights(const Frame& F, const Args& A, LAS unsigned char* lds, int nwg, int first, int last) {
    const int rounds = (nwg + F.G - 1) / F.G, nfull = nwg - (rounds - 1) * F.G, c = (int)blockIdx.x;
    int sl = F.lane; asm volatile("" : "+v"(sl));
    LAS float* scr = (LAS float*)(lds + F.wave * 16640);
    if (nfull >= F.G) weight_items(A, scr, sl, first, last, F.gw, F.NGW);
    else if (c >= nfull) weight_items(A, scr, sl, first, last, (c - nfull) * NWAVES + F.wave, (F.G - nfull) * NWAVES);
    __syncthreads();
}
__device__ __forceinline__ void p0_prologue(const Frame& F, const Args& A, LAS unsigned char* lds) {
    unsigned char* ws = A.ws;
    LAS float* scr = (LAS float*)(lds + F.wave * 16640);
    int lane_l = F.lane; asm volatile("" : "+v"(lane_l)); const int gw = F.gw, NGW = F.NGW, lane = lane_l;
    weight_items(A, scr, lane, 0, SLACK_W ? WI_A : WI_END, gw, NGW);
    { bf16* XB = (bf16*)(ws + WS_XB); float* SS = (float*)(ws + WS_SS);
      for (int m0 = gw * 2; m0 < MT; m0 += NGW * 2) {
        f32x4 v[2][4];
#pragma unroll
        for (int q = 0; q < 2; ++q) { const int m = m0 + q; const float* xr = (m < MP) ? A.in[0] + (size_t)m * 1024 : A.in[1] + (size_t)(m - MP) * 1024;
#pragma unroll
            for (int j = 0; j < 4; ++j) v[q][j] = *((const f32x4*)xr + lane + 64 * j); }
        __builtin_amdgcn_sched_barrier(0);
#pragma unroll
        for (int q = 0; q < 2; ++q) { const int m = m0 + q; float s = 0.f;
#pragma unroll
            for (int j = 0; j < 4; ++j) { const f32x4 w = v[q][j]; s += (w.x * w.x + w.y * w.y) + (w.z * w.z + w.w * w.w);
                v2u o; o.x = pk2(w.x, w.y); o.y = pk2(w.z, w.w); *((v2u*)(XB + (size_t)m * 1024) + lane + 64 * j) = o; }
            s = wave_sum(s);
            if (lane < 16) SS[(size_t)lane * MT + m] = (lane == 0) ? s : 0.f;
            if (m >= MP && lane < 32) SS[(size_t)16 * MT + lane * 256 + (m - MP)] = (lane == 0) ? s : 0.f; }
      } }
    { float* TAB = (float*)(ws + WS_TAB);
      for (int i = gw * 64 + lane; i < 2080 * 32; i += NGW * 64) { const int pos = i >> 5, f = i & 31;
        const float inv = powf(10000.0f, -(float)f / 32.0f); const float ang = (float)pos * inv; float sv, cv; sincosf(ang, &sv, &cv);
        TAB[pos * 64 + f] = cv; TAB[pos * 64 + 32 + f] = sv; } }
    if (gw < 2) { const float* lq = A.in[10] + gw * 256; const float a = wave_sum(lq[lane] * lq[64 + lane]), b = wave_sum(lq[128 + lane] * lq[192 + lane]);
        const float lam_init = 0.8f - 0.6f * expf(-0.3f * (float)gw);
        if (lane == 0) ((float*)(ws + WS_LAM))[gw] = expf(a) - expf(b) + lam_init; }
}

__device__ __forceinline__ int crow(int r, int hi) { return (r & 3) + 8 * (r >> 2) + 4 * hi; }
__device__ __forceinline__ void sample_attn_unit(const Frame& F, const Args& A, int l, int bh, int split, LAS unsigned char* lds) {
    int lane_l = F.lane; asm volatile("" : "+v"(lane_l)); const int b = bh >> 2, h = bh & 3, lane = lane_l, wid = F.wave, r32 = lane & 31, hi = lane >> 5;
    LAS unsigned short* PL = (LAS unsigned short*)lds;
    LAS float* OX = (LAS float*)(lds + 20480);
    LAS float* MB = (LAS float*)(lds + 40960);
    LAS float* LB = MB + 256;
    const bool last = (split == 7), two = last && (wid == 7);
    const int eb = wid & 3, kh = wid >> 2, nks = (last && kh == 1) ? 10 : 8;
    const size_t cro = ((size_t)(l * 8 + b) * 2048 + split * 256) * 512 + h * 128, nro = ((size_t)(l * 8 + b) * 32) * 512 + h * 128;
    const float* Kc = A.in[2] + cro; const float* Vc = A.in[3] + cro;
    const float* Kn = A.out + O_KS + nro; const float* Vn = A.out + O_VS + nro;
    const bf16* Qrow = (const bf16*)(A.ws + WS_Q) + (size_t)(MP + b * 32 + r32) * 512 + h * 128;
    bf16x8 vfr[10];
    { float t[10][8];
#pragma unroll
      for (int ks = 0; ks < 10; ++ks)
#pragma unroll
        for (int j = 0; j < 8; ++j) { const float* vp = (ks < 8) ? Vc + (size_t)(128 * kh + 16 * ks + 8 * hi + j) * 512 : Vn + (size_t)(16 * (ks - 8) + 8 * hi + j) * 512;
            t[ks][j] = (ks < nks) ? __builtin_nontemporal_load(vp + 32 * eb + r32) : 0.f; }
      __builtin_amdgcn_sched_barrier(0);
#pragma unroll
      for (int ks = 0; ks < 10; ++ks) { v4u w; w.x = pk2(t[ks][0], t[ks][1]); w.y = pk2(t[ks][2], t[ks][3]); w.z = pk2(t[ks][4], t[ks][5]); w.w = pk2(t[ks][6], t[ks][7]); vfr[ks] = __builtin_bit_cast(bf16x8, w); }
      __builtin_amdgcn_sched_barrier(0); }
    float* SPO = (float*)(A.ws + WS_SPO); float* SPM = (float*)(A.ws + WS_SPM);
    for (int c = 0; c < 2; ++c) {
        f32x16 s[2]; s[0] = f32x16{}; s[1] = f32x16{};
        bf16x8 qf[4];
        { v2u q0[4], q1[4]; f32x4 ka[2][4], kb[2][4];
#pragma unroll
          for (int d0 = 0; d0 < 4; ++d0) { const bf16* qp = Qrow + c * 64 + 32 * (d0 & 1) + 16 * hi + 4 * (d0 >> 1); q0[d0] = *(const v2u*)qp; q1[d0] = *(const v2u*)(qp + 8);
              const float* kp = Kc + (size_t)(32 * wid + r32) * 512 + c * 64 + 16 * d0 + 8 * hi; ka[0][d0] = __builtin_nontemporal_load((const f32x4*)kp); kb[0][d0] = __builtin_nontemporal_load((const f32x4*)(kp + 4));
              const float* kn = Kn + (size_t)r32 * 512 + c * 64 + 16 * d0 + 8 * hi;
              ka[1][d0] = two ? *(const f32x4*)kn : (f32x4){0.f, 0.f, 0.f, 0.f}; kb[1][d0] = two ? *(const f32x4*)(kn + 4) : (f32x4){0.f, 0.f, 0.f, 0.f}; }
          __builtin_amdgcn_sched_barrier(0);
#pragma unroll
          for (int d0 = 0; d0 < 4; ++d0) { v4u qw; qw.x = q0[d0].x; qw.y = q0[d0].y; qw.z = q1[d0].x; qw.w = q1[d0].y; qf[d0] = __builtin_bit_cast(bf16x8, qw); }
#pragma unroll
          for (int ch = 0; ch < 2; ++ch) if (ch == 0 || two) {
#pragma unroll
              for (int d0 = 0; d0 < 4; ++d0) { v4u kw; kw.x = pk2(ka[ch][d0].x, ka[ch][d0].y); kw.y = pk2(ka[ch][d0].z, ka[ch][d0].w); kw.z = pk2(kb[ch][d0].x, kb[ch][d0].y); kw.w = pk2(kb[ch][d0].z, kb[ch][d0].w);
                  s[ch] = __builtin_amdgcn_mfma_f32_32x32x16_bf16(__builtin_bit_cast(bf16x8, kw), qf[d0], s[ch], 0, 0, 0); } } }
        float m = s[0][0];
#pragma unroll
        for (int r = 1; r < 16; ++r) m = fmaxf(m, s[0][r]);
        if (two) {
#pragma unroll
            for (int r = 0; r < 16; ++r) m = fmaxf(m, s[1][r]); }
        m = fmaxf(m, __shfl_xor(m, 32));
        if (hi == 0) MB[wid * 32 + r32] = m;
        __syncthreads();
        float M = MB[r32];
#pragma unroll
        for (int w = 1; w < 8; ++w) M = fmaxf(M, MB[w * 32 + r32]);
        float lsum = 0.f;
#pragma unroll
        for (int ch = 0; ch < 2; ++ch) if (ch == 0 || two) {
#pragma unroll
            for (int r = 0; r < 16; ++r) { s[ch][r] = __builtin_amdgcn_exp2f(s[ch][r] - M); lsum += s[ch][r]; }
            const int kbase = (ch == 0) ? 32 * wid : 256;
#pragma unroll
            for (int t = 0; t < 4; ++t) { v2u w; w.x = pk2(s[ch][4 * t], s[ch][4 * t + 1]); w.y = pk2(s[ch][4 * t + 2], s[ch][4 * t + 3]);
                *(LAS v2u*)(PL + r32 * 296 + kbase + 8 * t + 4 * hi) = w; } }
        lsum += __shfl_xor(lsum, 32);
        if (hi == 0) LB[wid * 32 + r32] = lsum;
        __syncthreads();
        f32x16 o = {};
#pragma unroll
        for (int ks = 0; ks < 10; ++ks) if (ks < nks) {
            const int key0 = (ks < 8) ? 128 * kh + 16 * ks : 256 + 16 * (ks - 8);
            const bf16x8 pf = *(const LAS bf16x8*)(PL + r32 * 296 + key0 + 8 * hi);
            o = __builtin_amdgcn_mfma_f32_32x32x16_bf16(vfr[ks], pf, o, 0, 0, 0); }
        if (kh == 1) {
#pragma unroll
            for (int r = 0; r < 16; ++r) OX[eb * 1024 + r * 64 + lane] = o[r]; }
        __syncthreads();
        if (kh == 0) { const size_t pi = ((size_t)(bh * 8 + split) * 2 + c) * 32 + r32;
#pragma unroll
            for (int t = 0; t < 4; ++t) { f32x4 v; v.x = o[4 * t] + OX[eb * 1024 + (4 * t) * 64 + lane]; v.y = o[4 * t + 1] + OX[eb * 1024 + (4 * t + 1) * 64 + lane];
                v.z = o[4 * t + 2] + OX[eb * 1024 + (4 * t + 2) * 64 + lane]; v.w = o[4 * t + 3] + OX[eb * 1024 + (4 * t + 3) * 64 + lane];
                *(f32x4*)(SPO + pi * 128 + 32 * eb + 8 * t + 4 * hi) = v; }
            if (wid == 0 && hi == 0) { float Lq = LB[r32];
#pragma unroll
                for (int w = 1; w < 8; ++w) Lq += LB[w * 32 + r32];
                SPM[pi * 2] = M; SPM[pi * 2 + 1] = Lq; } }
    }
    __syncthreads();
}

template <int NB> __device__ __forceinline__ void sample_gemm_res(const Frame& F, const bf16* Arows, int lda, const bf16* Bt, int K, bf16* XBs, float* SS, LAS unsigned char* lds) {
    int lane_l = F.lane; asm volatile("" : "+v"(lane_l));
    const int lane = lane_l, ks = F.wave, r32 = lane & 31, hi = lane >> 5, rt = F.vcu >> 5, ct = F.vcu & 31;
    const int Kw = K >> 3, nst = Kw >> 4;
    const bf16* ap = Arows + (size_t)(32 * rt + r32) * lda + ks * Kw + 8 * hi;
    const bf16* bp = Bt + (size_t)(32 * ct + r32) * K + ks * Kw + 8 * hi;
    f32x16 acc = {};
#pragma unroll 1
    for (int s0 = 0; s0 < nst; s0 += NB) {
        bf16x8 a[NB], b[NB];
#pragma unroll
        for (int i = 0; i < NB; ++i) { a[i] = *(const bf16x8*)(ap + 16 * (s0 + i)); b[i] = *(const bf16x8*)(bp + 16 * (s0 + i)); }
        __builtin_amdgcn_sched_barrier(0);
#pragma unroll
        for (int i = 0; i < NB; ++i) acc = __builtin_amdgcn_mfma_f32_32x32x16_bf16(a[i], b[i], acc, 0, 0, 0);
        __builtin_amdgcn_sched_barrier(0);
    }
    LAS float* RED = (LAS float*)lds;
    LAS float* SSQ = (LAS float*)(lds + 32768);
    if (ks > 0) {
#pragma unroll
        for (int r = 0; r < 16; ++r) RED[(ks - 1) * 1024 + r * 64 + lane] = acc[r]; }
    __syncthreads();
    if (ks == 0) {
        float v[16]; unsigned xo[16];
#pragma unroll
        for (int r = 0; r < 16; ++r) { float t = acc[r];
#pragma unroll
            for (int w = 0; w < 7; ++w) t += RED[w * 1024 + r * 64 + lane];
            v[r] = t; xo[r] = (unsigned)XBs[(unsigned)(32 * rt + crow(r, hi)) * 1024 + 32 * ct + r32]; }
        __builtin_amdgcn_sched_barrier(0);
#pragma unroll
        for (int r = 0; r < 16; ++r) { const float x = v[r] + bflo(xo[r]);
            XBs[(unsigned)(32 * rt + crow(r, hi)) * 1024 + 32 * ct + r32] = (bf16)f2bf(x);
            SSQ[crow(r, hi) * 33 + r32] = x * x; }
    }
    __syncthreads();
    if (ks == 0 && lane < 32) { float s = 0.f;
#pragma unroll
        for (int c2 = 0; c2 < 32; ++c2) s += SSQ[lane * 33 + c2];
        SS[(size_t)16 * MT + ct * 256 + 32 * rt + lane] = s; }
    __syncthreads();
}

__device__ __forceinline__ void conv_item_fast(const Args& A, int l, int item, int lane) {
    const int row0 = item * 8; const bool smp = row0 >= MP;
    const int b = smp ? (row0 - MP) >> 5 : row0 >> 11, t0 = smp ? (row0 - MP) & 31 : row0 & 2047, L = smp ? 32 : 2048;
    const bf16* UC = (const bf16*)(A.ws + WS_UC) + (size_t)(row0 - t0) * 256 + 4 * lane;
    const float* dw = A.in[12] + (size_t)l * 31 * 256 + 4 * lane;
    v2u P[38];
#pragma unroll
    for (int s = 0; s < 38; ++s) { const int tt = t0 - 30 + s; P[s] = (v2u){0u, 0u}; if (tt >= 0) P[s] = *(const v2u*)(UC + (size_t)tt * 256); }
    f32x4 acc[8];
#pragma unroll
    for (int i = 0; i < 8; ++i) acc[i] = (f32x4){0.f, 0.f, 0.f, 0.f};
    f32x4 R[8];
#pragma unroll
    for (int i = 0; i < 7; ++i) { const v2u w = P[i]; R[i] = (f32x4){bflo(w.x), bfhi(w.x), bflo(w.y), bfhi(w.y)}; }
#pragma unroll
    for (int j = 0; j < 31; ++j) { const f32x4 wv = *(const f32x4*)(dw + j * 256);
        { const v2u w = P[7 + j]; R[7] = (f32x4){bflo(w.x), bfhi(w.x), bflo(w.y), bfhi(w.y)}; }
#pragma unroll
        for (int i = 0; i < 8; ++i) acc[i] += wv * R[i];
#pragma unroll
        for (int i = 0; i < 7; ++i) R[i] = R[i + 1];
        __builtin_amdgcn_sched_barrier(0); }
    if (t0 + 7 >= L - 30) { float* cout = A.out + (smp ? O_CS : O_CP) + ((size_t)(l * 8 + b) * 30) * 256 + 4 * lane;
#pragma unroll
        for (int i = 0; i < 8; ++i) { const int tq = t0 + i; const v2u w = P[30 + i]; if (tq >= L - 30) *(f32x4*)(cout + (size_t)(tq - (L - 30)) * 256) = (f32x4){bflo(w.x), bfhi(w.x), bflo(w.y), bfhi(w.y)}; } }
    const f32x4 bias = *(const f32x4*)(A.in[13] + l * 256 + 4 * lane), lg = *(const f32x4*)(A.in[14] + l * 256 + 4 * lane), lb = *(const f32x4*)(A.in[15] + l * 256 + 4 * lane);
    bf16* MIX = (bf16*)(A.ws + WS_MIX) + (size_t)row0 * 1024 + 768 + 4 * lane;
#pragma unroll
    for (int i = 0; i < 8; ++i) { f32x4 y = acc[i] + bias;
        const float mu = wave_sum((y.x + y.y) + (y.z + y.w)) * (1.0f / 256.0f); y = y - mu;
        const float var = wave_sum((y.x * y.x + y.y * y.y) + (y.z * y.z + y.w * y.w)) * (1.0f / 256.0f);
        const float rs = rsqrtf(var + 1e-6f); y = y * rs * lg + lb; y = y * pg8::sigm4(y);
        v2u o; o.x = pk2(y.x, y.y); o.y = pk2(y.z, y.w); *(v2u*)(MIX + (size_t)i * 1024) = o; }
}
__device__ __forceinline__ void conv_item(const Args& A, int l, int item, int lane) {
    const int row0 = item * 8; const bool smp = row0 >= MP;
    const int b = smp ? (row0 - MP) >> 5 : row0 >> 11, t0 = smp ? (row0 - MP) & 31 : row0 & 2047, L = smp ? 32 : 2048;
    const bf16* UC = (const bf16*)(A.ws + WS_UC) + (size_t)(row0 - t0) * 256 + 4 * lane;
    const float* hist = A.in[5] + ((size_t)(l * 8 + b) * 30) * 256 + 4 * lane;
    const float* dw = A.in[12] + (size_t)l * 31 * 256 + 4 * lane;
    f32x4 acc[8], R[8];
#pragma unroll
    for (int i = 0; i < 8; ++i) acc[i] = (f32x4){0.f, 0.f, 0.f, 0.f};
    float* cout = A.out + (smp ? O_CS : O_CP) + ((size_t)(l * 8 + b) * 30) * 256 + 4 * lane;
#define CONV_ROW(dst, tt_) do { const int tt = (tt_); const int ttc = tt < 0 ? 0 : tt; \
        const v2u w_ = *(const v2u*)(UC + (size_t)ttc * 256); f32x4 rv_ = (f32x4){bflo(w_.x), bfhi(w_.x), bflo(w_.y), bfhi(w_.y)}; \
        if (tt < 0) rv_ = (f32x4){0.f, 0.f, 0.f, 0.f}; dst = rv_; } while (0)
#define CONV_HIST(dst, tt_) do { const int tt = (tt_); int hr = 30 + tt; hr = hr < 0 ? 0 : (hr > 29 ? 29 : hr); const f32x4 hv_ = *(const f32x4*)(hist + (size_t)hr * 256); if (tt < 0) dst = hv_; } while (0)
#pragma unroll
    for (int i = 0; i < 7; ++i) CONV_ROW(R[i], t0 - 30 + i);
    if (smp) {
#pragma unroll
        for (int i = 0; i < 7; ++i) CONV_HIST(R[i], t0 - 30 + i); }
#pragma unroll 1
    for (int jb = 0; jb < 32; jb += 8) {
        f32x4 N[8], Wt[8];
#pragma unroll
        for (int jj = 0; jj < 8; ++jj) { const int j = jb + jj; int tt2 = t0 - 23 + j; if (tt2 > L - 1) tt2 = L - 1; CONV_ROW(N[jj], tt2);
            const int jc = j < 31 ? j : 30; Wt[jj] = *(const f32x4*)(dw + jc * 256); if (j >= 31) Wt[jj] = (f32x4){0.f, 0.f, 0.f, 0.f}; }
        if (smp && t0 - 23 + jb < 0) {
#pragma unroll
            for (int jj = 0; jj < 8; ++jj) CONV_HIST(N[jj], t0 - 23 + jb + jj); }
        __builtin_amdgcn_sched_barrier(0);
#pragma unroll
        for (int jj = 0; jj < 8; ++jj) { const int j = jb + jj; R[7] = N[jj];
            if (j >= 23 && j < 31) { const int tq = t0 + (j - 23); if (tq >= L - 30) *(f32x4*)(cout + (size_t)(tq - (L - 30)) * 256) = R[7]; }
#pragma unroll
            for (int i = 0; i < 8; ++i) acc[i] += Wt[jj] * R[i];
#pragma unroll
            for (int i = 0; i < 7; ++i) R[i] = R[i + 1]; }
    }
#undef CONV_HIST
#undef CONV_ROW
    const f32x4 bias = *(const f32x4*)(A.in[13] + l * 256 + 4 * lane), lg = *(const f32x4*)(A.in[14] + l * 256 + 4 * lane), lb = *(const f32x4*)(A.in[15] + l * 256 + 4 * lane);
    bf16* MIX = (bf16*)(A.ws + WS_MIX) + (size_t)row0 * 1024 + 768 + 4 * lane;
#pragma unroll
    for (int i = 0; i < 8; ++i) { f32x4 y = acc[i] + bias;
        const float mu = wave_sum((y.x + y.y) + (y.z + y.w)) * (1.0f / 256.0f); y = y - mu;
        const float var = wave_sum((y.x * y.x + y.y * y.y) + (y.z * y.z + y.w * y.w)) * (1.0f / 256.0f);
        const float rs = rsqrtf(var + 1e-6f); y = y * rs * lg + lb; y = y * pg8::sigm4(y);
        v2u o; o.x = pk2(y.x, y.y); o.y = pk2(y.z, y.w); *(v2u*)(MIX + (size_t)i * 1024) = o; }
}
__device__ __forceinline__ void pool_item(const Args& A, int l, int item, int lane) {
    const int row = item * 2 + (lane >> 5), c0 = (lane & 31) * 8, g = c0 >> 6, w = 2 << g;
    const bool smp = row >= MP; const int b = smp ? (row - MP) >> 5 : row >> 11, t = smp ? (row - MP) & 31 : row & 2047, L = smp ? 32 : 2048;
    const bf16* UP = (const bf16*)(A.ws + WS_UP) + (size_t)(row - t) * 256 + c0;
    const float* hist = A.in[4] + ((size_t)(l * 8 + b) * 15) * 256 + c0;
    float sum[8], own[8];
    v4u pv[16];
#pragma unroll
    for (int jj = 0; jj < 16; ++jj) { const int tt = t - jj; pv[jj] = (v4u){0u, 0u, 0u, 0u}; if (jj < w && tt >= 0) pv[jj] = *(const v4u*)(UP + (size_t)tt * 256); }
    __builtin_amdgcn_sched_barrier(0);
#pragma unroll
    for (int i = 0; i < 8; ++i) sum[i] = 0.f;
#pragma unroll
    for (int jj = 0; jj < 16; ++jj) { const v4u v = pv[jj];
        const float fv[8] = {bflo(v.x), bfhi(v.x), bflo(v.y), bfhi(v.y), bflo(v.z), bfhi(v.z), bflo(v.w), bfhi(v.w)};
#pragma unroll
        for (int i = 0; i < 8; ++i) { sum[i] += fv[i]; if (jj == 0) own[i] = fv[i]; } }
    if (smp && t < w - 1) { for (int jj = t + 1; jj < w; ++jj) { const int tt = t - jj;
            const f32x4 a = *(const f32x4*)(hist + (size_t)(15 + tt) * 256), bq = *(const f32x4*)(hist + (size_t)(15 + tt) * 256 + 4);
            sum[0] += a.x; sum[1] += a.y; sum[2] += a.z; sum[3] += a.w; sum[4] += bq.x; sum[5] += bq.y; sum[6] += bq.z; sum[7] += bq.w; } }
    const int cnt = smp ? w : ((t + 1 < w) ? t + 1 : w); const float ic = 1.0f / (float)cnt;
    v4u o; o.x = pk2(sum[0] * ic - own[0], sum[1] * ic - own[1]); o.y = pk2(sum[2] * ic - own[2], sum[3] * ic - own[3]);
    o.z = pk2(sum[4] * ic - own[4], sum[5] * ic - own[5]); o.w = pk2(sum[6] * ic - own[6], sum[7] * ic - own[7]);
    *(v4u*)((bf16*)(A.ws + WS_MIX) + (size_t)row * 1024 + c0) = o;
    if (t >= L - 15) { float* po = A.out + (smp ? O_PS : O_PP) + ((size_t)(l * 8 + b) * 15 + (t - (L - 15))) * 256 + c0;
        *(f32x4*)po = (f32x4){own[0], own[1], own[2], own[3]}; *(f32x4*)(po + 4) = (f32x4){own[4], own[5], own[6], own[7]}; }
}
__device__ __forceinline__ void post_item(const Args& A, int l, int row0, int lane, float lam, float osc) {
    const int h = lane >> 4, e = (lane & 15) * 8;
    const bf16* O4 = (const bf16*)(A.ws + WS_O4) + (size_t)row0 * 1024 + h * 256 + e;
    v4u a[4], bq[4];
#pragma unroll
    for (int i = 0; i < 4; ++i) { a[i] = *(const v4u*)(O4 + (size_t)i * 1024); bq[i] = *(const v4u*)(O4 + (size_t)i * 1024 + 128); }
    __builtin_amdgcn_sched_barrier(0);
    const f32x4 g0 = *(const f32x4*)(A.in[11] + l * 128 + e), g1 = *(const f32x4*)(A.in[11] + l * 128 + e + 4);
#pragma unroll
    for (int i = 0; i < 4; ++i) {
        float o[8] = {bflo(a[i].x) - lam * bflo(bq[i].x), bfhi(a[i].x) - lam * bfhi(bq[i].x), bflo(a[i].y) - lam * bflo(bq[i].y), bfhi(a[i].y) - lam * bfhi(bq[i].y),
                      bflo(a[i].z) - lam * bflo(bq[i].z), bfhi(a[i].z) - lam * bfhi(bq[i].z), bflo(a[i].w) - lam * bflo(bq[i].w), bfhi(a[i].w) - lam * bfhi(bq[i].w)};
        float ss = 0.f;
#pragma unroll
        for (int k = 0; k < 8; ++k) ss += o[k] * o[k];
        ss += __shfl_xor(ss, 1); ss += __shfl_xor(ss, 2); ss += __shfl_xor(ss, 4); ss += __shfl_xor(ss, 8);
        const float rs = rsqrtf(ss * (1.0f / 128.0f) + 1e-6f) * osc;
        v4u w; w.x = pk2(o[0] * rs * g0.x, o[1] * rs * g0.y); w.y = pk2(o[2] * rs * g0.z, o[3] * rs * g0.w); w.z = pk2(o[4] * rs * g1.x, o[5] * rs * g1.y); w.w = pk2(o[6] * rs * g1.z, o[7] * rs * g1.w);
        *(v4u*)((bf16*)(A.ws + WS_MIX) + (size_t)(row0 + i) * 1024 + 256 + h * 128 + e) = w; }
}
__device__ __forceinline__ void scomb_item(const Args& A, int l, int item, int lane, float lam, float osc) {
    const int rs_ = item >> 2, h = item & 3, b = rs_ >> 5, q = rs_ & 31, bh = b * 4 + h;
    const float* SPO = (const float*)(A.ws + WS_SPO); const float* SPM = (const float*)(A.ws + WS_SPM);
    float oc[2][2];
#pragma unroll
    for (int c = 0; c < 2; ++c) {
        typedef float f32x2t __attribute__((ext_vector_type(2)));
        f32x2t ml[8], ov[8];
#pragma unroll
        for (int s = 0; s < 8; ++s) { const size_t pi = ((size_t)(bh * 8 + s) * 2 + c) * 32 + q; ml[s] = *(const f32x2t*)(SPM + pi * 2); ov[s] = *(const f32x2t*)(SPO + pi * 128 + 2 * lane); }
        __builtin_amdgcn_sched_barrier(0);
        float M = ml[0].x;
#pragma unroll
        for (int s = 1; s < 8; ++s) M = fmaxf(M, ml[s].x);
        float Ls = 0.f, o0 = 0.f, o1 = 0.f;
#pragma unroll
        for (int s = 0; s < 8; ++s) { const float wgt = __builtin_amdgcn_exp2f(ml[s].x - M); Ls += wgt * ml[s].y; o0 += wgt * ov[s].x; o1 += wgt * ov[s].y; }
        const float il = 1.0f / Ls; oc[c][0] = o0 * il; oc[c][1] = o1 * il; }
    const float x0 = oc[0][0] - lam * oc[1][0], x1 = oc[0][1] - lam * oc[1][1];
    const float ss = wave_sum(x0 * x0 + x1 * x1); const float rs = rsqrtf(ss * (1.0f / 128.0f) + 1e-6f) * osc;
    const float* g = A.in[11] + l * 128 + 2 * lane;
    *(unsigned*)((bf16*)(A.ws + WS_MIX) + (size_t)(MP + rs_) * 1024 + 256 + h * 128 + 2 * lane) = pk2(x0 * rs * g[0], x1 * rs * g[1]);
}

__global__ void __launch_bounds__(NWAVES * 64, 2) mk_fwd(Args args) {
    extern __shared__ __attribute__((aligned(16))) unsigned char lds_raw[];
    LAS unsigned char* lds = (LAS unsigned char*)lds_raw;
    Frame F; F.tid = threadIdx.x; F.lane = F.tid & 63; F.wave = __builtin_amdgcn_readfirstlane(F.tid >> 6);
    F.G = gridDim.x; { const int bx = blockIdx.x; F.vcu = (F.G % 8 == 0) ? (bx % 8) * (F.G / 8) + bx / 8 : bx; }
    F.gw = F.vcu * NWAVES + F.wave; F.NGW = F.G * NWAVES;
    unsigned char* ws = args.ws;
    const int lo = args.ph_lo, hi = args.ph_hi;
#define IN(k) (lo <= (k) && (k) < hi)
#define SEAM(k) do { if (IN(k) && IN((k) + 1)) { xcd_barrier(bar); } } while (0)
    for (int u = F.tid; u < 64; u += NWAVES * 64) ((LAS unsigned*)(lds + MISC_OFF))[u] = 0u;
    __syncthreads();
    XcdBarrier bar; bar.bar = (unsigned*)ws; bar.x = 0; bar.st = nullptr;
    if (!MK_MULTI) bar = xcd_barrier_post((unsigned*)ws, (volatile LAS unsigned*)(lds + MISC_OFF) + 8);
    #ifndef REP_PRO
#define REP_PRO 1
#endif
#ifndef REP_INP
#define REP_INP 1
#endif
#ifndef REP_ATT
#define REP_ATT 1
#endif
#ifndef REP_MIX
#define REP_MIX 1
#endif
#ifndef REP_GU
#define REP_GU 1
#endif
    if (!MK_MULTI && lo < 0) cg::this_grid().sync();
    if (IN(0)) { for (int rep = 0; rep < REP_PRO; ++rep) { p0_prologue(F, args, lds); __syncthreads(); } }
    SEAM(0);
    for (int rep = 0; rep < REP_SYNC; ++rep) xcd_barrier(bar);
    float* X = args.out + O_Y;
    bf16* XB = (bf16*)(ws + WS_XB); float* SS = (float*)(ws + WS_SS);
#pragma unroll 1
    for (int l = 0; l < 2; ++l) {
        const int pb = 1 + 6 * l;
        if (IN(pb)) for (int rep = 0; rep < REP_INP; ++rep) {
            pg8::Gemm g{XB, (const bf16*)(ws + WS_WIN) + (size_t)l * INW * 1024, MT, INW, 1024}; pg8::StaticOrder S; S.init(MT, INW, F.G, (int)blockIdx.x);
            pg8::EpiInProj E{SS, (const float*)(ws + WS_TAB), (bf16*)(ws + WS_UP), (bf16*)(ws + WS_Q), (bf16*)(ws + WS_K), (bf16*)(ws + WS_V), (bf16*)(ws + WS_UC),
                args.out + O_KP + (size_t)l * 8 * 2048 * 512, args.out + O_KS + (size_t)l * 8 * 32 * 512, args.out + O_VP + (size_t)l * 8 * 2048 * 512, args.out + O_VS + (size_t)l * 8 * 32 * 512};
            pg8::gemm_phase<pg8::EpiInProj, pg8::StaticOrder, PG8_ALIGN, PG8_SP2>(lds, g, S, E);
            if (SLACK_W && rep == 0) { if (l == 0) slack_weights(F, args, lds, (MT / 256) * (INW / 256), WI_A, WI_B); else slack_weights(F, args, lds, (MT / 256) * (INW / 256), WI_C, WI_END); }
        }
        SEAM(pb);
        if (IN(pb + 1)) for (int rep = 0; rep < REP_ATT; ++rep) {
            const int bh = F.vcu >> 3, jj = F.vcu & 7, a = jj & 3, c = jj >> 2, b = bh >> 2, h = bh & 3;
            const attn_body::bf16* Qp = (const attn_body::bf16*)(ws + WS_Q); const attn_body::bf16* Kp = (const attn_body::bf16*)(ws + WS_K); const attn_body::bf16* Vp = (const attn_body::bf16*)(ws + WS_V);
            attn_body::bf16* Op = (attn_body::bf16*)(ws + WS_O4);
            const int spos = F.vcu % 5;
#pragma unroll 1
            for (int i = 0; i < 5; ++i) {
                if (i == spos) { sample_attn_unit(F, args, l, F.vcu >> 3, F.vcu & 7, lds); }
                else { const int k = i - (i > spos ? 1 : 0); const int vh = k >> 1, qb = (k & 1) ? 7 - a : a;
                    attn_body::attn_unit<8>(b, 2 * h + c, 2 * h + vh, qb, Qp, Kp, Vp, Op, h * 256 + c * 128 + vh * 64, (char*)lds_raw); __syncthreads(); }
            }
        }
        SEAM(pb + 1);
        if (IN(pb + 2)) for (int rep = 0; rep < REP_MIX; ++rep) {
            int mlane = F.lane; asm volatile("" : "+v"(mlane));
            const float lam = ((const float*)(ws + WS_LAM))[l]; const float osc = 1.0f - (0.8f - 0.6f * expf(-0.3f * (float)l));
            const bool heavy = (F.NGW == 2048) && ((F.gw & 63) == 0);
            const int lgw = (F.NGW == 2048) ? F.gw - ((F.gw + 63) >> 6) : F.gw, lng = (F.NGW == 2048) ? 2016 : F.NGW;
#pragma unroll 1
            for (int k = 0; k < 2; ++k) { if (k == 1 && !heavy) break; conv_item(args, l, k == 0 ? F.gw : MP / 8 + (F.gw >> 6), mlane); }
            if (!heavy) {
            for (int it = lgw; it < MT / 2; it += lng) pool_item(args, l, it, mlane);
            for (int it = lgw; it < MP / 4; it += lng) post_item(args, l, it * 4, mlane, lam, osc);
            for (int it = lgw; it < 1024; it += lng) scomb_item(args, l, it, mlane, lam, osc);
            }
        }
        SEAM(pb + 2);
#ifndef REP_OUT0
#define REP_OUT0 1
#endif
#ifndef REP_SYNC
#define REP_SYNC 0
#endif
#ifndef REP_FOLD
#define REP_FOLD 1
#endif
#ifndef REP_SLACK
#define REP_SLACK 1
#endif
#ifndef SLACK_W
#define SLACK_W 1
#endif
        if (IN(pb + 3)) for (int rep = 0; rep < (l == 0 ? REP_OUT0 : 1); ++rep) {
            pg8::Gemm g{(const bf16*)(ws + WS_MIX), (const bf16*)(ws + WS_WOUT) + (size_t)l * 1024 * 1024, MP, 1024, 1024}; pg8::StaticOrder S; S.init(MP, 1024, F.G, (int)blockIdx.x);
            pg8::EpiRes E{XB, SS, 0};
            pg8::gemm_phase<pg8::EpiRes, pg8::StaticOrder, PG8_ALIGN, PG8_SP2>(lds, g, S, E);
            sample_gemm_res<8>(F, (const bf16*)(ws + WS_MIX) + (size_t)MP * 1024, 1024, (const bf16*)(ws + WS_WOUT) + (size_t)l * 1024 * 1024, 1024, XB + (size_t)MP * 1024, SS, lds);
        }
        SEAM(pb + 3);
        if (IN(pb + 4)) for (int rep = 0; rep < REP_GU; ++rep) {
            pg8::Gemm g{XB, (const bf16*)(ws + WS_WGU) + (size_t)l * 2 * DFF * 1024, MT, 2 * DFF, 1024}; pg8::StaticOrder S; S.init(MT, 2 * DFF, F.G, (int)blockIdx.x);
            pg8::EpiSwiGLU E{(bf16*)(ws + WS_H), SS};
            pg8::gemm_phase<pg8::EpiSwiGLU, pg8::StaticOrder, PG8_ALIGN, PG8_SP2>(lds, g, S, E);
            if (SLACK_W && rep == 0 && l == 0) slack_weights(F, args, lds, (MT / 256) * (2 * DFF / 256), WI_B, WI_C);
        }
        SEAM(pb + 4);
#ifndef REP_DN
#define REP_DN 1
#endif
        if (IN(pb + 5)) for (int rep = 0; rep < REP_DN; ++rep) {
            pg8::Gemm g{(const bf16*)(ws + WS_H), (const bf16*)(ws + WS_WDN) + (size_t)l * 1024 * DFF, MP, 1024, DFF}; pg8::StaticOrder S; S.init(MP, 1024, F.G, (int)blockIdx.x);
            pg8::EpiRes E{XB, SS, rep < REP_DN - 1};
            pg8::gemm_phase<pg8::EpiRes, pg8::StaticOrder, PG8_ALIGN, PG8_SP2>(lds, g, S, E);
            if (rep == REP_DN - 1) sample_gemm_res<11>(F, (const bf16*)(ws + WS_H) + (size_t)MP * DFF, DFF, (const bf16*)(ws + WS_WDN) + (size_t)l * 1024 * DFF, DFF, XB + (size_t)MP * 1024, SS, lds);
        }
        SEAM(pb + 5);
    }
#ifndef REP_FIN
#define REP_FIN 1
#endif
    if (IN(13)) for (int rep = 0; rep < REP_FIN; ++rep) {
        const float* gf = args.in[21]; int flane = F.lane; asm volatile("" : "+v"(flane));
        for (int m0 = F.gw * 2; m0 < MT; m0 += F.NGW * 2) {
            v4u w[2][2];
#pragma unroll
            for (int q = 0; q < 2; ++q)
#pragma unroll
                for (int j = 0; j < 2; ++j) w[q][j] = *((const v4u*)(XB + (size_t)(m0 + q) * 1024) + flane + 64 * j);
            __builtin_amdgcn_sched_barrier(0);
#pragma unroll
            for (int q = 0; q < 2; ++q) { float v[2][8]; float s = 0.f;
#pragma unroll
                for (int j = 0; j < 2; ++j) { const v4u ww = w[q][j]; v[j][0] = bflo(ww.x); v[j][1] = bfhi(ww.x); v[j][2] = bflo(ww.y); v[j][3] = bfhi(ww.y); v[j][4] = bflo(ww.z); v[j][5] = bfhi(ww.z); v[j][6] = bflo(ww.w); v[j][7] = bfhi(ww.w);
#pragma unroll
                    for (int k = 0; k < 8; ++k) s += v[j][k] * v[j][k]; }
                const float r = rsqrtf(wave_sum(s) * (1.0f / 1024.0f) + 1e-6f);
#pragma unroll
                for (int j = 0; j < 2; ++j) { const f32x4 g0 = *((const f32x4*)gf + 2 * (flane + 64 * j)), g1 = *((const f32x4*)gf + 2 * (flane + 64 * j) + 1);
                    f32x4* yo = (f32x4*)(X + (size_t)(m0 + q) * 1024) + 2 * (flane + 64 * j);
                    yo[0] = (f32x4){v[j][0] * r * g0.x, v[j][1] * r * g0.y, v[j][2] * r * g0.z, v[j][3] * r * g0.w};
                    yo[1] = (f32x4){v[j][4] * r * g1.x, v[j][5] * r * g1.y, v[j][6] * r * g1.z, v[j][7] * r * g1.w}; } } }
    }
#undef IN
#undef SEAM
}

extern "C" void kernel_launch(void* const* d_in, const int* in_sizes, int n_in, void* d_out, int out_size, void* d_ws, size_t ws_size, hipStream_t stream) {
    static int grid = 0;
    if (grid == 0) {
        if (n_in != 22 || out_size != (int)O_END || ws_size < WS_END) { fprintf(stderr, "kernel_launch: unexpected shapes (n_in %d out %d ws %zu)\n", n_in, out_size, ws_size); grid = -1; return; }
        int dev = 0, cus = 0, per_cu = 0;
        hipGetDevice(&dev); hipDeviceGetAttribute(&cus, hipDeviceAttributeMultiprocessorCount, dev);
        if (hipFuncSetAttribute((const void*)mk_fwd, hipFuncAttributeMaxDynamicSharedMemorySize, LDS_BYTES) != hipSuccess) { fprintf(stderr, "kernel_launch: hipFuncSetAttribute failed\n"); grid = -1; return; }
        hipOccupancyMaxActiveBlocksPerMultiprocessor(&per_cu, (const void*)mk_fwd, NWAVES * 64, LDS_BYTES);
        (void)hipGetLastError();
        if (per_cu < 1) { fprintf(stderr, "kernel_launch: occupancy query says %d blocks per CU\n", per_cu); per_cu = 1; }
        grid = cus;
        if (grid > 256) grid = 256;
    }
    if (grid < 0) return;
    if (hipMemsetAsync(d_ws, 0, 65536, stream) != hipSuccess) { fprintf(stderr, "kernel_launch: memset failed\n"); return; }
    Args a{};
    for (int i = 0; i < 22; ++i) a.in[i] = (const float*)d_in[i];
    a.out = (float*)d_out; a.ws = (unsigned char*)d_ws;
#if MK_MULTI
    for (int p = 0; p < NPH; ++p) { a.ph_lo = p; a.ph_hi = p + 1; hipLaunchKernelGGL(mk_fwd, dim3(grid), dim3(NWAVES * 64), LDS_BYTES, stream, a); }
#else
    a.ph_lo = 0; a.ph_hi = NPH;
    void* kargs[] = {&a};
    hipError_t e = hipLaunchCooperativeKernel((const void*)mk_fwd, dim3(grid), dim3(NWAVES * 64), kargs, LDS_BYTES, stream);
    if (e != hipSuccess) fprintf(stderr, "kernel_launch: cooperative launch failed: %s (grid %d)\n", hipGetErrorString(e), grid);
#endif
}
```

```cpp
#define MK_MULTI 0
#include <hip/hip_runtime.h>
#include <hip/hip_cooperative_groups.h>
#include <cstdio>
#include <cstdint>
namespace cg = cooperative_groups;
namespace pg8 {
#define PG8_LAS __attribute__((address_space(3)))
typedef unsigned short bf16_t;
typedef short bf16x8 __attribute__((ext_vector_type(8)));
typedef float f32x4 __attribute__((ext_vector_type(4)));
typedef unsigned u32x4 __attribute__((ext_vector_type(4)));
constexpr int BM = 256, BK = 64, HALF = 128, HTB = HALF * BK * 2  , STAGE_BYTES = 8 * HTB, NXCD = 8, WGM = 4;

__host__ __device__ __forceinline__ int lds_byte(int r, int c) { const int st = (r >> 4) * 2 + (c >> 5), rr = r & 15, cc = c & 31, ob = rr * 64 + cc * 2; return st * 1024 + (ob ^ (((ob >> 9) & 1) << 5)); }
__host__ __device__ __forceinline__ void stage_rc(int b, int& R, int& C) { const int st = b / 1024, sb = b % 1024, swz = sb ^ (((sb >> 9) & 1) << 5); R = (st >> 1) * 16 + swz / 64; C = (st & 1) * 32 + (swz % 64) / 2; }
__host__ __device__ __forceinline__ int perm32(int rho) { const int n = rho >> 4, i = rho & 15; return 8 * (i >> 2) + 4 * n + (i & 3); }

struct Unit { int pm, pn; };
struct Gemm { const bf16_t* A; const bf16_t* Bt; int M, N, K; };

struct StaticOrder {
    int nM, nN, nwg, G, c;
    __host__ __device__ void init(int M, int N, int G_, int c_) { nM = M / BM; nN = N / BM; nwg = nM * nN; G = G_; c = c_; }
    __host__ __device__ bool next(int i, Unit& u) const {
        const long L = (long)i * G + c; if (L >= nwg) return false;
        int wgid = (int)L; { const int q = nwg / NXCD, r = nwg % NXCD, xcd = wgid % NXCD, off = wgid / NXCD; wgid = (xcd < r ? xcd * (q + 1) : r * (q + 1) + (xcd - r) * q) + off; }
        const int nig = WGM * nN, gid = wgid / nig, fm = gid * WGM, gsz = (nM - fm) < WGM ? (nM - fm) : WGM;
        u.pm = fm + ((wgid % nig) % gsz); u.pn = (wgid % nig) / gsz; return true;
    }
    __device__ __forceinline__ void a_ready(const Unit&) const {}
    __device__ __forceinline__ void done(const Unit&) const {}
};

__device__ __forceinline__ unsigned cvt_pk_bf16(float lo, float hi) { unsigned r; asm volatile("v_cvt_pk_bf16_f32 %0, %1, %2" : "=v"(r) : "v"(lo), "v"(hi)); return r; }
typedef float f32x2 __attribute__((ext_vector_type(2)));
template <class Epi, class Sched, bool ALIGN_EPI = false, bool SP2 = false>
__device__ __forceinline__ void gemm_phase(PG8_LAS unsigned char* lds, const Gemm g, const Sched& S, const Epi& E) {
    int tid_l = threadIdx.x; asm volatile("" : "+v"(tid_l));
    const int tid = tid_l, wid = __builtin_amdgcn_readfirstlane(tid >> 6), lane = tid & 63, wr = wid >> 2, wc = wid & 3, fr = lane & 15, fq = lane >> 4;
    const int K = g.K, nt = K / BK;
    unsigned voffA[2], voffB[2];
#pragma unroll
    for (int i = 0; i < 2; ++i) { int R, C; stage_rc(tid * 16 + i * 8192, R, C); const int Rb = Epi::PERM ? ((R & ~31) + perm32(R & 31)) : R;
        voffA[i] = (unsigned)(R * K + C) * 2u; voffB[i] = (unsigned)(Rb * K + C) * 2u; }
    const size_t kstep = (size_t)(BK * 2);
    const size_t hstep = (size_t)HALF * K * 2;
    const size_t tstep = 2 * hstep;
    const unsigned ldsw = (unsigned)wid * 1024u;
    const int aoff = lds_byte(wr * 64 + fr, fq * 8), boff = lds_byte(wc * 32 + fr, fq * 8);
#define PG8_SA(b, h) (((b) * 2 + (h)) * HTB)
#define PG8_SB(b, h) ((4 + (b) * 2 + (h)) * HTB)
#define PG8_STAGE(bufoff, gbase, voff) do { _Pragma("unroll") for (int _i = 0; _i < 2; ++_i) \
        __builtin_amdgcn_global_load_lds((const unsigned*)((const char*)(gbase) + (voff)[_i]), (PG8_LAS unsigned*)(lds + (bufoff) + ldsw + _i * 8192), 16, 0, 0); } while (0)
#define PG8_LDA(dst, b, h) do { _Pragma("unroll") for (int m = 0; m < 4; ++m) _Pragma("unroll") for (int k = 0; k < 2; ++k) dst[m][k] = *(const PG8_LAS bf16x8*)(lds + PG8_SA(b, h) + aoff + m * 2048 + k * 1024); } while (0)
#define PG8_LDB(dst, b, h) do { _Pragma("unroll") for (int n = 0; n < 2; ++n) _Pragma("unroll") for (int k = 0; k < 2; ++k) dst[n][k] = *(const PG8_LAS bf16x8*)(lds + PG8_SB(b, h) + boff + n * 2048 + k * 1024); } while (0)
#define PG8_MMA(ai, bj, At, Bt) do { __builtin_amdgcn_s_setprio(1); _Pragma("unroll") for (int m = 0; m < 4; ++m) _Pragma("unroll") for (int n = 0; n < 2; ++n) _Pragma("unroll") for (int k = 0; k < 2; ++k) \
        acc[ai][bj][m][n] = __builtin_amdgcn_mfma_f32_16x16x32_bf16(Bt[n][k], At[m][k], acc[ai][bj][m][n], 0, 0, 0); __builtin_amdgcn_s_setprio(0); } while (0)
#define PG8_WAIT_V(n) asm volatile("s_waitcnt vmcnt(" #n ")" ::: "memory")
#define PG8_WAIT_L(n) asm volatile("s_waitcnt lgkmcnt(" #n ")" ::: "memory")
#define PG8_BAR __builtin_amdgcn_s_barrier()
#define PG8_SCHED __builtin_amdgcn_sched_barrier(0)
    Unit cur, nxt; int ui = 0;
    if (!S.next(0, cur)) return;
    f32x4 acc[2][2][4][2];
#pragma unroll
    for (int a = 0; a < 2; ++a)
#pragma unroll
        for (int b = 0; b < 2; ++b)
#pragma unroll
            for (int m = 0; m < 4; ++m)
#pragma unroll
                for (int n = 0; n < 2; ++n) acc[a][b][m][n] = (f32x4){0.f, 0.f, 0.f, 0.f};
    bf16x8 At[4][2], B0[2][2], B1[2][2];
    const char* cA = (const char*)g.A + (size_t)cur.pm * tstep; const char* cB = (const char*)g.Bt + (size_t)cur.pn * tstep;
    S.a_ready(cur);
    if constexpr (SP2) {
        PG8_STAGE(PG8_SB(0, 0), cB, voffB); PG8_STAGE(PG8_SB(0, 1), cB + hstep, voffB); PG8_STAGE(PG8_SA(0, 0), cA, voffA); PG8_STAGE(PG8_SA(0, 1), cA + hstep, voffA);
        if (wr == 1) PG8_BAR;
        PG8_WAIT_V(2); PG8_BAR;
        PG8_STAGE(PG8_SB(1, 0), cB + kstep, voffB); PG8_STAGE(PG8_SA(1, 0), cA + kstep, voffA); PG8_STAGE(PG8_SB(1, 1), cB + hstep + kstep, voffB);
        PG8_WAIT_V(6); PG8_BAR;
    } else {
        PG8_STAGE(PG8_SB(0, 0), cB, voffB); PG8_STAGE(PG8_SA(0, 0), cA, voffA); PG8_STAGE(PG8_SB(0, 1), cB + hstep, voffB); PG8_STAGE(PG8_SA(0, 1), cA + hstep, voffA);
        if (wr == 1) PG8_BAR;
        PG8_WAIT_V(4); PG8_BAR;
        PG8_STAGE(PG8_SB(1, 0), cB + kstep, voffB); PG8_STAGE(PG8_SA(1, 0), cA + kstep, voffA); PG8_STAGE(PG8_SB(1, 1), cB + hstep + kstep, voffB);
        PG8_WAIT_V(6); PG8_BAR;
    }
    for (;;) {
        const bool has_next = S.next(ui + 1, nxt);
        const char* nA = has_next ? (const char*)g.A + (size_t)nxt.pm * tstep : cA; const char* nB = has_next ? (const char*)g.Bt + (size_t)nxt.pn * tstep : cB;
        for (int t = 0; t < nt; t += 2) {
            const bool last = (t == nt - 2);
            const char* a1 = cA + (size_t)(t + 1) * kstep;
            const char* a2 = last ? nA : cA + (size_t)(t + 2) * kstep; const char* b2 = last ? nB : cB + (size_t)(t + 2) * kstep;
            const char* a3 = a2 + kstep; const char* b3 = b2 + kstep;
            if (last && has_next) S.a_ready(nxt);
            if constexpr (SP2) {
            PG8_LDB(B0, 0, 0); PG8_LDB(B1, 0, 1); PG8_SCHED; PG8_LDA(At, 0, 0); PG8_STAGE(PG8_SA(1, 1), a1 + hstep, voffA);
            PG8_WAIT_V(8); PG8_WAIT_L(0); PG8_BAR; PG8_MMA(0, 0, At, B0); PG8_MMA(0, 1, At, B1); PG8_BAR; PG8_SCHED;
            PG8_LDA(At, 0, 1); PG8_STAGE(PG8_SB(0, 0), b2, voffB); PG8_STAGE(PG8_SB(0, 1), b2 + hstep, voffB); PG8_STAGE(PG8_SA(0, 0), a2, voffA);
            PG8_WAIT_V(8); PG8_WAIT_L(0); PG8_BAR; PG8_MMA(1, 0, At, B0); PG8_MMA(1, 1, At, B1); PG8_BAR; PG8_SCHED;
            PG8_LDB(B0, 1, 0); PG8_LDB(B1, 1, 1); PG8_SCHED; PG8_LDA(At, 1, 0); PG8_STAGE(PG8_SA(0, 1), a2 + hstep, voffA);
            PG8_WAIT_V(8); PG8_WAIT_L(0); PG8_BAR; PG8_MMA(0, 0, At, B0); PG8_MMA(0, 1, At, B1); PG8_BAR; PG8_SCHED;
            PG8_LDA(At, 1, 1); PG8_STAGE(PG8_SB(1, 0), b3, voffB); PG8_STAGE(PG8_SB(1, 1), b3 + hstep, voffB); PG8_STAGE(PG8_SA(1, 0), a3, voffA);
            PG8_WAIT_V(8); PG8_WAIT_L(0); PG8_BAR; PG8_MMA(1, 0, At, B0); PG8_MMA(1, 1, At, B1); PG8_BAR; PG8_SCHED;
            } else {
            PG8_LDB(B0, 0, 0); PG8_SCHED; PG8_LDA(At, 0, 0); PG8_STAGE(PG8_SA(1, 1), a1 + hstep, voffA);
            PG8_WAIT_L(8); PG8_BAR; PG8_WAIT_L(0); PG8_MMA(0, 0, At, B0); PG8_BAR; PG8_SCHED;
            PG8_LDB(B1, 0, 1); PG8_STAGE(PG8_SB(0, 0), b2, voffB);
            PG8_BAR; PG8_WAIT_L(0); PG8_MMA(0, 1, At, B1); PG8_BAR;
            PG8_LDA(At, 0, 1); PG8_STAGE(PG8_SA(0, 0), a2, voffA);
            PG8_BAR; PG8_WAIT_L(0); PG8_MMA(1, 0, At, B0); PG8_BAR; PG8_SCHED;
            PG8_STAGE(PG8_SB(0, 1), b2 + hstep, voffB);
            PG8_WAIT_V(6); PG8_BAR; PG8_MMA(1, 1, At, B1); PG8_BAR;
            PG8_LDB(B0, 1, 0); PG8_SCHED; PG8_LDA(At, 1, 0); PG8_STAGE(PG8_SA(0, 1), a2 + hstep, voffA);
            PG8_WAIT_L(8); PG8_BAR; PG8_WAIT_L(0); PG8_MMA(0, 0, At, B0); PG8_BAR; PG8_SCHED;
            PG8_LDB(B1, 1, 1); PG8_STAGE(PG8_SB(1, 0), b3, voffB);
            PG8_BAR; PG8_WAIT_L(0); PG8_MMA(0, 1, At, B1); PG8_BAR;
            PG8_LDA(At, 1, 1); PG8_STAGE(PG8_SA(1, 0), a3, voffA);
            PG8_BAR; PG8_WAIT_L(0); PG8_MMA(1, 0, At, B0); PG8_BAR; PG8_SCHED;
            PG8_STAGE(PG8_SB(1, 1), b3 + hstep, voffB);
            PG8_WAIT_V(6); PG8_BAR; PG8_MMA(1, 1, At, B1); PG8_BAR;
            }
        }
        if constexpr (ALIGN_EPI) { if (wr == 0) PG8_BAR; }
        if constexpr (!Epi::AFTER_DRAIN) { E(acc, cur, wr, wc, fr, fq); S.done(cur); }
        if (!has_next) break;
#pragma unroll
        for (int a = 0; a < 2; ++a)
#pragma unroll
            for (int b = 0; b < 2; ++b)
#pragma unroll
                for (int m = 0; m < 4; ++m)
#pragma unroll
                    for (int n = 0; n < 2; ++n) acc[a][b][m][n] = (f32x4){0.f, 0.f, 0.f, 0.f};
        cur = nxt; cA = nA; cB = nB; ++ui;
        if constexpr (ALIGN_EPI) { if (wr == 1) PG8_BAR; }
    }
    PG8_WAIT_V(0);
    if constexpr (!ALIGN_EPI) { if (wr == 0) PG8_BAR; }
    PG8_BAR;
    if constexpr (Epi::AFTER_DRAIN) { E.fused(acc, cur, wr, wc, fr, fq, lds, wid, lane); S.done(cur); }
#undef PG8_SA
#undef PG8_SB
#undef PG8_STAGE
#undef PG8_LDA
#undef PG8_LDB
#undef PG8_MMA
#undef PG8_WAIT_V
#undef PG8_WAIT_L
#undef PG8_BAR
#undef PG8_SCHED
}
}
#define PG8_SP2 true
#define PG8_ALIGN true
namespace pg8 {
constexpr int MT = 16640, MP = 16384;
constexpr float RMS_EPS = 1e-6f;
constexpr float QC2 = 0.125f * 1.4426950408889634f;
typedef unsigned u32x2 __attribute__((ext_vector_type(2)));
__device__ __forceinline__ float row_rs(const float* SS, int row, int fq) {
    float s = 0.f;
#pragma unroll
    for (int j = 0; j < 4; ++j) s += SS[(unsigned)(4 * fq + j) * MT + row];
    s += __shfl_xor(s, 16); s += __shfl_xor(s, 32);
    return rsqrtf(s * (1.0f / 1024.0f) + RMS_EPS);
}
__device__ __forceinline__ void rows_rs8(const float* SS, int row0, int fq, float (&r)[8]) {
    float s[8][4];
    if (row0 < MP) {
#pragma unroll
        for (int k = 0; k < 8; ++k)
#pragma unroll
            for (int j = 0; j < 4; ++j) s[k][j] = SS[(unsigned)(4 * fq + j) * MT + row0 + (k >> 2) * HALF + (k & 3) * 16];
    } else { const float* S2 = SS + 16 * MT + (row0 - MP);
#pragma unroll
        for (int h2 = 0; h2 < 2; ++h2) { float q[4][8];
            __builtin_amdgcn_sched_barrier(0);
#pragma unroll
            for (int k = 0; k < 4; ++k)
#pragma unroll
                for (int j = 0; j < 8; ++j) q[k][j] = S2[(unsigned)(8 * fq + j) * 256 + h2 * HALF + k * 16];
            __builtin_amdgcn_sched_barrier(0);
#pragma unroll
            for (int k = 0; k < 4; ++k)
#pragma unroll
                for (int j = 0; j < 4; ++j) s[h2 * 4 + k][j] = q[k][j] + q[k][j + 4]; }
    }
    __builtin_amdgcn_sched_barrier(0);
#pragma unroll
    for (int k = 0; k < 8; ++k) { float t = (s[k][0] + s[k][1]) + (s[k][2] + s[k][3]); t += __shfl_xor(t, 16); t += __shfl_xor(t, 32); r[k] = rsqrtf(t * (1.0f / 1024.0f) + RMS_EPS); }
    __builtin_amdgcn_sched_barrier(0);
}
__device__ __forceinline__ void store8(bf16_t* p, f32x4 a, f32x4 b) {
    u32x4 w; w.x = cvt_pk_bf16(a[0], a[1]); w.y = cvt_pk_bf16(a[2], a[3]); w.z = cvt_pk_bf16(b[0], b[1]); w.w = cvt_pk_bf16(b[2], b[3]);
    *(u32x4*)p = w;
}
__device__ __forceinline__ float sigm(float x) { return __builtin_amdgcn_rcpf(1.0f + __builtin_amdgcn_exp2f(-1.4426950408889634f * x)); }
__device__ __forceinline__ f32x4 sigm4(f32x4 x) { f32x4 r; r[0] = sigm(x[0]); r[1] = sigm(x[1]); r[2] = sigm(x[2]); r[3] = sigm(x[3]); return r; }

struct EpiRes {
    static constexpr bool PERM = true, AFTER_DRAIN = false;
    bf16_t* xb; float* SS; int dry;
    __device__ __forceinline__ void operator()(const f32x4 (&acc)[2][2][4][2], const Unit& u, int wr, int wc, int fr, int fq) const {
        const int col0 = u.pn * BM + wc * 32 + 8 * fq;
#pragma unroll
        for (int ai = 0; ai < 2; ++ai) {
            u32x4 xw[4][2];
#pragma unroll
            for (int m = 0; m < 4; ++m)
#pragma unroll
                for (int bj = 0; bj < 2; ++bj) xw[m][bj] = *(const u32x4*)(xb + (unsigned)(u.pm * BM + ai * HALF + wr * 64 + m * 16 + fr) * 1024 + col0 + bj * HALF);
            __builtin_amdgcn_sched_barrier(0);
#pragma unroll
            for (int m = 0; m < 4; ++m) {
                const int rl = ai * HALF + wr * 64 + m * 16 + fr;
                const unsigned goff = (unsigned)(u.pm * BM + rl) * 1024 + col0;
                float ss = 0.f;
#pragma unroll
                for (int bj = 0; bj < 2; ++bj) {
                    const u32x4 w = xw[m][bj];
                    f32x4 o0, o1;
                    o0[0] = __builtin_bit_cast(float, w.x << 16) + acc[ai][bj][m][0][0]; o0[1] = __builtin_bit_cast(float, w.x & 0xffff0000u) + acc[ai][bj][m][0][1];
                    o0[2] = __builtin_bit_cast(float, w.y << 16) + acc[ai][bj][m][0][2]; o0[3] = __builtin_bit_cast(float, w.y & 0xffff0000u) + acc[ai][bj][m][0][3];
                    o1[0] = __builtin_bit_cast(float, w.z << 16) + acc[ai][bj][m][1][0]; o1[1] = __builtin_bit_cast(float, w.z & 0xffff0000u) + acc[ai][bj][m][1][1];
                    o1[2] = __builtin_bit_cast(float, w.w << 16) + acc[ai][bj][m][1][2]; o1[3] = __builtin_bit_cast(float, w.w & 0xffff0000u) + acc[ai][bj][m][1][3];
                    if (!dry) store8(xb + goff + bj * HALF, o0, o1);
                    ss += (o0[0] * o0[0] + o0[1] * o0[1]) + (o0[2] * o0[2] + o0[3] * o0[3]) + (o1[0] * o1[0] + o1[1] * o1[1]) + (o1[2] * o1[2] + o1[3] * o1[3]);
                }
                ss += __shfl_xor(ss, 16); ss += __shfl_xor(ss, 32);
                if (fq == 0 && !dry) SS[(unsigned)(u.pn * 4 + wc) * MT + u.pm * BM + rl] = ss;
                if (dry) asm volatile("" :: "v"(ss));
            }
        }
    }
};
struct EpiSwiGLU {
    static constexpr bool PERM = true, AFTER_DRAIN = false;
    bf16_t* H; const float* SS;
    __device__ __forceinline__ void operator()(const f32x4 (&acc)[2][2][4][2], const Unit& u, int wr, int wc, int fr, int fq) const {
        const int row0 = u.pm * BM + wr * 64 + fr, col0 = u.pn * 128 + wc * 32 + 8 * fq;
        float r8[8]; rows_rs8(SS, row0, fq, r8);
#pragma unroll
        for (int ai = 0; ai < 2; ++ai)
#pragma unroll
            for (int m = 0; m < 4; ++m) {
                const int row = row0 + ai * HALF + m * 16; const float r = r8[ai * 4 + m];
                const f32x4 g0 = acc[ai][0][m][0] * r, g1 = acc[ai][0][m][1] * r, u0 = acc[ai][1][m][0] * r, u1 = acc[ai][1][m][1] * r;
                store8(H + (unsigned)row * 2816 + col0, g0 * sigm4(g0) * u0, g1 * sigm4(g1) * u1);
            }
    }
};
struct EpiInProj {
    static constexpr bool PERM = true, AFTER_DRAIN = false;
    const float* SS; const float* TAB; bf16_t *UP, *Q, *K, *V, *UC; float *kP, *kS, *vP, *vS;
    __device__ __forceinline__ void operator()(const f32x4 (&acc)[2][2][4][2], const Unit& u, int wr, int wc, int fr, int fq) const {
        const int pn = u.pn; const bool smp = (u.pm >= 64);
        const int row0 = u.pm * BM + wr * 64 + fr, cw = wc * 32 + 8 * fq;
        float r8[8]; rows_rs8(SS, row0, fq, r8);
        if (pn == 0) {
#pragma unroll
            for (int ai = 0; ai < 2; ++ai)
#pragma unroll
                for (int m = 0; m < 4; ++m) { const int row = row0 + ai * HALF + m * 16; const float r = r8[ai * 4 + m];
#pragma unroll
                    for (int bj = 0; bj < 2; ++bj) store8(UP + (unsigned)row * 256 + bj * HALF + cw, acc[ai][bj][m][0] * r, acc[ai][bj][m][1] * r); }
        } else if (pn <= 4) {
            const bool isq = pn <= 2; const int t2 = (pn - 1) & 1, j = 4 * (wc & 1) + fq;
#pragma unroll
            for (int ai = 0; ai < 2; ++ai) {
                f32x4 csv[4], snv[4];
#pragma unroll
                for (int m = 0; m < 4; ++m) { const int row = row0 + ai * HALF + m * 16; const int pos = smp ? 2048 + ((row - MP) & 31) : (row & 2047);
                    csv[m] = *(const f32x4*)(TAB + pos * 64 + 4 * j); snv[m] = *(const f32x4*)(TAB + pos * 64 + 32 + 4 * j); }
                __builtin_amdgcn_sched_barrier(0);
#pragma unroll
                for (int m = 0; m < 4; ++m) { const int row = row0 + ai * HALF + m * 16; const float r = r8[ai * 4 + m];
                    const f32x4 cs = csv[m], sn = snv[m];
#pragma unroll
                    for (int bj = 0; bj < 2; ++bj) { const int grp = t2 * 4 + bj * 2 + (wc >> 1);
                        const f32x4 x1 = acc[ai][bj][m][0] * r, x2 = acc[ai][bj][m][1] * r;
                        const f32x4 o1 = x1 * cs - x2 * sn, o2 = x2 * cs + x1 * sn;
                        const unsigned bo = (unsigned)row * 512 + grp * 64 + 32 * (wc & 1) + 8 * fq;
                        if (isq) store8(Q + bo, o1 * QC2, o2 * QC2);
                        else { store8(K + bo, o1, o2);
                            float* kf = (smp ? kS + (unsigned)(row - MP) * 512 : kP + (unsigned)row * 512) + grp * 64 + 4 * j;
                            *(f32x4*)kf = o1; *(f32x4*)(kf + 32) = o2; } } } }
        } else if (pn <= 6) {
#pragma unroll
            for (int ai = 0; ai < 2; ++ai)
#pragma unroll
                for (int m = 0; m < 4; ++m) { const int row = row0 + ai * HALF + m * 16; const float r = r8[ai * 4 + m];
#pragma unroll
                    for (int bj = 0; bj < 2; ++bj) { const int col = (pn - 5) * 256 + bj * HALF + cw;
                        const f32x4 v0 = acc[ai][bj][m][0] * r, v1 = acc[ai][bj][m][1] * r;
                        store8(V + (unsigned)row * 512 + col, v0, v1);
                        float* vf = (smp ? vS + (unsigned)(row - MP) * 512 : vP + (unsigned)row * 512) + col;
                        *(f32x4*)vf = v0; *(f32x4*)(vf + 4) = v1; } }
        } else {
            const int T = pn - 7;
#pragma unroll
            for (int ai = 0; ai < 2; ++ai)
#pragma unroll
                for (int m = 0; m < 4; ++m) { const int row = row0 + ai * HALF + m * 16; const float r = r8[ai * 4 + m];
                    const f32x4 a0 = acc[ai][0][m][0] * r, a1 = acc[ai][0][m][1] * r, b0 = acc[ai][1][m][0] * r, b1 = acc[ai][1][m][1] * r;
                    store8(UC + (unsigned)row * 256 + T * 128 + cw, a0 * sigm4(b0), a1 * sigm4(b1)); }
        }
    }
};
}
#include <hip/hip_bf16.h>
#include <cmath>
namespace attn_body {
using bf16=__hip_bfloat16;
using bf16x8=__attribute__((ext_vector_type(8)))short;
using s16x4=__attribute__((ext_vector_type(4)))short;
using f32x16=__attribute__((ext_vector_type(16)))float;
using u32x4=__attribute__((ext_vector_type(4)))unsigned;
constexpr int BATCH=8,NHEAD=8,SEQ=2048,D=64,DM=512;
constexpr int NW=8,QBLK=32,QB=QBLK*NW,KVBLK=64,NQB=SEQ/QB;
constexpr int ATTN_PITCH=DM, ATTN_UNIT_ROWS=QB;
__device__ __forceinline__ int crow(int r,int hi){return (r&3)+8*(r>>2)+4*hi;}
#define SBAR() __builtin_amdgcn_sched_barrier(0)
__device__ __forceinline__ void cmask(f32x16&p0,f32x16&p1,int jb,int wid){
  if(jb>(wid>>1)){ const float NEG=-INFINITY;
  #pragma unroll
  for(int r=0;r<16;++r){p0[r]=NEG;p1[r]=NEG;} }
}

constexpr int NSLOT=3, SLOTB=8192;
constexpr int LDS_K=0, LDS_V=NSLOT*SLOTB, LDS_WS=2*NSLOT*SLOTB, LDS_OST=LDS_WS+NW*64*4, LDS_BYTES=LDS_OST+NW*4096;
constexpr float C2=0.125f*1.4426950408889634f;
__device__ __forceinline__ void glds16(const void*gsrc,unsigned lds_dst){unsigned keep;
  asm volatile("s_mov_b32 %0, m0\n\ts_mov_b32 m0, %2\n\ts_nop 0\n\tglobal_load_lds_dwordx4 %1, off\n\ts_mov_b32 m0, %0":"=&s"(keep):"v"(gsrc),"s"(lds_dst):"memory");}
__device__ __forceinline__ float max3f(float a,float b,float c){float r;asm("v_max3_f32 %0, %1, %2, %3":"=v"(r):"v"(a),"v"(b),"v"(c));return r;}
__device__ __forceinline__ float max2f(float a,float b){float r;asm("v_max_f32_e32 %0, %1, %2":"=v"(r):"v"(a),"v"(b));return r;}
__device__ __forceinline__ float fadd_s(float a,float b){float r;asm("v_add_f32_e32 %0, %1, %2":"=v"(r):"v"(a),"v"(b));return r;}
__device__ __forceinline__ float fsub_s(float a,float b){float r;asm("v_sub_f32_e32 %0, %1, %2":"=v"(r):"v"(a),"v"(b));return r;}
typedef float f32x2_t __attribute__((ext_vector_type(2))); typedef __bf16 bf16x2_t __attribute__((ext_vector_type(2)));
__device__ __forceinline__ unsigned cvtpk_s(float lo,float hi){f32x2_t v={lo,hi};bf16x2_t b=__builtin_convertvector(v,bf16x2_t);return __builtin_bit_cast(unsigned,b);}
#define WAIT_BAR(N) asm volatile("s_waitcnt vmcnt(" #N ") lgkmcnt(0)\n\ts_barrier":::"memory")

__device__ __forceinline__ void qkt(f32x16&p0,f32x16&p1,const char*Kslot,const bf16x8*qr,const f32x16&negm,int r32,int hi){
  const char*kb=Kslot+hi*1024+r32*16;
  #pragma unroll
  for(int d0=0;d0<4;++d0){
    const bf16x8 b0=*reinterpret_cast<const bf16x8*>(kb+d0*2048);
    const bf16x8 b1=*reinterpret_cast<const bf16x8*>(kb+d0*2048+512);
    if(d0==0){p0=__builtin_amdgcn_mfma_f32_32x32x16_bf16(b0,qr[0],negm,0,0,0);p1=__builtin_amdgcn_mfma_f32_32x32x16_bf16(b1,qr[0],negm,0,0,0);}
    else{p0=__builtin_amdgcn_mfma_f32_32x32x16_bf16(b0,qr[d0],p0,0,0,0);p1=__builtin_amdgcn_mfma_f32_32x32x16_bf16(b1,qr[d0],p1,0,0,0);}}
}
typedef __attribute__((address_space(3))) const char* lds_cptr;
typedef short v4i16_t __attribute__((ext_vector_type(4)));
__device__ __forceinline__ void kload8(bf16x8*kf,lds_cptr kp){
  kf[0]=*(const __attribute__((address_space(3))) bf16x8*)(kp);      kf[1]=*(const __attribute__((address_space(3))) bf16x8*)(kp+512);
  kf[2]=*(const __attribute__((address_space(3))) bf16x8*)(kp+2048); kf[3]=*(const __attribute__((address_space(3))) bf16x8*)(kp+2560);
  kf[4]=*(const __attribute__((address_space(3))) bf16x8*)(kp+4096); kf[5]=*(const __attribute__((address_space(3))) bf16x8*)(kp+4608);
  kf[6]=*(const __attribute__((address_space(3))) bf16x8*)(kp+6144); kf[7]=*(const __attribute__((address_space(3))) bf16x8*)(kp+6656);
}
__device__ __forceinline__ void kload2(bf16x8*kf,lds_cptr kp,int j){ kf[2*j]=*(const __attribute__((address_space(3))) bf16x8*)(kp+j*2048); kf[2*j+1]=*(const __attribute__((address_space(3))) bf16x8*)(kp+j*2048+512); }
__device__ __forceinline__ s16x4 vtr(lds_cptr p){ return __builtin_bit_cast(s16x4,__builtin_amdgcn_ds_read_tr16_b64_v4i16((__attribute__((address_space(3))) v4i16_t*)p)); }
__device__ __forceinline__ float rowmax(const f32x16&p0,const f32x16&p1){
  float a=max3f(p0[0],p0[1],p1[0]),b=max3f(p0[2],p0[3],p1[1]);a=max3f(a,p1[2],p1[3]);
  #pragma unroll
  for(int r=4;r<16;r+=4){a=max3f(a,p0[r],p0[r+1]);b=max3f(b,p0[r+2],p0[r+3]);a=max3f(a,p1[r],p1[r+1]);b=max3f(b,p1[r+2],p1[r+3]);}
  const float m=max2f(a,b);
  auto rr=__builtin_amdgcn_permlane32_swap(__float_as_uint(m),__float_as_uint(m),false,false);
  return max2f(__uint_as_float(rr[0]),__uint_as_float(rr[1]));
}
__device__ __forceinline__ void pv(f32x16*o,int vb,bf16x8 pa0,bf16x8 pa1,bf16x8 pa2,bf16x8 pa3){
  #pragma unroll
  for(int d0=0;d0<2;++d0){s16x4 lo[4],hi[4];
    #pragma unroll
    for(int ks=0;ks<4;++ks){
      asm volatile("ds_read_b64_tr_b16 %0,%1 offset:%c2":"=&v"(lo[ks]):"v"(vb),"i"(d0*4096+ks*1024):"memory");
      asm volatile("ds_read_b64_tr_b16 %0,%1 offset:%c2":"=&v"(hi[ks]):"v"(vb),"i"(d0*4096+ks*1024+512):"memory");}
    asm volatile("s_waitcnt lgkmcnt(0)":::"memory");SBAR();
    #define PK(k) (bf16x8){lo[k][0],lo[k][1],lo[k][2],lo[k][3],hi[k][0],hi[k][1],hi[k][2],hi[k][3]}
    o[d0]=__builtin_amdgcn_mfma_f32_32x32x16_bf16(pa0,PK(0),o[d0],0,0,0);
    o[d0]=__builtin_amdgcn_mfma_f32_32x32x16_bf16(pa1,PK(1),o[d0],0,0,0);
    o[d0]=__builtin_amdgcn_mfma_f32_32x32x16_bf16(pa2,PK(2),o[d0],0,0,0);
    o[d0]=__builtin_amdgcn_mfma_f32_32x32x16_bf16(pa3,PK(3),o[d0],0,0,0);
    #undef PK
  }
}

#ifndef ATTN_STORE16
#define ATTN_STORE16(p,v) (*(u32x4*)(p)=(v))
#endif
template<int THRL> __device__ __forceinline__ void attn_unit(int b,int h,int hv,int qb,const bf16*Q,const bf16*__restrict__ K,const bf16*__restrict__ V,bf16*O,int ocol,char*shm){
  int tid_l=threadIdx.x; asm volatile("":"+v"(tid_l)); const int tid=tid_l,lane=tid&63,r32=lane&31,hi=lane>>5; const int wid=__builtin_amdgcn_readfirstlane(tid>>6);
  const long rowbase=(long)b*SEQ; const int q0=qb*QB;
  const bf16*Qw=Q+(rowbase+q0+wid*QBLK)*DM+h*D;
  const bf16*Kh=K+rowbase*DM+h*D,*Vh=V+rowbase*DM+hv*D;
  const unsigned lds0=(unsigned)(uintptr_t)shm;
  float*wsf=(float*)(shm+LDS_WS)+wid*64;
  const bf16*ksrc=Kh+(long)lane*DM+wid*8;
  const bf16*vsrc=Vh+(long)(16*(wid&3)+(lane>>2))*DM+(wid>>2)*32+(lane&3)*8;
  const unsigned kdst=lds0+LDS_K+wid*1024, vdst=lds0+LDS_V+wid*1024;
  #define DMA_K(t,slot) glds16(ksrc+(long)(t)*KVBLK*DM,(unsigned)__builtin_amdgcn_readfirstlane(kdst+(slot)))
  #define DMA_V(t,slot) glds16(vsrc+(long)(t)*KVBLK*DM,(unsigned)__builtin_amdgcn_readfirstlane(vdst+(slot)))
  const int vb0=(int)(lds0+LDS_V)+((lane>>4)&1)*32+(lane&3)*8+(4*hi+((lane&15)>>2))*64;
  const char*Kbase=shm+LDS_K; bf16x8 kf[8];
  const lds_cptr shm3=(lds_cptr)shm; const lds_cptr kp0=shm3+LDS_K+hi*1024+r32*16; const lds_cptr vp0=shm3+LDS_V+((lane>>4)&1)*32+(lane&3)*8+(4*hi+((lane&15)>>2))*64;
  const int NT=(q0+QB)/KVBLK;
  DMA_K(0,0);DMA_V(0,0);DMA_K(1,SLOTB);
  bf16x8 qr[4];
  #pragma unroll
  for(int d0=0;d0<4;++d0)qr[d0]=*reinterpret_cast<const bf16x8*>(&Qw[(long)r32*DM+d0*16+hi*8]);
  float mhat=0.f,l_reg=0.f;f32x16 o[2];o[0]=f32x16{};o[1]=f32x16{};f32x16 negm=f32x16{};asm volatile("":"+v"(negm));
  const int qrel=wid*QBLK+r32;
  #define CMASK(P0,P1,t) do{int jb_=(t)-(NT-4); if(jb_>=0)cmask(P0,P1,jb_,wid);}while(0)
  bool resc=false;
  #define START(P0,P1) do{ const float rm=rowmax(P0,P1); resc=false; \
    { const float dl=rm; mhat=fadd_s(mhat,dl); \
      _Pragma("unroll") for(int r=0;r<16;++r){P0[r]=fsub_s(P0[r],dl);P1[r]=fsub_s(P1[r],dl);} \
      _Pragma("unroll") for(int r=0;r<16;++r)negm[r]=-mhat; asm volatile("":"+v"(negm)); } \
    _Pragma("unroll") for(int r=0;r<16;++r)P0[r]=__builtin_amdgcn_exp2f(P0[r]); }while(0)
  #define RESC() do{ if(resc){ asm volatile("s_waitcnt lgkmcnt(0)":::"memory"); \
      _Pragma("unroll") for(int d_=0;d_<2;++d_) _Pragma("unroll") for(int r=0;r<16;++r)o[d_][r]*=wsf[crow(r,hi)]; } }while(0)
  f32x16 pA0,pA1,pB0,pB1;
  int sl_prev=0,sl_cur=0,sl_next=SLOTB;
  #define ROT() do{sl_prev=sl_cur;sl_cur=sl_next;sl_next=(sl_next==(NSLOT-1)*SLOTB)?0:sl_next+SLOTB;}while(0)
  DMA_K(2,2*SLOTB);
  WAIT_BAR(3);
  qkt(pA0,pA1,Kbase,qr,negm,r32,hi);asm volatile("s_nop 15\n\ts_nop 7":"+v"(pA0),"+v"(pA1));CMASK(pA0,pA1,0);
  START(pA0,pA1);
  _Pragma("unroll") for(int r=0;r<16;++r)pA1[r]=__builtin_amdgcn_exp2f(pA1[r]);
  WAIT_BAR(0);
  DMA_K(3,0);DMA_V(1,SLOTB);
  ROT();
  kload8(kf,kp0+sl_cur);
  WAIT_BAR(2);
  s16x4 vlo[8],vhi[8]; u32x4 pw0,pw1,pw2,pw3;
  #define PKW(P,B) cvtpk_s(P[B],P[B+1])
  #define PAF(k) __builtin_bit_cast(bf16x8,pw##k)
  #define VFR(i) (bf16x8){vlo[i][0],vlo[i][1],vlo[i][2],vlo[i][3],vhi[i][0],vhi[i][1],vhi[i][2],vhi[i][3]}
  #define PIN(x) asm volatile("":"+v"(x))
  #define MX3(a,b,c) __builtin_fmaxf(__builtin_fmaxf((a),(b)),(c))
  #define GAPA(MF,A0,A1,A2,A3,W0,W1,PW) do{ MF; sacc+=A0; sacc+=A1; sacc+=A2; sacc+=A3; PIN(sacc); W0; W1; PIN(PW); SBAR(); }while(0)
  #define EX(v) __builtin_amdgcn_exp2f(v)
  #define GAPB(MF,X,B) do{ MF; X[B]=EX(X[B]); X[B+1]=EX(X[B+1]); X[B+2]=EX(X[B+2]); X[B+3]=EX(X[B+3]); PIN(X); SBAR(); }while(0)
  #define VRD(i) do{ vlo[i]=vtr(vp_+(((i)>>2)*4096+((i)&3)*1024)); vhi[i]=vtr(vp_+(((i)>>2)*4096+((i)&3)*1024+512)); }while(0)
  #define KRD(G,j) do{ if(G){ kload2(kf,kp0+sl_next,j); SBAR(); } }while(0)
  #define STEP(C0,C1,P0,P1,t,GK,GV,GL) do{ SBAR(); \
    const lds_cptr vp_=vp0+sl_prev; \
    VRD(0); SBAR(); float sacc=(P0[0]+P0[1]); \
    GAPA(C0=__builtin_amdgcn_mfma_f32_32x32x16_bf16(kf[0],qr[0],negm,0,0,0), P0[2],P0[3],P0[4],P0[5],     pw0[0]=PKW(P0,0), pw0[1]=PKW(P0,2), pw0); \
    VRD(4); SBAR(); GAPA(C1=__builtin_amdgcn_mfma_f32_32x32x16_bf16(kf[1],qr[0],negm,0,0,0), P0[6],P0[7],P0[8],P0[9],     pw0[2]=PKW(P0,4), pw0[3]=PKW(P0,6), pw0); \
    VRD(1); SBAR(); GAPA(C0=__builtin_amdgcn_mfma_f32_32x32x16_bf16(kf[2],qr[1],C0,0,0,0),   P0[10],P0[11],P0[12],P0[13], pw1[0]=PKW(P0,8), pw1[1]=PKW(P0,10), pw1); \
    VRD(5); SBAR(); GAPA(C1=__builtin_amdgcn_mfma_f32_32x32x16_bf16(kf[3],qr[1],C1,0,0,0),   P0[14],P0[15],P1[0],P1[1],   pw1[2]=PKW(P0,12),pw1[3]=PKW(P0,14), pw1); \
    VRD(2); SBAR(); GAPA(C0=__builtin_amdgcn_mfma_f32_32x32x16_bf16(kf[4],qr[2],C0,0,0,0),   P1[2],P1[3],P1[4],P1[5],     pw2[0]=PKW(P1,0), pw2[1]=PKW(P1,2), pw2); \
    VRD(6); SBAR(); GAPA(C1=__builtin_amdgcn_mfma_f32_32x32x16_bf16(kf[5],qr[2],C1,0,0,0),   P1[6],P1[7],P1[8],P1[9],     pw2[2]=PKW(P1,4), pw2[3]=PKW(P1,6), pw2); \
    VRD(3); SBAR(); GAPA(C0=__builtin_amdgcn_mfma_f32_32x32x16_bf16(kf[6],qr[3],C0,0,0,0),   P1[10],P1[11],P1[12],P1[13], pw3[0]=PKW(P1,8), pw3[1]=PKW(P1,10), pw3); \
    VRD(7); SBAR(); GAPA(C1=__builtin_amdgcn_mfma_f32_32x32x16_bf16(kf[7],qr[3],C1,0,0,0),   P1[14],P1[15],0.f,0.f,       pw3[2]=PKW(P1,12),pw3[3]=PKW(P1,14), pw3); \
    l_reg+=sacc; \
    if(GK){DMA_K((t)+3,sl_cur);} if(GV){DMA_V((t)+1,sl_next);} \
    CMASK(C0,C1,t); \
    { float a=MX3(C0[0],C0[1],C1[0]),b=MX3(C0[2],C0[3],C1[1]); a=MX3(a,C1[2],C1[3]); \
      _Pragma("unroll") for(int r=4;r<16;r+=4){a=MX3(a,C0[r],C0[r+1]);b=MX3(b,C0[r+2],C0[r+3]);a=MX3(a,C1[r],C1[r+1]);b=MX3(b,C1[r+2],C1[r+3]);} \
      float rm=__builtin_fmaxf(a,b); { auto rr=__builtin_amdgcn_permlane32_swap(__float_as_uint(rm),__float_as_uint(rm),false,false); rm=__builtin_fmaxf(__uint_as_float(rr[0]),__uint_as_float(rr[1])); } \
      resc=false; \
      if(__builtin_expect(__any(rm>(float)THRL),0)){ const float dl=__builtin_fmaxf(rm,0.f); mhat+=dl; \
        _Pragma("unroll") for(int r=0;r<16;++r){C0[r]-=dl;C1[r]-=dl;} \
        _Pragma("unroll") for(int r=0;r<16;++r)negm[r]=-mhat; asm volatile("":"+v"(negm)); \
        const float f=__builtin_amdgcn_exp2f(-dl); l_reg*=f; if(hi==0)wsf[r32]=f; resc=true; } } \
    SBAR(); \
    GAPB(o[0]=__builtin_amdgcn_mfma_f32_32x32x16_bf16(PAF(0),VFR(0),o[0],0,0,0), C0,0); \
    GAPB(o[1]=__builtin_amdgcn_mfma_f32_32x32x16_bf16(PAF(0),VFR(4),o[1],0,0,0), C0,4); \
    KRD(GL,0); GAPB(o[0]=__builtin_amdgcn_mfma_f32_32x32x16_bf16(PAF(1),VFR(1),o[0],0,0,0), C0,8); \
    KRD(GL,1); GAPB(o[1]=__builtin_amdgcn_mfma_f32_32x32x16_bf16(PAF(1),VFR(5),o[1],0,0,0), C0,12); \
    KRD(GL,2); GAPB(o[0]=__builtin_amdgcn_mfma_f32_32x32x16_bf16(PAF(2),VFR(2),o[0],0,0,0), C1,0); \
    KRD(GL,3); GAPB(o[1]=__builtin_amdgcn_mfma_f32_32x32x16_bf16(PAF(2),VFR(6),o[1],0,0,0), C1,4); \
    GAPB(o[0]=__builtin_amdgcn_mfma_f32_32x32x16_bf16(PAF(3),VFR(3),o[0],0,0,0), C1,8); \
    GAPB(o[1]=__builtin_amdgcn_mfma_f32_32x32x16_bf16(PAF(3),VFR(7),o[1],0,0,0), C1,12); \
    }while(0)
  int t=1;
  #undef CMASK
  #define CMASK(P0,P1,t) do{}while(0)
  for(;t+5<NT;t+=2){
    STEP(pB0,pB1,pA0,pA1,t,true,true,true);     WAIT_BAR(2); RESC(); ROT();
    STEP(pA0,pA1,pB0,pB1,t+1,true,true,true);   WAIT_BAR(2); RESC(); ROT();
  }
  #undef CMASK
  #define CMASK(P0,P1,t) do{int jb_=(t)-(NT-4); if(jb_>=0)cmask(P0,P1,jb_,wid);}while(0)
  #define ENDW(tt) do{ if((tt)+3<NT){WAIT_BAR(2);} else if((tt)+2<NT){WAIT_BAR(1);} else {WAIT_BAR(0);} }while(0)
  for(;t+1<NT;t+=2){
    STEP(pB0,pB1,pA0,pA1,t,(t+3<NT),(t+1<NT),(t+1<NT));       ENDW(t);   RESC(); ROT();
    STEP(pA0,pA1,pB0,pB1,t+1,(t+4<NT),(t+2<NT),(t+2<NT));     ENDW(t+1); RESC(); ROT();
  }
  STEP(pB0,pB1,pA0,pA1,NT-1,false,false,false); RESC();
  { float sacc=pB0[0]+pB0[1]; _Pragma("unroll") for(int r=2;r<16;++r)sacc+=pB0[r]; _Pragma("unroll") for(int r=0;r<16;++r)sacc+=pB1[r]; l_reg+=sacc;
    pw0=(u32x4){PKW(pB0,0),PKW(pB0,2),PKW(pB0,4),PKW(pB0,6)};pw1=(u32x4){PKW(pB0,8),PKW(pB0,10),PKW(pB0,12),PKW(pB0,14)};pw2=(u32x4){PKW(pB1,0),PKW(pB1,2),PKW(pB1,4),PKW(pB1,6)};pw3=(u32x4){PKW(pB1,8),PKW(pB1,10),PKW(pB1,12),PKW(pB1,14)};
    SBAR(); pv(o,vb0+sl_cur,PAF(0),PAF(1),PAF(2),PAF(3)); }
  #undef PKW
  #undef PAF
  #undef VFR
  #undef PIN
  #undef MX3
  #undef GAPA
  #undef GAPB
  #undef EX
  #undef VRD
  #undef KRD
  #undef STEP
  #undef ENDW
  {auto rr=__builtin_amdgcn_permlane32_swap(__float_as_uint(l_reg),__float_as_uint(l_reg),false,false);l_reg=__uint_as_float(rr[0])+__uint_as_float(rr[1]);}
  if(hi==0)wsf[32+r32]=l_reg;asm volatile("s_waitcnt lgkmcnt(0)":::"memory");
  float rli[16];
  #pragma unroll
  for(int r=0;r<16;++r)rli[r]=__builtin_amdgcn_rcpf(wsf[32+crow(r,hi)]);
  bf16*Ow=O+(rowbase+q0+wid*QBLK)*1024+ocol;
  { bf16*stg=(bf16*)(shm+LDS_OST)+wid*2048;
    #pragma unroll
    for(int r=0;r<16;++r){const int orow=crow(r,hi);
      #pragma unroll
      for(int d0=0;d0<2;++d0)stg[orow*64+d0*32+r32]=__float2bfloat16(o[d0][r]*rli[r]);}
    asm volatile("s_waitcnt lgkmcnt(0)":::"memory");
    #pragma unroll
    for(int i=0;i<4;++i){const int row=i*8+(lane>>3),ch=lane&7; const u32x4 v=*(const u32x4*)(stg+row*64+ch*8); ATTN_STORE16(Ow+(long)row*1024+ch*8,v);} }
  asm volatile("s_waitcnt lgkmcnt(0)\n\ts_barrier":::"memory");
  #undef DMA_K
  #undef DMA_V
  #undef CMASK
  #undef START
  #undef RESC
  #undef ROT
}
constexpr int ATTN_LDS_BYTES=LDS_BYTES;
#undef SBAR
#undef WAIT_BAR
}
#ifndef MK_MULTI
#define MK_MULTI 0
#endif
#ifndef REP_SYNC
#define REP_SYNC 0
#endif
#ifndef REP_FOLD
#define REP_FOLD 1
#endif
#ifndef REP_SLACK
#define REP_SLACK 1
#endif
#ifndef SLACK_W
#define SLACK_W 1
#endif
constexpr int NWAVES = 8, NPH = 14;
constexpr int MT = pg8::MT, MP = pg8::MP, DM_ = 1024, INW = 2304, DFF = 2816;
constexpr size_t MiB = 1u << 20;
constexpr size_t WS_TAB = 1 * MiB;
constexpr size_t WS_LAM = 2 * MiB;
constexpr size_t WS_SS = 3 * MiB;
constexpr size_t WS_WIN = 5 * MiB, WS_WOUT = 14 * MiB, WS_WGU = 18 * MiB, WS_WDN = 40 * MiB;
constexpr size_t WS_XB = 52 * MiB;
constexpr size_t WS_SPO = 86 * MiB;
constexpr size_t WS_SPM = 95 * MiB;
constexpr size_t WS_Q = 96 * MiB, WS_K = 113 * MiB, WS_V = 130 * MiB, WS_UP = 147 * MiB, WS_UC = 156 * MiB, WS_O4 = 165 * MiB, WS_MIX = 197 * MiB;
constexpr size_t WS_H = 96 * MiB;
constexpr size_t WS_END = 230 * MiB;
static_assert(WS_H + (size_t)MT * DFF * 2 <= WS_MIX && WS_MIX + (size_t)MT * 1024 * 2 <= WS_END, "ws map");
constexpr size_t O_Y = 0, O_KP = 17039360, O_VP = 33816576, O_PP = 50593792, O_CP = 50655232, O_KS = 50778112, O_VS = 51040256, O_PS = 51302400, O_CS = 51363840, O_END = 51486720;
constexpr int LDS_BYTES = 147456;

#define LAS __attribute__((address_space(3)))
typedef unsigned short bf16;
typedef unsigned v4u __attribute__((ext_vector_type(4)));
typedef unsigned v2u __attribute__((ext_vector_type(2)));
typedef float f32x4 __attribute__((ext_vector_type(4)));
typedef float f32x16 __attribute__((ext_vector_type(16)));
typedef short bf16x8 __attribute__((ext_vector_type(8)));
__device__ __forceinline__ unsigned f2bf(float f) { unsigned u = __builtin_bit_cast(unsigned, f); return (u + 0x7fffu + ((u >> 16) & 1u)) >> 16; }
__device__ __forceinline__ unsigned pk2(float lo, float hi) { return f2bf(lo) | (f2bf(hi) << 16); }
__device__ __forceinline__ float bflo(unsigned w) { return __builtin_bit_cast(float, w << 16); }
__device__ __forceinline__ float bfhi(unsigned w) { return __builtin_bit_cast(float, w & 0xffff0000u); }
__device__ __forceinline__ float wave_sum(float v) {
#pragma unroll
    for (int o = 1; o < 64; o <<= 1) v += __shfl_xor(v, o);
    return v;
}
struct Args { const float* in[22]; float* out; unsigned char* ws; int ph_lo, ph_hi; };
struct Frame { int tid, lane, wave, vcu, G, gw, NGW; };

#define XB_TMO      128
#define XB_XCNT(j)  (256  + 64 * (j))
#define XB_XSUB(j)  (1280 + 64 * (j))
#define XB_XGEN(j)  (2304 + 64 * (j))
#define XB_TOP      3328
#define XB_TOPGEN   3392
#define XCD_BAR_WORDS 3456
#define XB_SPIN_CAP (1u << 18)

__device__ __forceinline__ unsigned xb_ld(unsigned* p)              { return __hip_atomic_load(p, __ATOMIC_RELAXED, __HIP_MEMORY_SCOPE_AGENT); }
__device__ __forceinline__ unsigned xb_add(unsigned* p, unsigned v) { return __hip_atomic_fetch_add(p, v, __ATOMIC_RELAXED, __HIP_MEMORY_SCOPE_AGENT); }
__device__ __forceinline__ unsigned xb_xcc_id() { return (unsigned)__builtin_amdgcn_s_getreg((3 << 11) | 20) & 0xFu; }
#define XB_SPIN(cond, bar) do { unsigned _sp = 0; while (cond) { __builtin_amdgcn_s_sleep(1); \
    if ((++_sp & 255u) == 0u) { if (xb_ld(&(bar)[XB_TMO])) break; if (_sp > XB_SPIN_CAP) { atomicAdd(&(bar)[XB_TMO], 1u); break; } } } } while (0)

struct XcdBarrier {
    unsigned* bar; unsigned x;
    volatile LAS unsigned* st;
};

__device__ __forceinline__ XcdBarrier xcd_barrier_post(unsigned* bar, volatile LAS unsigned* st) {
    XcdBarrier b; b.bar = bar; b.x = xb_xcc_id(); b.st = st;
    if (threadIdx.x == 0) (void)xb_add(&bar[XB_XCNT(b.x)], 1u);
    return b;
}
__device__ __forceinline__ void xcd_barrier_complete(unsigned* bar, unsigned x, unsigned& nloc, unsigned& nx) {
    const unsigned G = gridDim.x * gridDim.y * gridDim.z;
    unsigned sum, cnt, mine, sp = 0u;
    for (;;) {
        sum = 0u; cnt = 0u; mine = 0u;
#pragma unroll
        for (unsigned j = 0; j < 16; ++j) { const unsigned c = xb_ld(&bar[XB_XCNT(j)]); sum += c; cnt += (c > 0u) ? 1u : 0u; mine = (j == x) ? c : mine; }
        if (sum == G) break;
        __builtin_amdgcn_s_sleep(1);
        if ((++sp & 255u) == 0u) { if (xb_ld(&bar[XB_TMO])) break; if (sp > XB_SPIN_CAP) { atomicAdd(&bar[XB_TMO], 1u); break; } }
    }
    nloc = mine > 0u ? mine : 1u; nx = cnt > 0u ? cnt : 1u;
}

__device__ __forceinline__ void xcd_barrier(const XcdBarrier& b) {
    asm volatile("s_waitcnt vmcnt(0)" ::: "memory");
    __syncthreads();
    if (threadIdx.x == 0) {
        unsigned* bar = b.bar;
        __builtin_amdgcn_s_waitcnt(0);
        unsigned nloc = b.st[0], nx = b.st[1];
        if (nloc == 0u) { xcd_barrier_complete(bar, b.x, nloc, nx); b.st[0] = nloc; b.st[1] = nx; }
        const unsigned old = xb_add(&bar[XB_XSUB(b.x)], 1u);
        const unsigned gen = old / nloc;
        if (old + 1u == (gen + 1u) * nloc) {
            __builtin_amdgcn_fence(__ATOMIC_RELEASE, "agent");
            asm volatile("s_waitcnt vmcnt(0)" ::: "memory");
            const unsigned og = xb_add(&bar[XB_TOP], 1u);
            const unsigned tg = og / nx;
            if (og + 1u == (tg + 1u) * nx) xb_add(&bar[XB_TOPGEN], 1u);
            else XB_SPIN(xb_ld(&bar[XB_TOPGEN]) == tg, bar);
            __builtin_amdgcn_fence(__ATOMIC_ACQUIRE, "agent");
            xb_add(&bar[XB_XGEN(b.x)], 1u);
            asm volatile("s_waitcnt vmcnt(0)" ::: "memory");
        } else {
            XB_SPIN(xb_ld(&bar[XB_XGEN(b.x)]) == gen, bar);
            __builtin_amdgcn_fence(__ATOMIC_ACQUIRE, "agent");
            asm volatile("s_waitcnt vmcnt(0)" ::: "memory");
        }
    }
    __syncthreads();
}

constexpr int MISC_OFF = 147200;
__device__ __forceinline__ int perm_in(int n) {
    if (n < 256) return n;
    if (n < 1280) { const int p = n & 63, j = p >> 3, nn = (p >> 2) & 1, i = p & 3; return (n & ~63) + 32 * nn + 4 * j + i; }
    if (n < 1792) return n;
    const int x = n - 1792, T = x >> 8, bj = (x >> 7) & 1, cc = x & 127; return 1792 + 256 * bj + 128 * T + cc;
}
__device__ __forceinline__ int perm_gu(int n) { const int T = n >> 8, bj = (n >> 7) & 1, cc = n & 127; return 2816 * bj + 128 * T + cc; }
template <int MODE> __device__ __forceinline__ void transpose_item(const float* W, int ldw, const float* gk, bf16* WT, int ldwt, int koff, int nblk, LAS float* scr, int item, int lane) {
    (void)scr;
    const int kb = item / nblk, nb = item % nblk, k0 = 64 * kb, np = 64 * nb + lane;
    const int src = (MODE == 1) ? perm_in(np) : (MODE == 2) ? perm_gu(np) : np;
    const float* wp = W + (size_t)k0 * ldw + src;
    float v[64];
#pragma unroll
    for (int t = 0; t < 64; ++t) v[t] = __builtin_nontemporal_load(wp + (size_t)t * ldw);
    __builtin_amdgcn_sched_barrier(0);
    bf16* op = WT + (size_t)np * ldwt + koff + k0;
#pragma unroll
    for (int kc = 0; kc < 8; ++kc) {
        float g[8];
#pragma unroll
        for (int t = 0; t < 8; ++t) g[t] = gk ? gk[k0 + 8 * kc + t] : 1.0f;
        v4u o; o.x = pg8::cvt_pk_bf16(v[8 * kc] * g[0], v[8 * kc + 1] * g[1]); o.y = pg8::cvt_pk_bf16(v[8 * kc + 2] * g[2], v[8 * kc + 3] * g[3]);
        o.z = pg8::cvt_pk_bf16(v[8 * kc + 4] * g[4], v[8 * kc + 5] * g[5]); o.w = pg8::cvt_pk_bf16(v[8 * kc + 6] * g[6], v[8 * kc + 7] * g[7]);
        *(v4u*)(op + 8 * kc) = o; }
}
__device__ __forceinline__ void fold_item(const float* pool_w, const float* pool_scale, const float* conv_pw, const float* w_out, bf16* WT, LAS float* scr, int item, int lane) {
    const int kb = item >> 4, nb = item & 15, n = nb * 64 + lane;
    float acc[8];
#pragma unroll
    for (int i = 0; i < 8; ++i) acc[i] = 0.f;
    int k0, D, rb;
    if (kb < 32) { k0 = kb * 8; D = 64; const int g = k0 >> 6; rb = 64 * g; const float ps = pool_scale[64 * g + lane];
        float pw[8];
#pragma unroll
        for (int i = 0; i < 8; ++i) pw[i] = pool_w[(size_t)(g * 64 + ((k0 + i) & 63)) * 64 + lane];
        __builtin_amdgcn_sched_barrier(0);
#pragma unroll
        for (int i = 0; i < 8; ++i) scr[i * 64 + lane] = pw[i] * ps;
    } else { k0 = 768 + (kb - 32) * 8; D = 256; rb = 768;
        f32x4 cw[8];
#pragma unroll
        for (int i = 0; i < 8; ++i) cw[i] = *(const f32x4*)(conv_pw + (size_t)(k0 - 768 + i) * 256 + 4 * lane);
        __builtin_amdgcn_sched_barrier(0);
#pragma unroll
        for (int i = 0; i < 8; ++i) *(LAS f32x4*)(scr + i * 256 + 4 * lane) = cw[i];
    }
    asm volatile("s_waitcnt lgkmcnt(0)" ::: "memory");
    const float* wp = w_out + (size_t)rb * 1024 + n;
#pragma unroll 1
    for (int d = 0; d < D; d += 32) {
        float wv[32];
#pragma unroll
        for (int q = 0; q < 32; ++q) wv[q] = wp[(size_t)(d + q) * 1024];
        __builtin_amdgcn_sched_barrier(0);
#pragma unroll
        for (int q = 0; q < 32; q += 4)
#pragma unroll
            for (int i = 0; i < 8; ++i) { const f32x4 cf = *(const LAS f32x4*)(scr + i * D + d + q); acc[i] += (cf.x * wv[q] + cf.y * wv[q + 1]) + (cf.z * wv[q + 2] + cf.w * wv[q + 3]); }
        __builtin_amdgcn_sched_barrier(0);
    }
    asm volatile("s_waitcnt lgkmcnt(0)" ::: "memory");
    v4u o; o.x = pk2(acc[0], acc[1]); o.y = pk2(acc[2], acc[3]); o.z = pk2(acc[4], acc[5]); o.w = pk2(acc[6], acc[7]);
    *(v4u*)(WT + (size_t)n * 1024 + k0) = o;
}
constexpr int WI_A = 576, WI_B = 3840, WI_C = 5568, WI_END = 7680;
__device__ __forceinline__ void wi_in(const Args& A, LAS float* scr, int lane, int l, int it) { transpose_item<1>(A.in[7] + (size_t)l * 1024 * INW, INW, A.in[6] + l * 1024, (bf16*)(A.ws + WS_WIN) + (size_t)l * INW * 1024, 1024, 0, INW / 64, scr, it, lane); }
__device__ __forceinline__ void wi_gu(const Args& A, LAS float* scr, int lane, int l, int it) { transpose_item<2>(A.in[19] + (size_t)l * 1024 * 2 * DFF, 2 * DFF, A.in[18] + l * 1024, (bf16*)(A.ws + WS_WGU) + (size_t)l * 2 * DFF * 1024, 1024, 0, 2 * DFF / 64, scr, it, lane); }
__device__ __forceinline__ void wi_dn(const Args& A, LAS float* scr, int lane, int l, int it) { transpose_item<0>(A.in[20] + (size_t)l * DFF * 1024, 1024, nullptr, (bf16*)(A.ws + WS_WDN) + (size_t)l * 1024 * DFF, DFF, 0, 1024 / 64, scr, it, lane); }
__device__ __forceinline__ void wi_mid(const Args& A, LAS float* scr, int lane, int l, int it) { transpose_item<0>(A.in[17] + (size_t)l * 1024 * 1024 + 256 * 1024, 1024, nullptr, (bf16*)(A.ws + WS_WOUT) + (size_t)l * 1024 * 1024, 1024, 256, 1024 / 64, scr, it, lane); }
__device__ __forceinline__ void wi_fold(const Args& A, LAS float* scr, int lane, int l, int it) { fold_item(A.in[8] + (size_t)l * 4 * 64 * 64, A.in[9] + l * 256, A.in[16] + (size_t)l * 256 * 256, A.in[17] + (size_t)l * 1024 * 1024, (bf16*)(A.ws + WS_WOUT) + (size_t)l * 1024 * 1024, scr, it, lane); }
__device__ __forceinline__ void weight_items(const Args& A, LAS float* scr, int lane, int first, int last, int w0, int nw) {
#pragma unroll 1
    for (int idx = first + w0; idx < last; idx += nw) {
        if (idx < WI_A) wi_in(A, scr, lane, 0, idx);
        else if (idx < WI_B) { const int a = idx - WI_A; if (a < 1408) wi_gu(A, scr, lane, 0, a); else if (a < 2112) wi_dn(A, scr, lane, 0, a - 1408); else if (a < 2240) wi_mid(A, scr, lane, 0, a - 2112); else wi_fold(A, scr, lane, 0, a - 2240); }
        else if (idx < WI_C) { const int b2 = idx - WI_B; if (b2 < 576) wi_in(A, scr, lane, 1, b2); else if (b2 < 704) wi_mid(A, scr, lane, 1, b2 - 576); else wi_fold(A, scr, lane, 1, b2 - 704); }
        else { const int c2 = idx - WI_C; if (c2 < 1408) wi_gu(A, scr, lane, 1, c2); else wi_dn(A, scr, lane, 1, c2 - 1408); }
    }
}
__device__ __forceinline__ void slack_weights(const Frame& F, const Args& A, LAS unsigned char* lds, int nwg, int first, int last) {
    const int rounds = (nwg + F.G - 1) / F.G, nfull = nwg - (rounds - 1) * F.G, c = (int)blockIdx.x;
    int sl = F.lane; asm volatile("" : "+v"(sl));
    LAS float* scr = (LAS float*)(lds + F.wave * 16640);
    if (nfull >= F.G) weight_items(A, scr, sl, first, last, F.gw, F.NGW);
    else if (c >= nfull) weight_items(A, scr, sl, first, last, (c - nfull) * NWAVES + F.wave, (F.G - nfull) * NWAVES);
    __syncthreads();
}
__device__ __forceinline__ void p0_prologue(const Frame& F, const Args& A, LAS unsigned char* lds) {
    unsigned char* ws = A.ws;
    LAS float* scr = (LAS float*)(lds + F.wave * 16640);
    int lane_l = F.lane; asm volatile("" : "+v"(lane_l)); const int gw = F.gw, NGW = F.NGW, lane = lane_l;
    weight_items(A, scr, lane, 0, SLACK_W ? WI_A : WI_END, gw, NGW);
    { bf16* XB = (bf16*)(ws + WS_XB); float* SS = (float*)(ws + WS_SS);
      for (int m0 = gw * 2; m0 < MT; m0 += NGW * 2) {
        f32x4 v[2][4];
#pragma unroll
        for (int q = 0; q < 2; ++q) { const int m = m0 + q; const float* xr = (m < MP) ? A.in[0] + (size_t)m * 1024 : A.in[1] + (size_t)(m - MP) * 1024;
#pragma unroll
            for (int j = 0; j < 4; ++j) v[q][j] = __builtin_nontemporal_load((const f32x4*)xr + lane + 64 * j); }
        __builtin_amdgcn_sched_barrier(0);
#pragma unroll
        for (int q = 0; q < 2; ++q) { const int m = m0 + q; float s = 0.f;
#pragma unroll
            for (int j = 0; j < 4; ++j) { const f32x4 w = v[q][j]; s += (w.x * w.x + w.y * w.y) + (w.z * w.z + w.w * w.w);
                v2u o; o.x = pk2(w.x, w.y); o.y = pk2(w.z, w.w); *((v2u*)(XB + (size_t)m * 1024) + lane + 64 * j) = o; }
            s = wave_sum(s);
            if (lane < 16) SS[(size_t)lane * MT + m] = (lane == 0) ? s : 0.f;
            if (m >= MP && lane < 32) SS[(size_t)16 * MT + lane * 256 + (m - MP)] = (lane == 0) ? s : 0.f; }
      } }
    { float* TAB = (float*)(ws + WS_TAB);
      for (int i = gw * 64 + lane; i < 2080 * 32; i += NGW * 64) { const int pos = i >> 5, f = i & 31;
        const float inv = powf(10000.0f, -(float)f / 32.0f); const float ang = (float)pos * inv; float sv, cv; sincosf(ang, &sv, &cv);
        TAB[pos * 64 + f] = cv; TAB[pos * 64 + 32 + f] = sv; } }
    if (gw < 2) { const float* lq = A.in[10] + gw * 256; const float a = wave_sum(lq[lane] * lq[64 + lane]), b = wave_sum(lq[128 + lane] * lq[192 + lane]);
        const float lam_init = 0.8f - 0.6f * expf(-0.3f * (float)gw);
        if (lane == 0) ((float*)(ws + WS_LAM))[gw] = expf(a) - expf(b) + lam_init; }
}

__device__ __forceinline__ int crow(int r, int hi) { return (r & 3) + 8 * (r >> 2) + 4 * hi; }
__device__ __forceinline__ void sample_attn_unit(const Frame& F, const Args& A, int l, int bh, int split, LAS unsigned char* lds) {
    int lane_l = F.lane; asm volatile("" : "+v"(lane_l)); const int b = bh >> 2, h = bh & 3, lane = lane_l, wid = F.wave, r32 = lane & 31, hi = lane >> 5;
    LAS unsigned short* PL = (LAS unsigned short*)lds;
    LAS float* OX = (LAS float*)(lds + 20480);
    LAS float* MB = (LAS float*)(lds + 40960);
    LAS float* LB = MB + 256;
    const bool last = (split == 7), two = last && (wid == 7);
    const int eb = wid & 3, kh = wid >> 2, nks = (last && kh == 1) ? 10 : 8;
    const size_t cro = ((size_t)(l * 8 + b) * 2048 + split * 256) * 512 + h * 128, nro = ((size_t)(l * 8 + b) * 32) * 512 + h * 128;
    const float* Kc = A.in[2] + cro; const float* Vc = A.in[3] + cro;
    const float* Kn = A.out + O_KS + nro; const float* Vn = A.out + O_VS + nro;
    const bf16* Qrow = (const bf16*)(A.ws + WS_Q) + (size_t)(MP + b * 32 + r32) * 512 + h * 128;
    bf16x8 vfr[10];
    { float t[10][8];
#pragma unroll
      for (int ks = 0; ks < 10; ++ks)
#pragma unroll
        for (int j = 0; j < 8; ++j) { const float* vp = (ks < 8) ? Vc + (size_t)(128 * kh + 16 * ks + 8 * hi + j) * 512 : Vn + (size_t)(16 * (ks - 8) + 8 * hi + j) * 512;
            t[ks][j] = (ks < nks) ? __builtin_nontemporal_load(vp + 32 * eb + r32) : 0.f; }
      __builtin_amdgcn_sched_barrier(0);
#pragma unroll
      for (int ks = 0; ks < 10; ++ks) { v4u w; w.x = pk2(t[ks][0], t[ks][1]); w.y = pk2(t[ks][2], t[ks][3]); w.z = pk2(t[ks][4], t[ks][5]); w.w = pk2(t[ks][6], t[ks][7]); vfr[ks] = __builtin_bit_cast(bf16x8, w); }
      __builtin_amdgcn_sched_barrier(0); }
    float* SPO = (float*)(A.ws + WS_SPO); float* SPM = (float*)(A.ws + WS_SPM);
    for (int c = 0; c < 2; ++c) {
        f32x16 s[2]; s[0] = f32x16{}; s[1] = f32x16{};
        bf16x8 qf[4];
        { v2u q0[4], q1[4]; f32x4 ka[2][4], kb[2][4];
#pragma unroll
          for (int d0 = 0; d0 < 4; ++d0) { const bf16* qp = Qrow + c * 64 + 32 * (d0 & 1) + 16 * hi + 4 * (d0 >> 1); q0[d0] = *(const v2u*)qp; q1[d0] = *(const v2u*)(qp + 8);
              const float* kp = Kc + (size_t)(32 * wid + r32) * 512 + c * 64 + 16 * d0 + 8 * hi; ka[0][d0] = __builtin_nontemporal_load((const f32x4*)kp); kb[0][d0] = __builtin_nontemporal_load((const f32x4*)(kp + 4));
              const float* kn = Kn + (size_t)r32 * 512 + c * 64 + 16 * d0 + 8 * hi;
              ka[1][d0] = two ? *(const f32x4*)kn : (f32x4){0.f, 0.f, 0.f, 0.f}; kb[1][d0] = two ? *(const f32x4*)(kn + 4) : (f32x4){0.f, 0.f, 0.f, 0.f}; }
          __builtin_amdgcn_sched_barrier(0);
#pragma unroll
          for (int d0 = 0; d0 < 4; ++d0) { v4u qw; qw.x = q0[d0].x; qw.y = q0[d0].y; qw.z = q1[d0].x; qw.w = q1[d0].y; qf[d0] = __builtin_bit_cast(bf16x8, qw); }
#pragma unroll
          for (int ch = 0; ch < 2; ++ch) if (ch == 0 || two) {
#pragma unroll
              for (int d0 = 0; d0 < 4; ++d0) { v4u kw; kw.x = pk2(ka[ch][d0].x, ka[ch][d0].y); kw.y = pk2(ka[ch][d0].z, ka[ch][d0].w); kw.z = pk2(kb[ch][d0].x, kb[ch][d0].y); kw.w = pk2(kb[ch][d0].z, kb[ch][d0].w);
                  s[ch] = __builtin_amdgcn_mfma_f32_32x32x16_bf16(__builtin_bit_cast(bf16x8, kw), qf[d0], s[ch], 0, 0, 0); } } }
        float m = s[0][0];
#pragma unroll
        for (int r = 1; r < 16; ++r) m = fmaxf(m, s[0][r]);
        if (two) {
#pragma unroll
            for (int r = 0; r < 16; ++r) m = fmaxf(m, s[1][r]); }
        m = fmaxf(m, __shfl_xor(m, 32));
        if (hi == 0) MB[wid * 32 + r32] = m;
        __syncthreads();
        float M = MB[r32];
#pragma unroll
        for (int w = 1; w < 8; ++w) M = fmaxf(M, MB[w * 32 + r32]);
        float lsum = 0.f;
#pragma unroll
        for (int ch = 0; ch < 2; ++ch) if (ch == 0 || two) {
#pragma unroll
            for (int r = 0; r < 16; ++r) { s[ch][r] = __builtin_amdgcn_exp2f(s[ch][r] - M); lsum += s[ch][r]; }
            const int kbase = (ch == 0) ? 32 * wid : 256;
#pragma unroll
            for (int t = 0; t < 4; ++t) { v2u w; w.x = pk2(s[ch][4 * t], s[ch][4 * t + 1]); w.y = pk2(s[ch][4 * t + 2], s[ch][4 * t + 3]);
                *(LAS v2u*)(PL + r32 * 296 + kbase + 8 * t + 4 * hi) = w; } }
        lsum += __shfl_xor(lsum, 32);
        if (hi == 0) LB[wid * 32 + r32] = lsum;
        __syncthreads();
        f32x16 o = {};
#pragma unroll
        for (int ks = 0; ks < 10; ++ks) if (ks < nks) {
            const int key0 = (ks < 8) ? 128 * kh + 16 * ks : 256 + 16 * (ks - 8);
            const bf16x8 pf = *(const LAS bf16x8*)(PL + r32 * 296 + key0 + 8 * hi);
            o = __builtin_amdgcn_mfma_f32_32x32x16_bf16(vfr[ks], pf, o, 0, 0, 0); }
        if (kh == 1) {
#pragma unroll
            for (int r = 0; r < 16; ++r) OX[eb * 1024 + r * 64 + lane] = o[r]; }
        __syncthreads();
        if (kh == 0) { const size_t pi = ((size_t)(bh * 8 + split) * 2 + c) * 32 + r32;
#pragma unroll
            for (int t = 0; t < 4; ++t) { f32x4 v; v.x = o[4 * t] + OX[eb * 1024 + (4 * t) * 64 + lane]; v.y = o[4 * t + 1] + OX[eb * 1024 + (4 * t + 1) * 64 + lane];
                v.z = o[4 * t + 2] + OX[eb * 1024 + (4 * t + 2) * 64 + lane]; v.w = o[4 * t + 3] + OX[eb * 1024 + (4 * t + 3) * 64 + lane];
                *(f32x4*)(SPO + pi * 128 + 32 * eb + 8 * t + 4 * hi) = v; }
            if (wid == 0 && hi == 0) { float Lq = LB[r32];
#pragma unroll
                for (int w = 1; w < 8; ++w) Lq += LB[w * 32 + r32];
                SPM[pi * 2] = M; SPM[pi * 2 + 1] = Lq; } }
    }
    __syncthreads();
}

template <int NB> __device__ __forceinline__ void sample_gemm_res(const Frame& F, const bf16* Arows, int lda, const bf16* Bt, int K, bf16* XBs, float* SS, LAS unsigned char* lds) {
    int lane_l = F.lane; asm volatile("" : "+v"(lane_l));
    const int lane = lane_l, ks = F.wave, r32 = lane & 31, hi = lane >> 5, rt = F.vcu >> 5, ct = F.vcu & 31;
    const int Kw = K >> 3, nst = Kw >> 4;
    const bf16* ap = Arows + (size_t)(32 * rt + r32) * lda + ks * Kw + 8 * hi;
    const bf16* bp = Bt + (size_t)(32 * ct + r32) * K + ks * Kw + 8 * hi;
    f32x16 acc = {};
#pragma unroll 1
    for (int s0 = 0; s0 < nst; s0 += NB) {
        bf16x8 a[NB], b[NB];
#pragma unroll
        for (int i = 0; i < NB; ++i) { a[i] = *(const bf16x8*)(ap + 16 * (s0 + i)); b[i] = *(const bf16x8*)(bp + 16 * (s0 + i)); }
        __builtin_amdgcn_sched_barrier(0);
#pragma unroll
        for (int i = 0; i < NB; ++i) acc = __builtin_amdgcn_mfma_f32_32x32x16_bf16(a[i], b[i], acc, 0, 0, 0);
        __builtin_amdgcn_sched_barrier(0);
    }
    LAS float* RED = (LAS float*)lds;
    LAS float* SSQ = (LAS float*)(lds + 32768);
    if (ks > 0) {
#pragma unroll
        for (int r = 0; r < 16; ++r) RED[(ks - 1) * 1024 + r * 64 + lane] = acc[r]; }
    __syncthreads();
    if (ks == 0) {
        float v[16]; unsigned xo[16];
#pragma unroll
        for (int r = 0; r < 16; ++r) { float t = acc[r];
#pragma unroll
            for (int w = 0; w < 7; ++w) t += RED[w * 1024 + r * 64 + lane];
            v[r] = t; xo[r] = (unsigned)XBs[(unsigned)(32 * rt + crow(r, hi)) * 1024 + 32 * ct + r32]; }
        __builtin_amdgcn_sched_barrier(0);
#pragma unroll
        for (int r = 0; r < 16; ++r) { const float x = v[r] + bflo(xo[r]);
            XBs[(unsigned)(32 * rt + crow(r, hi)) * 1024 + 32 * ct + r32] = (bf16)f2bf(x);
            SSQ[crow(r, hi) * 33 + r32] = x * x; }
    }
    __syncthreads();
    if (ks == 0 && lane < 32) { float s = 0.f;
#pragma unroll
        for (int c2 = 0; c2 < 32; ++c2) s += SSQ[lane * 33 + c2];
        SS[(size_t)16 * MT + ct * 256 + 32 * rt + lane] = s; }
    __syncthreads();
}

__device__ __forceinline__ void conv_item_fast(const Args& A, int l, int item, int lane) {
    const int row0 = item * 8; const bool smp = row0 >= MP;
    const int b = smp ? (row0 - MP) >> 5 : row0 >> 11, t0 = smp ? (row0 - MP) & 31 : row0 & 2047, L = smp ? 32 : 2048;
    const bf16* UC = (const bf16*)(A.ws + WS_UC) + (size_t)(row0 - t0) * 256 + 4 * lane;
    const float* dw = A.in[12] + (size_t)l * 31 * 256 + 4 * lane;
    v2u P[38];
#pragma unroll
    for (int s = 0; s < 38; ++s) { const int tt = t0 - 30 + s; P[s] = (v2u){0u, 0u}; if (tt >= 0) P[s] = *(const v2u*)(UC + (size_t)tt * 256); }
    f32x4 acc[8];
#pragma unroll
    for (int i = 0; i < 8; ++i) acc[i] = (f32x4){0.f, 0.f, 0.f, 0.f};
    f32x4 R[8];
#pragma unroll
    for (int i = 0; i < 7; ++i) { const v2u w = P[i]; R[i] = (f32x4){bflo(w.x), bfhi(w.x), bflo(w.y), bfhi(w.y)}; }
#pragma unroll
    for (int j = 0; j < 31; ++j) { const f32x4 wv = *(const f32x4*)(dw + j * 256);
        { const v2u w = P[7 + j]; R[7] = (f32x4){bflo(w.x), bfhi(w.x), bflo(w.y), bfhi(w.y)}; }
#pragma unroll
        for (int i = 0; i < 8; ++i) acc[i] += wv * R[i];
#pragma unroll
        for (int i = 0; i < 7; ++i) R[i] = R[i + 1];
        __builtin_amdgcn_sched_barrier(0); }
    if (t0 + 7 >= L - 30) { float* cout = A.out + (smp ? O_CS : O_CP) + ((size_t)(l * 8 + b) * 30) * 256 + 4 * lane;
#pragma unroll
        for (int i = 0; i < 8; ++i) { const int tq = t0 + i; const v2u w = P[30 + i]; if (tq >= L - 30) *(f32x4*)(cout + (size_t)(tq - (L - 30)) * 256) = (f32x4){bflo(w.x), bfhi(w.x), bflo(w.y), bfhi(w.y)}; } }
    const f32x4 bias = *(const f32x4*)(A.in[13] + l * 256 + 4 * lane), lg = *(const f32x4*)(A.in[14] + l * 256 + 4 * lane), lb = *(const f32x4*)(A.in[15] + l * 256 + 4 * lane);
    bf16* MIX = (bf16*)(A.ws + WS_MIX) + (size_t)row0 * 1024 + 768 + 4 * lane;
#pragma unroll
    for (int i = 0; i < 8; ++i) { f32x4 y = acc[i] + bias;
        const float mu = wave_sum((y.x + y.y) + (y.z + y.w)) * (1.0f / 256.0f); y = y - mu;
        const float var = wave_sum((y.x * y.x + y.y * y.y) + (y.z * y.z + y.w * y.w)) * (1.0f / 256.0f);
        const float rs = rsqrtf(var + 1e-6f); y = y * rs * lg + lb; y = y * pg8::sigm4(y);
        v2u o; o.x = pk2(y.x, y.y); o.y = pk2(y.z, y.w); *(v2u*)(MIX + (size_t)i * 1024) = o; }
}
__device__ __forceinline__ void conv_item(const Args& A, int l, int item, int lane) {
    const int row0 = item * 8; const bool smp = row0 >= MP;
    const int b = smp ? (row0 - MP) >> 5 : row0 >> 11, t0 = smp ? (row0 - MP) & 31 : row0 & 2047, L = smp ? 32 : 2048;
    const bf16* UC = (const bf16*)(A.ws + WS_UC) + (size_t)(row0 - t0) * 256 + 4 * lane;
    const float* hist = A.in[5] + ((size_t)(l * 8 + b) * 30) * 256 + 4 * lane;
    const float* dw = A.in[12] + (size_t)l * 31 * 256 + 4 * lane;
    f32x4 acc[8], R[8];
#pragma unroll
    for (int i = 0; i < 8; ++i) acc[i] = (f32x4){0.f, 0.f, 0.f, 0.f};
    float* cout = A.out + (smp ? O_CS : O_CP) + ((size_t)(l * 8 + b) * 30) * 256 + 4 * lane;
#define CONV_ROW(dst, tt_) do { const int tt = (tt_); const int ttc = tt < 0 ? 0 : tt; \
        const v2u w_ = *(const v2u*)(UC + (size_t)ttc * 256); f32x4 rv_ = (f32x4){bflo(w_.x), bfhi(w_.x), bflo(w_.y), bfhi(w_.y)}; \
        if (tt < 0) rv_ = (f32x4){0.f, 0.f, 0.f, 0.f}; dst = rv_; } while (0)
#define CONV_HIST(dst, tt_) do { const int tt = (tt_); int hr = 30 + tt; hr = hr < 0 ? 0 : (hr > 29 ? 29 : hr); const f32x4 hv_ = *(const f32x4*)(hist + (size_t)hr * 256); if (tt < 0) dst = hv_; } while (0)
#pragma unroll
    for (int i = 0; i < 7; ++i) CONV_ROW(R[i], t0 - 30 + i);
    if (smp) {
#pragma unroll
        for (int i = 0; i < 7; ++i) CONV_HIST(R[i], t0 - 30 + i); }
#pragma unroll 1
    for (int jb = 0; jb < 32; jb += 8) {
        f32x4 N[8], Wt[8];
#pragma unroll
        for (int jj = 0; jj < 8; ++jj) { const int j = jb + jj; int tt2 = t0 - 23 + j; if (tt2 > L - 1) tt2 = L - 1; CONV_ROW(N[jj], tt2);
            const int jc = j < 31 ? j : 30; Wt[jj] = *(const f32x4*)(dw + jc * 256); if (j >= 31) Wt[jj] = (f32x4){0.f, 0.f, 0.f, 0.f}; }
        if (smp && t0 - 23 + jb < 0) {
#pragma unroll
            for (int jj = 0; jj < 8; ++jj) CONV_HIST(N[jj], t0 - 23 + jb + jj); }
        __builtin_amdgcn_sched_barrier(0);
#pragma unroll
        for (int jj = 0; jj < 8; ++jj) { const int j = jb + jj; R[7] = N[jj];
            if (j >= 23 && j < 31) { const int tq = t0 + (j - 23); if (tq >= L - 30) *(f32x4*)(cout + (size_t)(tq - (L - 30)) * 256) = R[7]; }
#pragma unroll
            for (int i = 0; i < 8; ++i) acc[i] += Wt[jj] * R[i];
#pragma unroll
            for (int i = 0; i < 7; ++i) R[i] = R[i + 1]; }
    }
#undef CONV_HIST
#undef CONV_ROW
    const f32x4 bias = *(const f32x4*)(A.in[13] + l * 256 + 4 * lane), lg = *(const f32x4*)(A.in[14] + l * 256 + 4 * lane), lb = *(const f32x4*)(A.in[15] + l * 256 + 4 * lane);
    bf16* MIX = (bf16*)(A.ws + WS_MIX) + (size_t)row0 * 1024 + 768 + 4 * lane;
#pragma unroll
    for (int i = 0; i < 8; ++i) { f32x4 y = acc[i] + bias;
        const float mu = wave_sum((y.x + y.y) + (y.z + y.w)) * (1.0f / 256.0f); y = y - mu;
        const float var = wave_sum((y.x * y.x + y.y * y.y) + (y.z * y.z + y.w * y.w)) * (1.0f / 256.0f);
        const float rs = rsqrtf(var + 1e-6f); y = y * rs * lg + lb; y = y * pg8::sigm4(y);
        v2u o; o.x = pk2(y.x, y.y); o.y = pk2(y.z, y.w); *(v2u*)(MIX + (size_t)i * 1024) = o; }
}
__device__ __forceinline__ void pool_item(const Args& A, int l, int item, int lane) {
    const int row = item * 2 + (lane >> 5), c0 = (lane & 31) * 8, g = c0 >> 6, w = 2 << g;
    const bool smp = row >= MP; const int b = smp ? (row - MP) >> 5 : row >> 11, t = smp ? (row - MP) & 31 : row & 2047, L = smp ? 32 : 2048;
    const bf16* UP = (const bf16*)(A.ws + WS_UP) + (size_t)(row - t) * 256 + c0;
    const float* hist = A.in[4] + ((size_t)(l * 8 + b) * 15) * 256 + c0;
    float sum[8], own[8];
    v4u pv[16];
#pragma unroll
    for (int jj = 0; jj < 16; ++jj) { const int tt = t - jj; pv[jj] = (v4u){0u, 0u, 0u, 0u}; if (jj < w && tt >= 0) pv[jj] = *(const v4u*)(UP + (size_t)tt * 256); }
    __builtin_amdgcn_sched_barrier(0);
#pragma unroll
    for (int i = 0; i < 8; ++i) sum[i] = 0.f;
#pragma unroll
    for (int jj = 0; jj < 16; ++jj) { const v4u v = pv[jj];
        const float fv[8] = {bflo(v.x), bfhi(v.x), bflo(v.y), bfhi(v.y), bflo(v.z), bfhi(v.z), bflo(v.w), bfhi(v.w)};
#pragma unroll
        for (int i = 0; i < 8; ++i) { sum[i] += fv[i]; if (jj == 0) own[i] = fv[i]; } }
    if (smp && t < w - 1) { for (int jj = t + 1; jj < w; ++jj) { const int tt = t - jj;
            const f32x4 a = *(const f32x4*)(hist + (size_t)(15 + tt) * 256), bq = *(const f32x4*)(hist + (size_t)(15 + tt) * 256 + 4);
            sum[0] += a.x; sum[1] += a.y; sum[2] += a.z; sum[3] += a.w; sum[4] += bq.x; sum[5] += bq.y; sum[6] += bq.z; sum[7] += bq.w; } }
    const int cnt = smp ? w : ((t + 1 < w) ? t + 1 : w); const float ic = 1.0f / (float)cnt;
    v4u o; o.x = pk2(sum[0] * ic - own[0], sum[1] * ic - own[1]); o.y = pk2(sum[2] * ic - own[2], sum[3] * ic - own[3]);
    o.z = pk2(sum[4] * ic - own[4], sum[5] * ic - own[5]); o.w = pk2(sum[6] * ic - own[6], sum[7] * ic - own[7]);
    *(v4u*)((bf16*)(A.ws + WS_MIX) + (size_t)row * 1024 + c0) = o;
    if (t >= L - 15) { float* po = A.out + (smp ? O_PS : O_PP) + ((size_t)(l * 8 + b) * 15 + (t - (L - 15))) * 256 + c0;
        *(f32x4*)po = (f32x4){own[0], own[1], own[2], own[3]}; *(f32x4*)(po + 4) = (f32x4){own[4], own[5], own[6], own[7]}; }
}
__device__ __forceinline__ void post_item(const Args& A, int l, int row0, int lane, float lam, float osc) {
    const int h = lane >> 4, e = (lane & 15) * 8;
    const bf16* O4 = (const bf16*)(A.ws + WS_O4) + (size_t)row0 * 1024 + h * 256 + e;
    v4u a[4], bq[4];
#pragma unroll
    for (int i = 0; i < 4; ++i) { a[i] = *(const v4u*)(O4 + (size_t)i * 1024); bq[i] = *(const v4u*)(O4 + (size_t)i * 1024 + 128); }
    __builtin_amdgcn_sched_barrier(0);
    const f32x4 g0 = *(const f32x4*)(A.in[11] + l * 128 + e), g1 = *(const f32x4*)(A.in[11] + l * 128 + e + 4);
#pragma unroll
    for (int i = 0; i < 4; ++i) {
        float o[8] = {bflo(a[i].x) - lam * bflo(bq[i].x), bfhi(a[i].x) - lam * bfhi(bq[i].x), bflo(a[i].y) - lam * bflo(bq[i].y), bfhi(a[i].y) - lam * bfhi(bq[i].y),
                      bflo(a[i].z) - lam * bflo(bq[i].z), bfhi(a[i].z) - lam * bfhi(bq[i].z), bflo(a[i].w) - lam * bflo(bq[i].w), bfhi(a[i].w) - lam * bfhi(bq[i].w)};
        float ss = 0.f;
#pragma unroll
        for (int k = 0; k < 8; ++k) ss += o[k] * o[k];
        ss += __shfl_xor(ss, 1); ss += __shfl_xor(ss, 2); ss += __shfl_xor(ss, 4); ss += __shfl_xor(ss, 8);
        const float rs = rsqrtf(ss * (1.0f / 128.0f) + 1e-6f) * osc;
        v4u w; w.x = pk2(o[0] * rs * g0.x, o[1] * rs * g0.y); w.y = pk2(o[2] * rs * g0.z, o[3] * rs * g0.w); w.z = pk2(o[4] * rs * g1.x, o[5] * rs * g1.y); w.w = pk2(o[6] * rs * g1.z, o[7] * rs * g1.w);
        *(v4u*)((bf16*)(A.ws + WS_MIX) + (size_t)(row0 + i) * 1024 + 256 + h * 128 + e) = w; }
}
__device__ __forceinline__ void scomb_item(const Args& A, int l, int item, int lane, float lam, float osc) {
    const int rs_ = item >> 2, h = item & 3, b = rs_ >> 5, q = rs_ & 31, bh = b * 4 + h;
    const float* SPO = (const float*)(A.ws + WS_SPO); const float* SPM = (const float*)(A.ws + WS_SPM);
    float oc[2][2];
#pragma unroll
    for (int c = 0; c < 2; ++c) {
        typedef float f32x2t __attribute__((ext_vector_type(2)));
        f32x2t ml[8], ov[8];
#pragma unroll
        for (int s = 0; s < 8; ++s) { const size_t pi = ((size_t)(bh * 8 + s) * 2 + c) * 32 + q; ml[s] = *(const f32x2t*)(SPM + pi * 2); ov[s] = *(const f32x2t*)(SPO + pi * 128 + 2 * lane); }
        __builtin_amdgcn_sched_barrier(0);
        float M = ml[0].x;
#pragma unroll
        for (int s = 1; s < 8; ++s) M = fmaxf(M, ml[s].x);
        float Ls = 0.f, o0 = 0.f, o1 = 0.f;
#pragma unroll
        for (int s = 0; s < 8; ++s) { const float wgt = __builtin_amdgcn_exp2f(ml[s].x - M); Ls += wgt * ml[s].y; o0 += wgt * ov[s].x; o1 += wgt * ov[s].y; }
        const float il = 1.0f / Ls; oc[c][0] = o0 * il; oc[c][1] = o1 * il; }
    const float x0 = oc[0][0] - lam * oc[1][0], x1 = oc[0][1] - lam * oc[1][1];
    const float ss = wave_sum(x0 * x0 + x1 * x1); const float rs = rsqrtf(ss * (1.0f / 128.0f) + 1e-6f) * osc;
    const float* g = A.in[11] + l * 128 + 2 * lane;
    *(unsigned*)((bf16*)(A.ws + WS_MIX) + (size_t)(MP + rs_) * 1024 + 256 + h * 128 + 2 * lane) = pk2(x0 * rs * g[0], x1 * rs * g[1]);
}

__global__ void __launch_bounds__(NWAVES * 64, 2) mk_fwd(Args args) {
    extern __shared__ __attribute__((aligned(16))) unsigned char lds_raw[];
    LAS unsigned char* lds = (LAS unsigned char*)lds_raw;
    Frame F; F.tid = threadIdx.x; F.lane = F.tid & 63; F.wave = __builtin_amdgcn_readfirstlane(F.tid >> 6);
    F.G = gridDim.x; { const int bx = blockIdx.x; F.vcu = (F.G % 8 == 0) ? (bx % 8) * (F.G / 8) + bx / 8 : bx; }
    F.gw = F.vcu * NWAVES + F.wave; F.NGW = F.G * NWAVES;
    unsigned char* ws = args.ws;
    const int lo = args.ph_lo, hi = args.ph_hi;
#define IN(k) (lo <= (k) && (k) < hi)
#define SEAM(k) do { if (IN(k) && IN((k) + 1)) { xcd_barrier(bar); } } while (0)
    for (int u = F.tid; u < 64; u += NWAVES * 64) ((LAS unsigned*)(lds + MISC_OFF))[u] = 0u;
    __syncthreads();
    XcdBarrier bar; bar.bar = (unsigned*)ws; bar.x = 0; bar.st = nullptr;
    if (!MK_MULTI) bar = xcd_barrier_post((unsigned*)ws, (volatile LAS unsigned*)(lds + MISC_OFF) + 8);
    #ifndef REP_PRO
#define REP_PRO 1
#endif
#ifndef REP_INP
#define REP_INP 1
#endif
#ifndef REP_ATT
#define REP_ATT 1
#endif
#ifndef REP_MIX
#define REP_MIX 1
#endif
#ifndef REP_GU
#define REP_GU 1
#endif
    if (!MK_MULTI && lo < 0) cg::this_grid().sync();
    if (IN(0)) { for (int rep = 0; rep < REP_PRO; ++rep) { p0_prologue(F, args, lds); __syncthreads(); } }
    SEAM(0);
    for (int rep = 0; rep < REP_SYNC; ++rep) xcd_barrier(bar);
    float* X = args.out + O_Y;
    bf16* XB = (bf16*)(ws + WS_XB); float* SS = (float*)(ws + WS_SS);
#pragma unroll 1
    for (int l = 0; l < 2; ++l) {
        const int pb = 1 + 6 * l;
        if (IN(pb)) for (int rep = 0; rep < REP_INP; ++rep) {
            pg8::Gemm g{XB, (const bf16*)(ws + WS_WIN) + (size_t)l * INW * 1024, MT, INW, 1024}; pg8::StaticOrder S; S.init(MT, INW, F.G, (int)blockIdx.x);
            pg8::EpiInProj E{SS, (const float*)(ws + WS_TAB), (bf16*)(ws + WS_UP), (bf16*)(ws + WS_Q), (bf16*)(ws + WS_K), (bf16*)(ws + WS_V), (bf16*)(ws + WS_UC),
                args.out + O_KP + (size_t)l * 8 * 2048 * 512, args.out + O_KS + (size_t)l * 8 * 32 * 512, args.out + O_VP + (size_t)l * 8 * 2048 * 512, args.out + O_VS + (size_t)l * 8 * 32 * 512};
            pg8::gemm_phase<pg8::EpiInProj, pg8::StaticOrder, PG8_ALIGN, PG8_SP2>(lds, g, S, E);
            if (SLACK_W && rep == 0) { if (l == 0) slack_weights(F, args, lds, (MT / 256) * (INW / 256), WI_A, WI_B); else slack_weights(F, args, lds, (MT / 256) * (INW / 256), WI_C, WI_END); }
        }
        SEAM(pb);
        if (IN(pb + 1)) for (int rep = 0; rep < REP_ATT; ++rep) {
            const int bh = F.vcu >> 3, jj = F.vcu & 7, a = jj & 3, c = jj >> 2, b = bh >> 2, h = bh & 3;
            const attn_body::bf16* Qp = (const attn_body::bf16*)(ws + WS_Q); const attn_body::bf16* Kp = (const attn_body::bf16*)(ws + WS_K); const attn_body::bf16* Vp = (const attn_body::bf16*)(ws + WS_V);
            attn_body::bf16* Op = (attn_body::bf16*)(ws + WS_O4);
            const int spos = F.vcu % 5;
#pragma unroll 1
            for (int i = 0; i < 5; ++i) {
                if (i == spos) { sample_attn_unit(F, args, l, F.vcu >> 3, F.vcu & 7, lds); }
                else { const int k = i - (i > spos ? 1 : 0); const int vh = k >> 1, qb = (k & 1) ? 7 - a : a;
                    attn_body::attn_unit<8>(b, 2 * h + c, 2 * h + vh, qb, Qp, Kp, Vp, Op, h * 256 + c * 128 + vh * 64, (char*)lds_raw); __syncthreads(); }
            }
        }
        SEAM(pb + 1);
        if (IN(pb + 2)) for (int rep = 0; rep < REP_MIX; ++rep) {
            int mlane = F.lane; asm volatile("" : "+v"(mlane));
            const float lam = ((const float*)(ws + WS_LAM))[l]; const float osc = 1.0f - (0.8f - 0.6f * expf(-0.3f * (float)l));
            const bool heavy = (F.NGW == 2048) && ((F.gw & 63) == 0);
            const int lgw = (F.NGW == 2048) ? F.gw - ((F.gw + 63) >> 6) : F.gw, lng = (F.NGW == 2048) ? 2016 : F.NGW;
#pragma unroll 1
            for (int k = 0; k < 2; ++k) { if (k == 1 && !heavy) break; conv_item(args, l, k == 0 ? F.gw : MP / 8 + (F.gw >> 6), mlane); }
            if (!heavy) {
            for (int it = lgw; it < MT / 2; it += lng) pool_item(args, l, it, mlane);
            for (int it = lgw; it < MP / 4; it += lng) post_item(args, l, it * 4, mlane, lam, osc);
            for (int it = lgw; it < 1024; it += lng) scomb_item(args, l, it, mlane, lam, osc);
            }
        }
        SEAM(pb + 2);
#ifndef REP_OUT0
#define REP_OUT0 1
#endif
#ifndef REP_SYNC
#define REP_SYNC 0
#endif
#ifndef REP_FOLD
#define REP_FOLD 1
#endif
#ifndef REP_SLACK
#define REP_SLACK 1
#endif
#ifndef SLACK_W
#define SLACK_W 1
#endif
        if (IN(pb + 3)) for (int rep = 0; rep < (l == 0 ? REP_OUT0 : 1); ++rep) {
            pg8::Gemm g{(const bf16*)(ws + WS_MIX), (const bf16*)(ws + WS_WOUT) + (size_t)l * 1024 * 1024, MP, 1024, 1024}; pg8::StaticOrder S; S.init(MP, 1024, F.G, (int)blockIdx.x);
            pg8::EpiRes E{XB, SS, 0};
            pg8::gemm_phase<pg8::EpiRes, pg8::StaticOrder, PG8_ALIGN, PG8_SP2>(lds, g, S, E);
            sample_gemm_res<8>(F, (const bf16*)(ws + WS_MIX) + (size_t)MP * 1024, 1024, (const bf16*)(ws + WS_WOUT) + (size_t)l * 1024 * 1024, 1024, XB + (size_t)MP * 1024, SS, lds);
        }
        SEAM(pb + 3);
        if (IN(pb + 4)) for (int rep = 0; rep < REP_GU; ++rep) {
            pg8::Gemm g{XB, (const bf16*)(ws + WS_WGU) + (size_t)l * 2 * DFF * 1024, MT, 2 * DFF, 1024}; pg8::StaticOrder S; S.init(MT, 2 * DFF, F.G, (int)blockIdx.x);
            pg8::EpiSwiGLU E{(bf16*)(ws + WS_H), SS};
            pg8::gemm_phase<pg8::EpiSwiGLU, pg8::StaticOrder, PG8_ALIGN, PG8_SP2>(lds, g, S, E);
            if (SLACK_W && rep == 0 && l == 0) slack_weights(F, args, lds, (MT / 256) * (2 * DFF / 256), WI_B, WI_C);
        }
        SEAM(pb + 4);
#ifndef REP_DN
#define REP_DN 1
#endif
        if (IN(pb + 5)) for (int rep = 0; rep < REP_DN; ++rep) {
            pg8::Gemm g{(const bf16*)(ws + WS_H), (const bf16*)(ws + WS_WDN) + (size_t)l * 1024 * DFF, MP, 1024, DFF}; pg8::StaticOrder S; S.init(MP, 1024, F.G, (int)blockIdx.x);
            pg8::EpiRes E{XB, SS, rep < REP_DN - 1};
            pg8::gemm_phase<pg8::EpiRes, pg8::StaticOrder, PG8_ALIGN, PG8_SP2>(lds, g, S, E);
            if (rep == REP_DN - 1) sample_gemm_res<11>(F, (const bf16*)(ws + WS_H) + (size_t)MP * DFF, DFF, (const bf16*)(ws + WS_WDN) + (size_t)l * 1024 * DFF, DFF, XB + (size_t)MP * 1024, SS, lds);
        }
        SEAM(pb + 5);
    }
#ifndef REP_FIN
#define REP_FIN 1
#endif
    if (IN(13)) for (int rep = 0; rep < REP_FIN; ++rep) {
        const float* gf = args.in[21]; int flane = F.lane; asm volatile("" : "+v"(flane));
        for (int m0 = F.gw * 2; m0 < MT; m0 += F.NGW * 2) {
            v4u w[2][2];
#pragma unroll
            for (int q = 0; q < 2; ++q)
#pragma unroll
                for (int j = 0; j < 2; ++j) w[q][j] = *((const v4u*)(XB + (size_t)(m0 + q) * 1024) + flane + 64 * j);
            __builtin_amdgcn_sched_barrier(0);
#pragma unroll
            for (int q = 0; q < 2; ++q) { float v[2][8]; float s = 0.f;
#pragma unroll
                for (int j = 0; j < 2; ++j) { const v4u ww = w[q][j]; v[j][0] = bflo(ww.x); v[j][1] = bfhi(ww.x); v[j][2] = bflo(ww.y); v[j][3] = bfhi(ww.y); v[j][4] = bflo(ww.z); v[j][5] = bfhi(ww.z); v[j][6] = bflo(ww.w); v[j][7] = bfhi(ww.w);
#pragma unroll
                    for (int k = 0; k < 8; ++k) s += v[j][k] * v[j][k]; }
                const float r = rsqrtf(wave_sum(s) * (1.0f / 1024.0f) + 1e-6f);
#pragma unroll
                for (int j = 0; j < 2; ++j) { const f32x4 g0 = *((const f32x4*)gf + 2 * (flane + 64 * j)), g1 = *((const f32x4*)gf + 2 * (flane + 64 * j) + 1);
                    f32x4* yo = (f32x4*)(X + (size_t)(m0 + q) * 1024) + 2 * (flane + 64 * j);
                    yo[0] = (f32x4){v[j][0] * r * g0.x, v[j][1] * r * g0.y, v[j][2] * r * g0.z, v[j][3] * r * g0.w};
                    yo[1] = (f32x4){v[j][4] * r * g1.x, v[j][5] * r * g1.y, v[j][6] * r * g1.z, v[j][7] * r * g1.w}; } } }
    }
#undef IN
#undef SEAM
}

extern "C" void kernel_launch(void* const* d_in, const int* in_sizes, int n_in, void* d_out, int out_size, void* d_ws, size_t ws_size, hipStream_t stream) {
    static int grid = 0;
    if (grid == 0) {
        if (n_in != 22 || out_size != (int)O_END || ws_size < WS_END) { fprintf(stderr, "kernel_launch: unexpected shapes (n_in %d out %d ws %zu)\n", n_in, out_size, ws_size); grid = -1; return; }
        int dev = 0, cus = 0, per_cu = 0;
        hipGetDevice(&dev); hipDeviceGetAttribute(&cus, hipDeviceAttributeMultiprocessorCount, dev);
        if (hipFuncSetAttribute((const void*)mk_fwd, hipFuncAttributeMaxDynamicSharedMemorySize, LDS_BYTES) != hipSuccess) { fprintf(stderr, "kernel_launch: hipFuncSetAttribute failed\n"); grid = -1; return; }
        hipOccupancyMaxActiveBlocksPerMultiprocessor(&per_cu, (const void*)mk_fwd, NWAVES * 64, LDS_BYTES);
        (void)hipGetLastError();
        if (per_cu < 1) { fprintf(stderr, "kernel_launch: occupancy query says %d blocks per CU\n", per_cu); per_cu = 1; }
        grid = cus;
        if (grid > 256) grid = 256;
    }
    if (grid < 0) return;
    if (hipMemsetAsync(d_ws, 0, 65536, stream) != hipSuccess) { fprintf(stderr, "kernel_launch: memset failed\n"); return; }
    Args a{};
    for (int i = 0; i < 22; ++i) a.in[i] = (const float*)d_in[i];
    a.out = (float*)d_out; a.ws = (unsigned char*)d_ws;
#if MK_MULTI
    for (int p = 0; p < NPH; ++p) { a.ph_lo = p; a.ph_hi = p + 1; hipLaunchKernelGGL(mk_fwd, dim3(grid), dim3(NWAVES * 64), LDS_BYTES, stream, a); }
#else
    a.ph_lo = 0; a.ph_hi = NPH;
    void* kargs[] = {&a};
    hipError_t e = hipLaunchCooperativeKernel((const void*)mk_fwd, dim3(grid), dim3(NWAVES * 64), kargs, LDS_BYTES, stream);
    if (e != hipSuccess) fprintf(stderr, "kernel_launch: cooperative launch failed: %s (grid %d)\n", hipGetErrorString(e), grid);
#endif
}
```

```cpp
#define MK_MULTI 0
#include <hip/hip_runtime.h>
#include <hip/hip_cooperative_groups.h>
#include <cstdio>
#include <cstdint>
namespace cg = cooperative_groups;
namespace pg8 {
#define PG8_LAS __attribute__((address_space(3)))
typedef unsigned short bf16_t;
typedef short bf16x8 __attribute__((ext_vector_type(8)));
typedef float f32x4 __attribute__((ext_vector_type(4)));
typedef unsigned u32x4 __attribute__((ext_vector_type(4)));
constexpr int BM = 256, BK = 64, HALF = 128, HTB = HALF * BK * 2  , STAGE_BYTES = 8 * HTB, NXCD = 8, WGM = 4;

__host__ __device__ __forceinline__ int lds_byte(int r, int c) { const int st = (r >> 4) * 2 + (c >> 5), rr = r & 15, cc = c & 31, ob = rr * 64 + cc * 2; return st * 1024 + (ob ^ (((ob >> 9) & 1) << 5)); }
__host__ __device__ __forceinline__ void stage_rc(int b, int& R, int& C) { const int st = b / 1024, sb = b % 1024, swz = sb ^ (((sb >> 9) & 1) << 5); R = (st >> 1) * 16 + swz / 64; C = (st & 1) * 32 + (swz % 64) / 2; }
__host__ __device__ __forceinline__ int perm32(int rho) { const int n = rho >> 4, i = rho & 15; return 8 * (i >> 2) + 4 * n + (i & 3); }

struct Unit { int pm, pn; };
struct Gemm { const bf16_t* A; const bf16_t* Bt; int M, N, K; };

struct StaticOrder {
    int nM, nN, nwg, G, c;
    __host__ __device__ void init(int M, int N, int G_, int c_) { nM = M / BM; nN = N / BM; nwg = nM * nN; G = G_; c = c_; }
    __host__ __device__ bool next(int i, Unit& u) const {
        const long L = (long)i * G + c; if (L >= nwg) return false;
        int wgid = (int)L; { const int q = nwg / NXCD, r = nwg % NXCD, xcd = wgid % NXCD, off = wgid / NXCD; wgid = (xcd < r ? xcd * (q + 1) : r * (q + 1) + (xcd - r) * q) + off; }
        const int nig = WGM * nN, gid = wgid / nig, fm = gid * WGM, gsz = (nM - fm) < WGM ? (nM - fm) : WGM;
        u.pm = fm + ((wgid % nig) % gsz); u.pn = (wgid % nig) / gsz; return true;
    }
    __device__ __forceinline__ void a_ready(const Unit&) const {}
    __device__ __forceinline__ void done(const Unit&) const {}
};

__device__ __forceinline__ unsigned cvt_pk_bf16(float lo, float hi) { unsigned r; asm volatile("v_cvt_pk_bf16_f32 %0, %1, %2" : "=v"(r) : "v"(lo), "v"(hi)); return r; }
typedef float f32x2 __attribute__((ext_vector_type(2)));
template <class Epi, class Sched, bool ALIGN_EPI = false, bool SP2 = false>
__device__ __forceinline__ void gemm_phase(PG8_LAS unsigned char* lds, const Gemm g, const Sched& S, const Epi& E) {
    int tid_l = threadIdx.x; asm volatile("" : "+v"(tid_l));
    const int tid = tid_l, wid = __builtin_amdgcn_readfirstlane(tid >> 6), lane = tid & 63, wr = wid >> 2, wc = wid & 3, fr = lane & 15, fq = lane >> 4;
    const int K = g.K, nt = K / BK;
    unsigned voffA[2], voffB[2];
#pragma unroll
    for (int i = 0; i < 2; ++i) { int R, C; stage_rc(tid * 16 + i * 8192, R, C); const int Rb = Epi::PERM ? ((R & ~31) + perm32(R & 31)) : R;
        voffA[i] = (unsigned)(R * K + C) * 2u; voffB[i] = (unsigned)(Rb * K + C) * 2u; }
    const size_t kstep = (size_t)(BK * 2);
    const size_t hstep = (size_t)HALF * K * 2;
    const size_t tstep = 2 * hstep;
    const unsigned ldsw = (unsigned)wid * 1024u;
    const int aoff = lds_byte(wr * 64 + fr, fq * 8), boff = lds_byte(wc * 32 + fr, fq * 8);
#define PG8_SA(b, h) (((b) * 2 + (h)) * HTB)
#define PG8_SB(b, h) ((4 + (b) * 2 + (h)) * HTB)
#define PG8_STAGE(bufoff, gbase, voff) do { _Pragma("unroll") for (int _i = 0; _i < 2; ++_i) \
        __builtin_amdgcn_global_load_lds((const unsigned*)((const char*)(gbase) + (voff)[_i]), (PG8_LAS unsigned*)(lds + (bufoff) + ldsw + _i * 8192), 16, 0, 0); } while (0)
#define PG8_LDA(dst, b, h) do { _Pragma("unroll") for (int m = 0; m < 4; ++m) _Pragma("unroll") for (int k = 0; k < 2; ++k) dst[m][k] = *(const PG8_LAS bf16x8*)(lds + PG8_SA(b, h) + aoff + m * 2048 + k * 1024); } while (0)
#define PG8_LDB(dst, b, h) do { _Pragma("unroll") for (int n = 0; n < 2; ++n) _Pragma("unroll") for (int k = 0; k < 2; ++k) dst[n][k] = *(const PG8_LAS bf16x8*)(lds + PG8_SB(b, h) + boff + n * 2048 + k * 1024); } while (0)
#define PG8_MMA(ai, bj, At, Bt) do { __builtin_amdgcn_s_setprio(1); _Pragma("unroll") for (int m = 0; m < 4; ++m) _Pragma("unroll") for (int n = 0; n < 2; ++n) _Pragma("unroll") for (int k = 0; k < 2; ++k) \
        acc[ai][bj][m][n] = __builtin_amdgcn_mfma_f32_16x16x32_bf16(Bt[n][k], At[m][k], acc[ai][bj][m][n], 0, 0, 0); __builtin_amdgcn_s_setprio(0); } while (0)
#define PG8_WAIT_V(n) asm volatile("s_waitcnt vmcnt(" #n ")" ::: "memory")
#define PG8_WAIT_L(n) asm volatile("s_waitcnt lgkmcnt(" #n ")" ::: "memory")
#define PG8_BAR __builtin_amdgcn_s_barrier()
#define PG8_SCHED __builtin_amdgcn_sched_barrier(0)
    Unit cur, nxt; int ui = 0;
    if (!S.next(0, cur)) return;
    f32x4 acc[2][2][4][2];
#pragma unroll
    for (int a = 0; a < 2; ++a)
#pragma unroll
        for (int b = 0; b < 2; ++b)
#pragma unroll
            for (int m = 0; m < 4; ++m)
#pragma unroll
                for (int n = 0; n < 2; ++n) acc[a][b][m][n] = (f32x4){0.f, 0.f, 0.f, 0.f};
    bf16x8 At[4][2], B0[2][2], B1[2][2];
    const char* cA = (const char*)g.A + (size_t)cur.pm * tstep; const char* cB = (const char*)g.Bt + (size_t)cur.pn * tstep;
    S.a_ready(cur);
    if constexpr (SP2) {
        PG8_STAGE(PG8_SB(0, 0), cB, voffB); PG8_STAGE(PG8_SB(0, 1), cB + hstep, voffB); PG8_STAGE(PG8_SA(0, 0), cA, voffA); PG8_STAGE(PG8_SA(0, 1), cA + hstep, voffA);
        if (wr == 1) PG8_BAR;
        PG8_WAIT_V(2); PG8_BAR;
        PG8_STAGE(PG8_SB(1, 0), cB + kstep, voffB); PG8_STAGE(PG8_SA(1, 0), cA + kstep, voffA); PG8_STAGE(PG8_SB(1, 1), cB + hstep + kstep, voffB);
        PG8_WAIT_V(6); PG8_BAR;
    } else {
        PG8_STAGE(PG8_SB(0, 0), cB, voffB); PG8_STAGE(PG8_SA(0, 0), cA, voffA); PG8_STAGE(PG8_SB(0, 1), cB + hstep, voffB); PG8_STAGE(PG8_SA(0, 1), cA + hstep, voffA);
        if (wr == 1) PG8_BAR;
        PG8_WAIT_V(4); PG8_BAR;
        PG8_STAGE(PG8_SB(1, 0), cB + kstep, voffB); PG8_STAGE(PG8_SA(1, 0), cA + kstep, voffA); PG8_STAGE(PG8_SB(1, 1), cB + hstep + kstep, voffB);
        PG8_WAIT_V(6); PG8_BAR;
    }
    for (;;) {
        const bool has_next = S.next(ui + 1, nxt);
        const char* nA = has_next ? (const char*)g.A + (size_t)nxt.pm * tstep : cA; const char* nB = has_next ? (const char*)g.Bt + (size_t)nxt.pn * tstep : cB;
        for (int t = 0; t < nt; t += 2) {
            const bool last = (t == nt - 2);
            const char* a1 = cA + (size_t)(t + 1) * kstep;
            const char* a2 = last ? nA : cA + (size_t)(t + 2) * kstep; const char* b2 = last ? nB : cB + (size_t)(t + 2) * kstep;
            const char* a3 = a2 + kstep; const char* b3 = b2 + kstep;
            if (last && has_next) S.a_ready(nxt);
            if constexpr (SP2) {
            PG8_LDB(B0, 0, 0); PG8_LDB(B1, 0, 1); PG8_SCHED; PG8_LDA(At, 0, 0); PG8_STAGE(PG8_SA(1, 1), a1 + hstep, voffA);
            PG8_WAIT_V(8); PG8_WAIT_L(0); PG8_BAR; PG8_MMA(0, 0, At, B0); PG8_MMA(0, 1, At, B1); PG8_BAR; PG8_SCHED;
            PG8_LDA(At, 0, 1); PG8_STAGE(PG8_SB(0, 0), b2, voffB); PG8_STAGE(PG8_SB(0, 1), b2 + hstep, voffB); PG8_STAGE(PG8_SA(0, 0), a2, voffA);
            PG8_WAIT_V(8); PG8_WAIT_L(0); PG8_BAR; PG8_MMA(1, 0, At, B0); PG8_MMA(1, 1, At, B1); PG8_BAR; PG8_SCHED;
            PG8_LDB(B0, 1, 0); PG8_LDB(B1, 1, 1); PG8_SCHED; PG8_LDA(At, 1, 0); PG8_STAGE(PG8_SA(0, 1), a2 + hstep, voffA);
            PG8_WAIT_V(8); PG8_WAIT_L(0); PG8_BAR; PG8_MMA(0, 0, At, B0); PG8_MMA(0, 1, At, B1); PG8_BAR; PG8_SCHED;
            PG8_LDA(At, 1, 1); PG8_STAGE(PG8_SB(1, 0), b3, voffB); PG8_STAGE(PG8_SB(1, 1), b3 + hstep, voffB); PG8_STAGE(PG8_SA(1, 0), a3, voffA);
            PG8_WAIT_V(8); PG8_WAIT_L(0); PG8_BAR; PG8_MMA(1, 0, At, B0); PG8_MMA(1, 1, At, B1); PG8_BAR; PG8_SCHED;
            } else {
            PG8_LDB(B0, 0, 0); PG8_SCHED; PG8_LDA(At, 0, 0); PG8_STAGE(PG8_SA(1, 1), a1 + hstep, voffA);
            PG8_WAIT_L(8); PG8_BAR; PG8_WAIT_L(0); PG8_MMA(0, 0, At, B0); PG8_BAR; PG8_SCHED;
            PG8_LDB(B1, 0, 1); PG8_STAGE(PG8_SB(0, 0), b2, voffB);
            PG8_BAR; PG8_WAIT_L(0); PG8_MMA(0, 1, At, B1); PG8_BAR;
            PG8_LDA(At, 0, 1); PG8_STAGE(PG8_SA(0, 0), a2, voffA);
            PG8_BAR; PG8_WAIT_L(0); PG8_MMA(1, 0, At, B0); PG8_BAR; PG8_SCHED;
            PG8_STAGE(PG8_SB(0, 1), b2 + hstep, voffB);
            PG8_WAIT_V(6); PG8_BAR; PG8_MMA(1, 1, At, B1); PG8_BAR;
            PG8_LDB(B0, 1, 0); PG8_SCHED; PG8_LDA(At, 1, 0); PG8_STAGE(PG8_SA(0, 1), a2 + hstep, voffA);
            PG8_WAIT_L(8); PG8_BAR; PG8_WAIT_L(0); PG8_MMA(0, 0, At, B0); PG8_BAR; PG8_SCHED;
            PG8_LDB(B1, 1, 1); PG8_STAGE(PG8_SB(1, 0), b3, voffB);
            PG8_BAR; PG8_WAIT_L(0); PG8_MMA(0, 1, At, B1); PG8_BAR;
            PG8_LDA(At, 1, 1); PG8_STAGE(PG8_SA(1, 0), a3, voffA);
            PG8_BAR; PG8_WAIT_L(0); PG8_MMA(1, 0, At, B0); PG8_BAR; PG8_SCHED;
            PG8_STAGE(PG8_SB(1, 1), b3 + hstep, voffB);
            PG8_WAIT_V(6); PG8_BAR; PG8_MMA(1, 1, At, B1); PG8_BAR;
            }
        }
        if constexpr (ALIGN_EPI) { if (wr == 0) PG8_BAR; }
        if constexpr (!Epi::AFTER_DRAIN) { E(acc, cur, wr, wc, fr, fq); S.done(cur); }
        if (!has_next) break;
#pragma unroll
        for (int a = 0; a < 2; ++a)
#pragma unroll
            for (int b = 0; b < 2; ++b)
#pragma unroll
                for (int m = 0; m < 4; ++m)
#pragma unroll
                    for (int n = 0; n < 2; ++n) acc[a][b][m][n] = (f32x4){0.f, 0.f, 0.f, 0.f};
        cur = nxt; cA = nA; cB = nB; ++ui;
        if constexpr (ALIGN_EPI) { if (wr == 1) PG8_BAR; }
    }
    PG8_WAIT_V(0);
    if constexpr (!ALIGN_EPI) { if (wr == 0) PG8_BAR; }
    PG8_BAR;
    if constexpr (Epi::AFTER_DRAIN) { E.fused(acc, cur, wr, wc, fr, fq, lds, wid, lane); S.done(cur); }
#undef PG8_SA
#undef PG8_SB
#undef PG8_STAGE
#undef PG8_LDA
#undef PG8_LDB
#undef PG8_MMA
#undef PG8_WAIT_V
#undef PG8_WAIT_L
#undef PG8_BAR
#undef PG8_SCHED
}
}
#define PG8_SP2 true
#define PG8_ALIGN true
namespace pg8 {
constexpr int MT = 16640, MP = 16384;
constexpr float RMS_EPS = 1e-6f;
constexpr float QC2 = 0.125f * 1.4426950408889634f;
typedef unsigned u32x2 __attribute__((ext_vector_type(2)));
__device__ __forceinline__ float row_rs(const float* SS, int row, int fq) {
    float s = 0.f;
#pragma unroll
    for (int j = 0; j < 4; ++j) s += SS[(unsigned)(4 * fq + j) * MT + row];
    s += __shfl_xor(s, 16); s += __shfl_xor(s, 32);
    return rsqrtf(s * (1.0f / 1024.0f) + RMS_EPS);
}
__device__ __forceinline__ void rows_rs8(const float* SS, int row0, int fq, float (&r)[8]) {
    float s[8][4];
    if (row0 < MP) {
#pragma unroll
        for (int k = 0; k < 8; ++k)
#pragma unroll
            for (int j = 0; j < 4; ++j) s[k][j] = SS[(unsigned)(4 * fq + j) * MT + row0 + (k >> 2) * HALF + (k & 3) * 16];
    } else { const float* S2 = SS + 16 * MT + (row0 - MP);
#pragma unroll
        for (int h2 = 0; h2 < 2; ++h2) { float q[4][8];
            __builtin_amdgcn_sched_barrier(0);
#pragma unroll
            for (int k = 0; k < 4; ++k)
#pragma unroll
                for (int j = 0; j < 8; ++j) q[k][j] = S2[(unsigned)(8 * fq + j) * 256 + h2 * HALF + k * 16];
            __builtin_amdgcn_sched_barrier(0);
#pragma unroll
            for (int k = 0; k < 4; ++k)
#pragma unroll
                for (int j = 0; j < 4; ++j) s[h2 * 4 + k][j] = q[k][j] + q[k][j + 4]; }
    }
    __builtin_amdgcn_sched_barrier(0);
#pragma unroll
    for (int k = 0; k < 8; ++k) { float t = (s[k][0] + s[k][1]) + (s[k][2] + s[k][3]); t += __shfl_xor(t, 16); t += __shfl_xor(t, 32); r[k] = rsqrtf(t * (1.0f / 1024.0f) + RMS_EPS); }
    __builtin_amdgcn_sched_barrier(0);
}
__device__ __forceinline__ void store8(bf16_t* p, f32x4 a, f32x4 b) {
    u32x4 w; w.x = cvt_pk_bf16(a[0], a[1]); w.y = cvt_pk_bf16(a[2], a[3]); w.z = cvt_pk_bf16(b[0], b[1]); w.w = cvt_pk_bf16(b[2], b[3]);
    *(u32x4*)p = w;
}
__device__ __forceinline__ float sigm(float x) { return __builtin_amdgcn_rcpf(1.0f + __builtin_amdgcn_exp2f(-1.4426950408889634f * x)); }
__device__ __forceinline__ f32x4 sigm4(f32x4 x) { f32x4 r; r[0] = sigm(x[0]); r[1] = sigm(x[1]); r[2] = sigm(x[2]); r[3] = sigm(x[3]); return r; }

struct EpiRes {
    static constexpr bool PERM = true, AFTER_DRAIN = false;
    bf16_t* xb; float* SS; int dry;
    __device__ __forceinline__ void operator()(const f32x4 (&acc)[2][2][4][2], const Unit& u, int wr, int wc, int fr, int fq) const {
        const int col0 = u.pn * BM + wc * 32 + 8 * fq;
#pragma unroll
        for (int ai = 0; ai < 2; ++ai) {
            u32x4 xw[4][2];
#pragma unroll
            for (int m = 0; m < 4; ++m)
#pragma unroll
                for (int bj = 0; bj < 2; ++bj) xw[m][bj] = *(const u32x4*)(xb + (unsigned)(u.pm * BM + ai * HALF + wr * 64 + m * 16 + fr) * 1024 + col0 + bj * HALF);
            __builtin_amdgcn_sched_barrier(0);
#pragma unroll
            for (int m = 0; m < 4; ++m) {
                const int rl = ai * HALF + wr * 64 + m * 16 + fr;
                const unsigned goff = (unsigned)(u.pm * BM + rl) * 1024 + col0;
                float ss = 0.f;
#pragma unroll
                for (int bj = 0; bj < 2; ++bj) {
                    const u32x4 w = xw[m][bj];
                    f32x4 o0, o1;
                    o0[0] = __builtin_bit_cast(float, w.x << 16) + acc[ai][bj][m][0][0]; o0[1] = __builtin_bit_cast(float, w.x & 0xffff0000u) + acc[ai][bj][m][0][1];
                    o0[2] = __builtin_bit_cast(float, w.y << 16) + acc[ai][bj][m][0][2]; o0[3] = __builtin_bit_cast(float, w.y & 0xffff0000u) + acc[ai][bj][m][0][3];
                    o1[0] = __builtin_bit_cast(float, w.z << 16) + acc[ai][bj][m][1][0]; o1[1] = __builtin_bit_cast(float, w.z & 0xffff0000u) + acc[ai][bj][m][1][1];
                    o1[2] = __builtin_bit_cast(float, w.w << 16) + acc[ai][bj][m][1][2]; o1[3] = __builtin_bit_cast(float, w.w & 0xffff0000u) + acc[ai][bj][m][1][3];
                    if (!dry) store8(xb + goff + bj * HALF, o0, o1);
                    ss += (o0[0] * o0[0] + o0[1] * o0[1]) + (o0[2] * o0[2] + o0[3] * o0[3]) + (o1[0] * o1[0] + o1[1] * o1[1]) + (o1[2] * o1[2] + o1[3] * o1[3]);
                }
                ss += __shfl_xor(ss, 16); ss += __shfl_xor(ss, 32);
                if (fq == 0 && !dry) SS[(unsigned)(u.pn * 4 + wc) * MT + u.pm * BM + rl] = ss;
                if (dry) asm volatile("" :: "v"(ss));
            }
        }
    }
};
struct EpiSwiGLU {
    static constexpr bool PERM = true, AFTER_DRAIN = false;
    bf16_t* H; const float* SS;
    __device__ __forceinline__ void operator()(const f32x4 (&acc)[2][2][4][2], const Unit& u, int wr, int wc, int fr, int fq) const {
        const int row0 = u.pm * BM + wr * 64 + fr, col0 = u.pn * 128 + wc * 32 + 8 * fq;
        float r8[8]; rows_rs8(SS, row0, fq, r8);
#pragma unroll
        for (int ai = 0; ai < 2; ++ai)
#pragma unroll
            for (int m = 0; m < 4; ++m) {
                const int row = row0 + ai * HALF + m * 16; const float r = r8[ai * 4 + m];
                const f32x4 g0 = acc[ai][0][m][0] * r, g1 = acc[ai][0][m][1] * r, u0 = acc[ai][1][m][0] * r, u1 = acc[ai][1][m][1] * r;
                store8(H + (unsigned)row * 2816 + col0, g0 * sigm4(g0) * u0, g1 * sigm4(g1) * u1);
            }
    }
};
struct EpiInProj {
    static constexpr bool PERM = true, AFTER_DRAIN = false;
    const float* SS; const float* TAB; bf16_t *UP, *Q, *K, *V, *UC; float *kP, *kS, *vP, *vS;
    __device__ __forceinline__ void operator()(const f32x4 (&acc)[2][2][4][2], const Unit& u, int wr, int wc, int fr, int fq) const {
        const int pn = u.pn; const bool smp = (u.pm >= 64);
        const int row0 = u.pm * BM + wr * 64 + fr, cw = wc * 32 + 8 * fq;
        float r8[8]; rows_rs8(SS, row0, fq, r8);
        if (pn == 0) {
#pragma unroll
            for (int ai = 0; ai < 2; ++ai)
#pragma unroll
                for (int m = 0; m < 4; ++m) { const int row = row0 + ai * HALF + m * 16; const float r = r8[ai * 4 + m];
#pragma unroll
                    for (int bj = 0; bj < 2; ++bj) store8(UP + (unsigned)row * 256 + bj * HALF + cw, acc[ai][bj][m][0] * r, acc[ai][bj][m][1] * r); }
        } else if (pn <= 4) {
            const bool isq = pn <= 2; const int t2 = (pn - 1) & 1, j = 4 * (wc & 1) + fq;
#pragma unroll
            for (int ai = 0; ai < 2; ++ai) {
                f32x4 csv[4], snv[4];
#pragma unroll
                for (int m = 0; m < 4; ++m) { const int row = row0 + ai * HALF + m * 16; const int pos = smp ? 2048 + ((row - MP) & 31) : (row & 2047);
                    csv[m] = *(const f32x4*)(TAB + pos * 64 + 4 * j); snv[m] = *(const f32x4*)(TAB + pos * 64 + 32 + 4 * j); }
                __builtin_amdgcn_sched_barrier(0);
#pragma unroll
                for (int m = 0; m < 4; ++m) { const int row = row0 + ai * HALF + m * 16; const float r = r8[ai * 4 + m];
                    const f32x4 cs = csv[m], sn = snv[m];
#pragma unroll
                    for (int bj = 0; bj < 2; ++bj) { const int grp = t2 * 4 + bj * 2 + (wc >> 1);
                        const f32x4 x1 = acc[ai][bj][m][0] * r, x2 = acc[ai][bj][m][1] * r;
                        const f32x4 o1 = x1 * cs - x2 * sn, o2 = x2 * cs + x1 * sn;
                        const unsigned bo = (unsigned)row * 512 + grp * 64 + 32 * (wc & 1) + 8 * fq;
                        if (isq) store8(Q + bo, o1 * QC2, o2 * QC2);
                        else { store8(K + bo, o1, o2);
                            float* kf = (smp ? kS + (unsigned)(row - MP) * 512 : kP + (unsigned)row * 512) + grp * 64 + 4 * j;
                            __builtin_nontemporal_store(o1, (f32x4*)kf); __builtin_nontemporal_store(o2, (f32x4*)(kf + 32)); } } } }
        } else if (pn <= 6) {
#pragma unroll
            for (int ai = 0; ai < 2; ++ai)
#pragma unroll
                for (int m = 0; m < 4; ++m) { const int row = row0 + ai * HALF + m * 16; const float r = r8[ai * 4 + m];
#pragma unroll
                    for (int bj = 0; bj < 2; ++bj) { const int col = (pn - 5) * 256 + bj * HALF + cw;
                        const f32x4 v0 = acc[ai][bj][m][0] * r, v1 = acc[ai][bj][m][1] * r;
                        store8(V + (unsigned)row * 512 + col, v0, v1);
                        float* vf = (smp ? vS + (unsigned)(row - MP) * 512 : vP + (unsigned)row * 512) + col;
                        __builtin_nontemporal_store(v0, (f32x4*)vf); __builtin_nontemporal_store(v1, (f32x4*)(vf + 4)); } }
        } else {
            const int T = pn - 7;
#pragma unroll
            for (int ai = 0; ai < 2; ++ai)
#pragma unroll
                for (int m = 0; m < 4; ++m) { const int row = row0 + ai * HALF + m * 16; const float r = r8[ai * 4 + m];
                    const f32x4 a0 = acc[ai][0][m][0] * r, a1 = acc[ai][0][m][1] * r, b0 = acc[ai][1][m][0] * r, b1 = acc[ai][1][m][1] * r;
                    store8(UC + (unsigned)row * 256 + T * 128 + cw, a0 * sigm4(b0), a1 * sigm4(b1)); }
        }
    }
};
}
#include <hip/hip_bf16.h>
#include <cmath>
namespace attn_body {
using bf16=__hip_bfloat16;
using bf16x8=__attribute__((ext_vector_type(8)))short;
using s16x4=__attribute__((ext_vector_type(4)))short;
using f32x16=__attribute__((ext_vector_type(16)))float;
using u32x4=__attribute__((ext_vector_type(4)))unsigned;
constexpr int BATCH=8,NHEAD=8,SEQ=2048,D=64,DM=512;
constexpr int NW=8,QBLK=32,QB=QBLK*NW,KVBLK=64,NQB=SEQ/QB;
constexpr int ATTN_PITCH=DM, ATTN_UNIT_ROWS=QB;
__device__ __forceinline__ int crow(int r,int hi){return (r&3)+8*(r>>2)+4*hi;}
#define SBAR() __builtin_amdgcn_sched_barrier(0)
__device__ __forceinline__ void cmask(f32x16&p0,f32x16&p1,int jb,int wid){
  if(jb>(wid>>1)){ const float NEG=-INFINITY;
  #pragma unroll
  for(int r=0;r<16;++r){p0[r]=NEG;p1[r]=NEG;} }
}

constexpr int NSLOT=3, SLOTB=8192;
constexpr int LDS_K=0, LDS_V=NSLOT*SLOTB, LDS_WS=2*NSLOT*SLOTB, LDS_OST=LDS_WS+NW*64*4, LDS_BYTES=LDS_OST+NW*4096;
constexpr float C2=0.125f*1.4426950408889634f;
__device__ __forceinline__ void glds16(const void*gsrc,unsigned lds_dst){unsigned keep;
  asm volatile("s_mov_b32 %0, m0\n\ts_mov_b32 m0, %2\n\ts_nop 0\n\tglobal_load_lds_dwordx4 %1, off\n\ts_mov_b32 m0, %0":"=&s"(keep):"v"(gsrc),"s"(lds_dst):"memory");}
__device__ __forceinline__ float max3f(float a,float b,float c){float r;asm("v_max3_f32 %0, %1, %2, %3":"=v"(r):"v"(a),"v"(b),"v"(c));return r;}
__device__ __forceinline__ float max2f(float a,float b){float r;asm("v_max_f32_e32 %0, %1, %2":"=v"(r):"v"(a),"v"(b));return r;}
__device__ __forceinline__ float fadd_s(float a,float b){float r;asm("v_add_f32_e32 %0, %1, %2":"=v"(r):"v"(a),"v"(b));return r;}
__device__ __forceinline__ float fsub_s(float a,float b){float r;asm("v_sub_f32_e32 %0, %1, %2":"=v"(r):"v"(a),"v"(b));return r;}
typedef float f32x2_t __attribute__((ext_vector_type(2))); typedef __bf16 bf16x2_t __attribute__((ext_vector_type(2)));
__device__ __forceinline__ unsigned cvtpk_s(float lo,float hi){f32x2_t v={lo,hi};bf16x2_t b=__builtin_convertvector(v,bf16x2_t);return __builtin_bit_cast(unsigned,b);}
#define WAIT_BAR(N) asm volatile("s_waitcnt vmcnt(" #N ") lgkmcnt(0)\n\ts_barrier":::"memory")

__device__ __forceinline__ void qkt(f32x16&p0,f32x16&p1,const char*Kslot,const bf16x8*qr,const f32x16&negm,int r32,int hi){
  const char*kb=Kslot+hi*1024+r32*16;
  #pragma unroll
  for(int d0=0;d0<4;++d0){
    const bf16x8 b0=*reinterpret_cast<const bf16x8*>(kb+d0*2048);
    const bf16x8 b1=*reinterpret_cast<const bf16x8*>(kb+d0*2048+512);
    if(d0==0){p0=__builtin_amdgcn_mfma_f32_32x32x16_bf16(b0,qr[0],negm,0,0,0);p1=__builtin_amdgcn_mfma_f32_32x32x16_bf16(b1,qr[0],negm,0,0,0);}
    else{p0=__builtin_amdgcn_mfma_f32_32x32x16_bf16(b0,qr[d0],p0,0,0,0);p1=__builtin_amdgcn_mfma_f32_32x32x16_bf16(b1,qr[d0],p1,0,0,0);}}
}
typedef __attribute__((address_space(3))) const char* lds_cptr;
typedef short v4i16_t __attribute__((ext_vector_type(4)));
__device__ __forceinline__ void kload8(bf16x8*kf,lds_cptr kp){
  kf[0]=*(const __attribute__((address_space(3))) bf16x8*)(kp);      kf[1]=*(const __attribute__((address_space(3))) bf16x8*)(kp+512);
  kf[2]=*(const __attribute__((address_space(3))) bf16x8*)(kp+2048); kf[3]=*(const __attribute__((address_space(3))) bf16x8*)(kp+2560);
  kf[4]=*(const __attribute__((address_space(3))) bf16x8*)(kp+4096); kf[5]=*(const __attribute__((address_space(3))) bf16x8*)(kp+4608);
  kf[6]=*(const __attribute__((address_space(3))) bf16x8*)(kp+6144); kf[7]=*(const __attribute__((address_space(3))) bf16x8*)(kp+6656);
}
__device__ __forceinline__ void kload2(bf16x8*kf,lds_cptr kp,int j){ kf[2*j]=*(const __attribute__((address_space(3))) bf16x8*)(kp+j*2048); kf[2*j+1]=*(const __attribute__((address_space(3))) bf16x8*)(kp+j*2048+512); }
__device__ __forceinline__ s16x4 vtr(lds_cptr p){ return __builtin_bit_cast(s16x4,__builtin_amdgcn_ds_read_tr16_b64_v4i16((__attribute__((address_space(3))) v4i16_t*)p)); }
__device__ __forceinline__ float rowmax(const f32x16&p0,const f32x16&p1){
  float a=max3f(p0[0],p0[1],p1[0]),b=max3f(p0[2],p0[3],p1[1]);a=max3f(a,p1[2],p1[3]);
  #pragma unroll
  for(int r=4;r<16;r+=4){a=max3f(a,p0[r],p0[r+1]);b=max3f(b,p0[r+2],p0[r+3]);a=max3f(a,p1[r],p1[r+1]);b=max3f(b,p1[r+2],p1[r+3]);}
  const float m=max2f(a,b);
  auto rr=__builtin_amdgcn_permlane32_swap(__float_as_uint(m),__float_as_uint(m),false,false);
  return max2f(__uint_as_float(rr[0]),__uint_as_float(rr[1]));
}
__device__ __forceinline__ void pv(f32x16*o,int vb,bf16x8 pa0,bf16x8 pa1,bf16x8 pa2,bf16x8 pa3){
  #pragma unroll
  for(int d0=0;d0<2;++d0){s16x4 lo[4],hi[4];
    #pragma unroll
    for(int ks=0;ks<4;++ks){
      asm volatile("ds_read_b64_tr_b16 %0,%1 offset:%c2":"=&v"(lo[ks]):"v"(vb),"i"(d0*4096+ks*1024):"memory");
      asm volatile("ds_read_b64_tr_b16 %0,%1 offset:%c2":"=&v"(hi[ks]):"v"(vb),"i"(d0*4096+ks*1024+512):"memory");}
    asm volatile("s_waitcnt lgkmcnt(0)":::"memory");SBAR();
    #define PK(k) (bf16x8){lo[k][0],lo[k][1],lo[k][2],lo[k][3],hi[k][0],hi[k][1],hi[k][2],hi[k][3]}
    o[d0]=__builtin_amdgcn_mfma_f32_32x32x16_bf16(pa0,PK(0),o[d0],0,0,0);
    o[d0]=__builtin_amdgcn_mfma_f32_32x32x16_bf16(pa1,PK(1),o[d0],0,0,0);
    o[d0]=__builtin_amdgcn_mfma_f32_32x32x16_bf16(pa2,PK(2),o[d0],0,0,0);
    o[d0]=__builtin_amdgcn_mfma_f32_32x32x16_bf16(pa3,PK(3),o[d0],0,0,0);
    #undef PK
  }
}

#ifndef ATTN_STORE16
#define ATTN_STORE16(p,v) (*(u32x4*)(p)=(v))
#endif
template<int THRL> __device__ __forceinline__ void attn_unit(int b,int h,int hv,int qb,const bf16*Q,const bf16*__restrict__ K,const bf16*__restrict__ V,bf16*O,int ocol,char*shm){
  int tid_l=threadIdx.x; asm volatile("":"+v"(tid_l)); const int tid=tid_l,lane=tid&63,r32=lane&31,hi=lane>>5; const int wid=__builtin_amdgcn_readfirstlane(tid>>6);
  const long rowbase=(long)b*SEQ; const int q0=qb*QB;
  const bf16*Qw=Q+(rowbase+q0+wid*QBLK)*DM+h*D;
  const bf16*Kh=K+rowbase*DM+h*D,*Vh=V+rowbase*DM+hv*D;
  const unsigned lds0=(unsigned)(uintptr_t)shm;
  float*wsf=(float*)(shm+LDS_WS)+wid*64;
  const bf16*ksrc=Kh+(long)lane*DM+wid*8;
  const bf16*vsrc=Vh+(long)(16*(wid&3)+(lane>>2))*DM+(wid>>2)*32+(lane&3)*8;
  const unsigned kdst=lds0+LDS_K+wid*1024, vdst=lds0+LDS_V+wid*1024;
  #define DMA_K(t,slot) glds16(ksrc+(long)(t)*KVBLK*DM,(unsigned)__builtin_amdgcn_readfirstlane(kdst+(slot)))
  #define DMA_V(t,slot) glds16(vsrc+(long)(t)*KVBLK*DM,(unsigned)__builtin_amdgcn_readfirstlane(vdst+(slot)))
  const int vb0=(int)(lds0+LDS_V)+((lane>>4)&1)*32+(lane&3)*8+(4*hi+((lane&15)>>2))*64;
  const char*Kbase=shm+LDS_K; bf16x8 kf[8];
  const lds_cptr shm3=(lds_cptr)shm; const lds_cptr kp0=shm3+LDS_K+hi*1024+r32*16; const lds_cptr vp0=shm3+LDS_V+((lane>>4)&1)*32+(lane&3)*8+(4*hi+((lane&15)>>2))*64;
  const int NT=(q0+QB)/KVBLK;
  DMA_K(0,0);DMA_V(0,0);DMA_K(1,SLOTB);
  bf16x8 qr[4];
  #pragma unroll
  for(int d0=0;d0<4;++d0)qr[d0]=*reinterpret_cast<const bf16x8*>(&Qw[(long)r32*DM+d0*16+hi*8]);
  float mhat=0.f,l_reg=0.f;f32x16 o[2];o[0]=f32x16{};o[1]=f32x16{};f32x16 negm=f32x16{};asm volatile("":"+v"(negm));
  const int qrel=wid*QBLK+r32;
  #define CMASK(P0,P1,t) do{int jb_=(t)-(NT-4); if(jb_>=0)cmask(P0,P1,jb_,wid);}while(0)
  bool resc=false;
  #define START(P0,P1) do{ const float rm=rowmax(P0,P1); resc=false; \
    { const float dl=rm; mhat=fadd_s(mhat,dl); \
      _Pragma("unroll") for(int r=0;r<16;++r){P0[r]=fsub_s(P0[r],dl);P1[r]=fsub_s(P1[r],dl);} \
      _Pragma("unroll") for(int r=0;r<16;++r)negm[r]=-mhat; asm volatile("":"+v"(negm)); } \
    _Pragma("unroll") for(int r=0;r<16;++r)P0[r]=__builtin_amdgcn_exp2f(P0[r]); }while(0)
  #define RESC() do{ if(resc){ asm volatile("s_waitcnt lgkmcnt(0)":::"memory"); \
      _Pragma("unroll") for(int d_=0;d_<2;++d_) _Pragma("unroll") for(int r=0;r<16;++r)o[d_][r]*=wsf[crow(r,hi)]; } }while(0)
  f32x16 pA0,pA1,pB0,pB1;
  int sl_prev=0,sl_cur=0,sl_next=SLOTB;
  #define ROT() do{sl_prev=sl_cur;sl_cur=sl_next;sl_next=(sl_next==(NSLOT-1)*SLOTB)?0:sl_next+SLOTB;}while(0)
  DMA_K(2,2*SLOTB);
  WAIT_BAR(3);
  qkt(pA0,pA1,Kbase,qr,negm,r32,hi);asm volatile("s_nop 15\n\ts_nop 7":"+v"(pA0),"+v"(pA1));CMASK(pA0,pA1,0);
  START(pA0,pA1);
  _Pragma("unroll") for(int r=0;r<16;++r)pA1[r]=__builtin_amdgcn_exp2f(pA1[r]);
  WAIT_BAR(0);
  DMA_K(3,0);DMA_V(1,SLOTB);
  ROT();
  kload8(kf,kp0+sl_cur);
  WAIT_BAR(2);
  s16x4 vlo[8],vhi[8]; u32x4 pw0,pw1,pw2,pw3;
  #define PKW(P,B) cvtpk_s(P[B],P[B+1])
  #define PAF(k) __builtin_bit_cast(bf16x8,pw##k)
  #define VFR(i) (bf16x8){vlo[i][0],vlo[i][1],vlo[i][2],vlo[i][3],vhi[i][0],vhi[i][1],vhi[i][2],vhi[i][3]}
  #define PIN(x) asm volatile("":"+v"(x))
  #define MX3(a,b,c) __builtin_fmaxf(__builtin_fmaxf((a),(b)),(c))
  #define GAPA(MF,A0,A1,A2,A3,W0,W1,PW) do{ MF; sacc+=A0; sacc+=A1; sacc+=A2; sacc+=A3; PIN(sacc); W0; W1; PIN(PW); SBAR(); }while(0)
  #define EX(v) __builtin_amdgcn_exp2f(v)
  #define GAPB(MF,X,B) do{ MF; X[B]=EX(X[B]); X[B+1]=EX(X[B+1]); X[B+2]=EX(X[B+2]); X[B+3]=EX(X[B+3]); PIN(X); SBAR(); }while(0)
  #define VRD(i) do{ vlo[i]=vtr(vp_+(((i)>>2)*4096+((i)&3)*1024)); vhi[i]=vtr(vp_+(((i)>>2)*4096+((i)&3)*1024+512)); }while(0)
  #define KRD(G,j) do{ if(G){ kload2(kf,kp0+sl_next,j); SBAR(); } }while(0)
  #define STEP(C0,C1,P0,P1,t,GK,GV,GL) do{ SBAR(); \
    const lds_cptr vp_=vp0+sl_prev; \
    VRD(0); SBAR(); float sacc=(P0[0]+P0[1]); \
    GAPA(C0=__builtin_amdgcn_mfma_f32_32x32x16_bf16(kf[0],qr[0],negm,0,0,0), P0[2],P0[3],P0[4],P0[5],     pw0[0]=PKW(P0,0), pw0[1]=PKW(P0,2), pw0); \
    VRD(4); SBAR(); GAPA(C1=__builtin_amdgcn_mfma_f32_32x32x16_bf16(kf[1],qr[0],negm,0,0,0), P0[6],P0[7],P0[8],P0[9],     pw0[2]=PKW(P0,4), pw0[3]=PKW(P0,6), pw0); \
    VRD(1); SBAR(); GAPA(C0=__builtin_amdgcn_mfma_f32_32x32x16_bf16(kf[2],qr[1],C0,0,0,0),   P0[10],P0[11],P0[12],P0[13], pw1[0]=PKW(P0,8), pw1[1]=PKW(P0,10), pw1); \
    VRD(5); SBAR(); GAPA(C1=__builtin_amdgcn_mfma_f32_32x32x16_bf16(kf[3],qr[1],C1,0,0,0),   P0[14],P0[15],P1[0],P1[1],   pw1[2]=PKW(P0,12),pw1[3]=PKW(P0,14), pw1); \
    VRD(2); SBAR(); GAPA(C0=__builtin_amdgcn_mfma_f32_32x32x16_bf16(kf[4],qr[2],C0,0,0,0),   P1[2],P1[3],P1[4],P1[5],     pw2[0]=PKW(P1,0), pw2[1]=PKW(P1,2), pw2); \
    VRD(6); SBAR(); GAPA(C1=__builtin_amdgcn_mfma_f32_32x32x16_bf16(kf[5],qr[2],C1,0,0,0),   P1[6],P1[7],P1[8],P1[9],     pw2[2]=PKW(P1,4), pw2[3]=PKW(P1,6), pw2); \
    VRD(3); SBAR(); GAPA(C0=__builtin_amdgcn_mfma_f32_32x32x16_bf16(kf[6],qr[3],C0,0,0,0),   P1[10],P1[11],P1[12],P1[13], pw3[0]=PKW(P1,8), pw3[1]=PKW(P1,10), pw3); \
    VRD(7); SBAR(); GAPA(C1=__builtin_amdgcn_mfma_f32_32x32x16_bf16(kf[7],qr[3],C1,0,0,0),   P1[14],P1[15],0.f,0.f,       pw3[2]=PKW(P1,12),pw3[3]=PKW(P1,14), pw3); \
    l_reg+=sacc; \
    if(GK){DMA_K((t)+3,sl_cur);} if(GV){DMA_V((t)+1,sl_next);} \
    CMASK(C0,C1,t); \
    { float a=MX3(C0[0],C0[1],C1[0]),b=MX3(C0[2],C0[3],C1[1]); a=MX3(a,C1[2],C1[3]); \
      _Pragma("unroll") for(int r=4;r<16;r+=4){a=MX3(a,C0[r],C0[r+1]);b=MX3(b,C0[r+2],C0[r+3]);a=MX3(a,C1[r],C1[r+1]);b=MX3(b,C1[r+2],C1[r+3]);} \
      float rm=__builtin_fmaxf(a,b); { auto rr=__builtin_amdgcn_permlane32_swap(__float_as_uint(rm),__float_as_uint(rm),false,false); rm=__builtin_fmaxf(__uint_as_float(rr[0]),__uint_as_float(rr[1])); } \
      resc=false; \
      if(__builtin_expect(__any(rm>(float)THRL),0)){ const float dl=__builtin_fmaxf(rm,0.f); mhat+=dl; \
        _Pragma("unroll") for(int r=0;r<16;++r){C0[r]-=dl;C1[r]-=dl;} \
        _Pragma("unroll") for(int r=0;r<16;++r)negm[r]=-mhat; asm volatile("":"+v"(negm)); \
        const float f=__builtin_amdgcn_exp2f(-dl); l_reg*=f; if(hi==0)wsf[r32]=f; resc=true; } } \
    SBAR(); \
    GAPB(o[0]=__builtin_amdgcn_mfma_f32_32x32x16_bf16(PAF(0),VFR(0),o[0],0,0,0), C0,0); \
    GAPB(o[1]=__builtin_amdgcn_mfma_f32_32x32x16_bf16(PAF(0),VFR(4),o[1],0,0,0), C0,4); \
    KRD(GL,0); GAPB(o[0]=__builtin_amdgcn_mfma_f32_32x32x16_bf16(PAF(1),VFR(1),o[0],0,0,0), C0,8); \
    KRD(GL,1); GAPB(o[1]=__builtin_amdgcn_mfma_f32_32x32x16_bf16(PAF(1),VFR(5),o[1],0,0,0), C0,12); \
    KRD(GL,2); GAPB(o[0]=__builtin_amdgcn_mfma_f32_32x32x16_bf16(PAF(2),VFR(2),o[0],0,0,0), C1,0); \
    KRD(GL,3); GAPB(o[1]=__builtin_amdgcn_mfma_f32_32x32x16_bf16(PAF(2),VFR(6),o[1],0,0,0), C1,4); \
    GAPB(o[0]=__builtin_amdgcn_mfma_f32_32x32x16_bf16(PAF(3),VFR(3),o[0],0,0,0), C1,8); \
    GAPB(o[1]=__builtin_amdgcn_mfma_f32_32x32x16_bf16(PAF(3),VFR(7),o[1],0,0,0), C1,12); \
    }while(0)
  int t=1;
  #undef CMASK
  #define CMASK(P0,P1,t) do{}while(0)
  for(;t+5<NT;t+=2){
    STEP(pB0,pB1,pA0,pA1,t,true,true,true);     WAIT_BAR(2); RESC(); ROT();
    STEP(pA0,pA1,pB0,pB1,t+1,true,true,true);   WAIT_BAR(2); RESC(); ROT();
  }
  #undef CMASK
  #define CMASK(P0,P1,t) do{int jb_=(t)-(NT-4); if(jb_>=0)cmask(P0,P1,jb_,wid);}while(0)
  #define ENDW(tt) do{ if((tt)+3<NT){WAIT_BAR(2);} else if((tt)+2<NT){WAIT_BAR(1);} else {WAIT_BAR(0);} }while(0)
  for(;t+1<NT;t+=2){
    STEP(pB0,pB1,pA0,pA1,t,(t+3<NT),(t+1<NT),(t+1<NT));       ENDW(t);   RESC(); ROT();
    STEP(pA0,pA1,pB0,pB1,t+1,(t+4<NT),(t+2<NT),(t+2<NT));     ENDW(t+1); RESC(); ROT();
  }
  STEP(pB0,pB1,pA0,pA1,NT-1,false,false,false); RESC();
  { float sacc=pB0[0]+pB0[1]; _Pragma("unroll") for(int r=2;r<16;++r)sacc+=pB0[r]; _Pragma("unroll") for(int r=0;r<16;++r)sacc+=pB1[r]; l_reg+=sacc;
    pw0=(u32x4){PKW(pB0,0),PKW(pB0,2),PKW(pB0,4),PKW(pB0,6)};pw1=(u32x4){PKW(pB0,8),PKW(pB0,10),PKW(pB0,12),PKW(pB0,14)};pw2=(u32x4){PKW(pB1,0),PKW(pB1,2),PKW(pB1,4),PKW(pB1,6)};pw3=(u32x4){PKW(pB1,8),PKW(pB1,10),PKW(pB1,12),PKW(pB1,14)};
    SBAR(); pv(o,vb0+sl_cur,PAF(0),PAF(1),PAF(2),PAF(3)); }
  #undef PKW
  #undef PAF
  #undef VFR
  #undef PIN
  #undef MX3
  #undef GAPA
  #undef GAPB
  #undef EX
  #undef VRD
  #undef KRD
  #undef STEP
  #undef ENDW
  {auto rr=__builtin_amdgcn_permlane32_swap(__float_as_uint(l_reg),__float_as_uint(l_reg),false,false);l_reg=__uint_as_float(rr[0])+__uint_as_float(rr[1]);}
  if(hi==0)wsf[32+r32]=l_reg;asm volatile("s_waitcnt lgkmcnt(0)":::"memory");
  float rli[16];
  #pragma unroll
  for(int r=0;r<16;++r)rli[r]=__builtin_amdgcn_rcpf(wsf[32+crow(r,hi)]);
  bf16*Ow=O+(rowbase+q0+wid*QBLK)*1024+ocol;
  { bf16*stg=(bf16*)(shm+LDS_OST)+wid*2048;
    #pragma unroll
    for(int r=0;r<16;++r){const int orow=crow(r,hi);
      #pragma unroll
      for(int d0=0;d0<2;++d0)stg[orow*64+d0*32+r32]=__float2bfloat16(o[d0][r]*rli[r]);}
    asm volatile("s_waitcnt lgkmcnt(0)":::"memory");
    #pragma unroll
    for(int i=0;i<4;++i){const int row=i*8+(lane>>3),ch=lane&7; const u32x4 v=*(const u32x4*)(stg+row*64+ch*8); ATTN_STORE16(Ow+(long)row*1024+ch*8,v);} }
  asm volatile("s_waitcnt lgkmcnt(0)\n\ts_barrier":::"memory");
  #undef DMA_K
  #undef DMA_V
  #undef CMASK
  #undef START
  #undef RESC
  #undef ROT
}
constexpr int ATTN_LDS_BYTES=LDS_BYTES;
#undef SBAR
#undef WAIT_BAR
}
#ifndef MK_MULTI
#define MK_MULTI 0
#endif
#ifndef REP_SYNC
#define REP_SYNC 0
#endif
#ifndef REP_FOLD
#define REP_FOLD 1
#endif
#ifndef REP_SLACK
#define REP_SLACK 1
#endif
#ifndef SLACK_W
#define SLACK_W 1
#endif
constexpr int NWAVES = 8, NPH = 14;
constexpr int MT = pg8::MT, MP = pg8::MP, DM_ = 1024, INW = 2304, DFF = 2816;
constexpr size_t MiB = 1u << 20;
constexpr size_t WS_TAB = 1 * MiB;
constexpr size_t WS_LAM = 2 * MiB;
constexpr size_t WS_SS = 3 * MiB;
constexpr size_t WS_WIN = 5 * MiB, WS_WOUT = 14 * MiB, WS_WGU = 18 * MiB, WS_WDN = 40 * MiB;
constexpr size_t WS_XB = 52 * MiB;
constexpr size_t WS_SPO = 86 * MiB;
constexpr size_t WS_SPM = 95 * MiB;
constexpr size_t WS_Q = 96 * MiB, WS_K = 113 * MiB, WS_V = 130 * MiB, WS_UP = 147 * MiB, WS_UC = 156 * MiB, WS_O4 = 165 * MiB, WS_MIX = 197 * MiB;
constexpr size_t WS_H = 96 * MiB;
constexpr size_t WS_END = 230 * MiB;
static_assert(WS_H + (size_t)MT * DFF * 2 <= WS_MIX && WS_MIX + (size_t)MT * 1024 * 2 <= WS_END, "ws map");
constexpr size_t O_Y = 0, O_KP = 17039360, O_VP = 33816576, O_PP = 50593792, O_CP = 50655232, O_KS = 50778112, O_VS = 51040256, O_PS = 51302400, O_CS = 51363840, O_END = 51486720;
constexpr int LDS_BYTES = 147456;

#define LAS __attribute__((address_space(3)))
typedef unsigned short bf16;
typedef unsigned v4u __attribute__((ext_vector_type(4)));
typedef unsigned v2u __attribute__((ext_vector_type(2)));
typedef float f32x4 __attribute__((ext_vector_type(4)));
typedef float f32x16 __attribute__((ext_vector_type(16)));
typedef short bf16x8 __attribute__((ext_vector_type(8)));
__device__ __forceinline__ unsigned f2bf(float f) { unsigned u = __builtin_bit_cast(unsigned, f); return (u + 0x7fffu + ((u >> 16) & 1u)) >> 16; }
__device__ __forceinline__ unsigned pk2(float lo, float hi) { return f2bf(lo) | (f2bf(hi) << 16); }
__device__ __forceinline__ float bflo(unsigned w) { return __builtin_bit_cast(float, w << 16); }
__device__ __forceinline__ float bfhi(unsigned w) { return __builtin_bit_cast(float, w & 0xffff0000u); }
__device__ __forceinline__ float wave_sum(float v) {
#pragma unroll
    for (int o = 1; o < 64; o <<= 1) v += __shfl_xor(v, o);
    return v;
}
struct Args { const float* in[22]; float* out; unsigned char* ws; int ph_lo, ph_hi; };
struct Frame { int tid, lane, wave, vcu, G, gw, NGW; };

#define XB_TMO      128
#define XB_XCNT(j)  (256  + 64 * (j))
#define XB_XSUB(j)  (1280 + 64 * (j))
#define XB_XGEN(j)  (2304 + 64 * (j))
#define XB_TOP      3328
#define XB_TOPGEN   3392
#define XCD_BAR_WORDS 3456
#define XB_SPIN_CAP (1u << 18)

__device__ __forceinline__ unsigned xb_ld(unsigned* p)              { return __hip_atomic_load(p, __ATOMIC_RELAXED, __HIP_MEMORY_SCOPE_AGENT); }
__device__ __forceinline__ unsigned xb_add(unsigned* p, unsigned v) { return __hip_atomic_fetch_add(p, v, __ATOMIC_RELAXED, __HIP_MEMORY_SCOPE_AGENT); }
__device__ __forceinline__ unsigned xb_xcc_id() { return (unsigned)__builtin_amdgcn_s_getreg((3 << 11) | 20) & 0xFu; }
#define XB_SPIN(cond, bar) do { unsigned _sp = 0; while (cond) { __builtin_amdgcn_s_sleep(1); \
    if ((++_sp & 255u) == 0u) { if (xb_ld(&(bar)[XB_TMO])) break; if (_sp > XB_SPIN_CAP) { atomicAdd(&(bar)[XB_TMO], 1u); break; } } } } while (0)

struct XcdBarrier {
    unsigned* bar; unsigned x;
    volatile LAS unsigned* st;
};

__device__ __forceinline__ XcdBarrier xcd_barrier_post(unsigned* bar, volatile LAS unsigned* st) {
    XcdBarrier b; b.bar = bar; b.x = xb_xcc_id(); b.st = st;
    if (threadIdx.x == 0) (void)xb_add(&bar[XB_XCNT(b.x)], 1u);
    return b;
}
__device__ __forceinline__ void xcd_barrier_complete(unsigned* bar, unsigned x, unsigned& nloc, unsigned& nx) {
    const unsigned G = gridDim.x * gridDim.y * gridDim.z;
    unsigned sum, cnt, mine, sp = 0u;
    for (;;) {
        sum = 0u; cnt = 0u; mine = 0u;
#pragma unroll
        for (unsigned j = 0; j < 16; ++j) { const unsigned c = xb_ld(&bar[XB_XCNT(j)]); sum += c; cnt += (c > 0u) ? 1u : 0u; mine = (j == x) ? c : mine; }
        if (sum == G) break;
        __builtin_amdgcn_s_sleep(1);
        if ((++sp & 255u) == 0u) { if (xb_ld(&bar[XB_TMO])) break; if (sp > XB_SPIN_CAP) { atomicAdd(&bar[XB_TMO], 1u); break; } }
    }
    nloc = mine > 0u ? mine : 1u; nx = cnt > 0u ? cnt : 1u;
}

__device__ __forceinline__ void xcd_barrier(const XcdBarrier& b) {
    asm volatile("s_waitcnt vmcnt(0)" ::: "memory");
    __syncthreads();
    if (threadIdx.x == 0) {
        unsigned* bar = b.bar;
        __builtin_amdgcn_s_waitcnt(0);
        unsigned nloc = b.st[0], nx = b.st[1];
        if (nloc == 0u) { xcd_barrier_complete(bar, b.x, nloc, nx); b.st[0] = nloc; b.st[1] = nx; }
        const unsigned old = xb_add(&bar[XB_XSUB(b.x)], 1u);
        const unsigned gen = old / nloc;
        if (old + 1u == (gen + 1u) * nloc) {
            __builtin_amdgcn_fence(__ATOMIC_RELEASE, "agent");
            asm volatile("s_waitcnt vmcnt(0)" ::: "memory");
            const unsigned og = xb_add(&bar[XB_TOP], 1u);
            const unsigned tg = og / nx;
            if (og + 1u == (tg + 1u) * nx) xb_add(&bar[XB_TOPGEN], 1u);
            else XB_SPIN(xb_ld(&bar[XB_TOPGEN]) == tg, bar);
            __builtin_amdgcn_fence(__ATOMIC_ACQUIRE, "agent");
            xb_add(&bar[XB_XGEN(b.x)], 1u);
            asm volatile("s_waitcnt vmcnt(0)" ::: "memory");
        } else {
            XB_SPIN(xb_ld(&bar[XB_XGEN(b.x)]) == gen, bar);
            __builtin_amdgcn_fence(__ATOMIC_ACQUIRE, "agent");
            asm volatile("s_waitcnt vmcnt(0)" ::: "memory");
        }
    }
    __syncthreads();
}

constexpr int MISC_OFF = 147200;
__device__ __forceinline__ int perm_in(int n) {
    if (n < 256) return n;
    if (n < 1280) { const int p = n & 63, j = p >> 3, nn = (p >> 2) & 1, i = p & 3; return (n & ~63) + 32 * nn + 4 * j + i; }
    if (n < 1792) return n;
    const int x = n - 1792, T = x >> 8, bj = (x >> 7) & 1, cc = x & 127; return 1792 + 256 * bj + 128 * T + cc;
}
__device__ __forceinline__ int perm_gu(int n) { const int T = n >> 8, bj = (n >> 7) & 1, cc = n & 127; return 2816 * bj + 128 * T + cc; }
template <int MODE> __device__ __forceinline__ void transpose_item(const float* W, int ldw, const float* gk, bf16* WT, int ldwt, int koff, int nblk, LAS float* scr, int item, int lane) {
    (void)scr;
    const int kb = item / nblk, nb = item % nblk, k0 = 64 * kb, np = 64 * nb + lane;
    const int src = (MODE == 1) ? perm_in(np) : (MODE == 2) ? perm_gu(np) : np;
    const float* wp = W + (size_t)k0 * ldw + src;
    float v[64];
#pragma unroll
    for (int t = 0; t < 64; ++t) v[t] = __builtin_nontemporal_load(wp + (size_t)t * ldw);
    __builtin_amdgcn_sched_barrier(0);
    bf16* op = WT + (size_t)np * ldwt + koff + k0;
#pragma unroll
    for (int kc = 0; kc < 8; ++kc) {
        float g[8];
#pragma unroll
        for (int t = 0; t < 8; ++t) g[t] = gk ? gk[k0 + 8 * kc + t] : 1.0f;
        v4u o; o.x = pg8::cvt_pk_bf16(v[8 * kc] * g[0], v[8 * kc + 1] * g[1]); o.y = pg8::cvt_pk_bf16(v[8 * kc + 2] * g[2], v[8 * kc + 3] * g[3]);
        o.z = pg8::cvt_pk_bf16(v[8 * kc + 4] * g[4], v[8 * kc + 5] * g[5]); o.w = pg8::cvt_pk_bf16(v[8 * kc + 6] * g[6], v[8 * kc + 7] * g[7]);
        *(v4u*)(op + 8 * kc) = o; }
}
__device__ __forceinline__ void fold_item(const float* pool_w, const float* pool_scale, const float* conv_pw, const float* w_out, bf16* WT, LAS float* scr, int item, int lane) {
    const int kb = item >> 4, nb = item & 15, n = nb * 64 + lane;
    float acc[8];
#pragma unroll
    for (int i = 0; i < 8; ++i) acc[i] = 0.f;
    int k0, D, rb;
    if (kb < 32) { k0 = kb * 8; D = 64; const int g = k0 >> 6; rb = 64 * g; const float ps = pool_scale[64 * g + lane];
        float pw[8];
#pragma unroll
        for (int i = 0; i < 8; ++i) pw[i] = pool_w[(size_t)(g * 64 + ((k0 + i) & 63)) * 64 + lane];
        __builtin_amdgcn_sched_barrier(0);
#pragma unroll
        for (int i = 0; i < 8; ++i) scr[i * 64 + lane] = pw[i] * ps;
    } else { k0 = 768 + (kb - 32) * 8; D = 256; rb = 768;
        f32x4 cw[8];
#pragma unroll
        for (int i = 0; i < 8; ++i) cw[i] = *(const f32x4*)(conv_pw + (size_t)(k0 - 768 + i) * 256 + 4 * lane);
        __builtin_amdgcn_sched_barrier(0);
#pragma unroll
        for (int i = 0; i < 8; ++i) *(LAS f32x4*)(scr + i * 256 + 4 * lane) = cw[i];
    }
    asm volatile("s_waitcnt lgkmcnt(0)" ::: "memory");
    const float* wp = w_out + (size_t)rb * 1024 + n;
#pragma unroll 1
    for (int d = 0; d < D; d += 32) {
        float wv[32];
#pragma unroll
        for (int q = 0; q < 32; ++q) wv[q] = wp[(size_t)(d + q) * 1024];
        __builtin_amdgcn_sched_barrier(0);
#pragma unroll
        for (int q = 0; q < 32; q += 4)
#pragma unroll
            for (int i = 0; i < 8; ++i) { const f32x4 cf = *(const LAS f32x4*)(scr + i * D + d + q); acc[i] += (cf.x * wv[q] + cf.y * wv[q + 1]) + (cf.z * wv[q + 2] + cf.w * wv[q + 3]); }
        __builtin_amdgcn_sched_barrier(0);
    }
    asm volatile("s_waitcnt lgkmcnt(0)" ::: "memory");
    v4u o; o.x = pk2(acc[0], acc[1]); o.y = pk2(acc[2], acc[3]); o.z = pk2(acc[4], acc[5]); o.w = pk2(acc[6], acc[7]);
    *(v4u*)(WT + (size_t)n * 1024 + k0) = o;
}
constexpr int WI_A = 576, WI_B = 3840, WI_C = 5568, WI_END = 7680;
__device__ __forceinline__ void wi_in(const Args& A, LAS float* scr, int lane, int l, int it) { transpose_item<1>(A.in[7] + (size_t)l * 1024 * INW, INW, A.in[6] + l * 1024, (bf16*)(A.ws + WS_WIN) + (size_t)l * INW * 1024, 1024, 0, INW / 64, scr, it, lane); }
__device__ __forceinline__ void wi_gu(const Args& A, LAS float* scr, int lane, int l, int it) { transpose_item<2>(A.in[19] + (size_t)l * 1024 * 2 * DFF, 2 * DFF, A.in[18] + l * 1024, (bf16*)(A.ws + WS_WGU) + (size_t)l * 2 * DFF * 1024, 1024, 0, 2 * DFF / 64, scr, it, lane); }
__device__ __forceinline__ void wi_dn(const Args& A, LAS float* scr, int lane, int l, int it) { transpose_item<0>(A.in[20] + (size_t)l * DFF * 1024, 1024, nullptr, (bf16*)(A.ws + WS_WDN) + (size_t)l * 1024 * DFF, DFF, 0, 1024 / 64, scr, it, lane); }
__device__ __forceinline__ void wi_mid(const Args& A, LAS float* scr, int lane, int l, int it) { transpose_item<0>(A.in[17] + (size_t)l * 1024 * 1024 + 256 * 1024, 1024, nullptr, (bf16*)(A.ws + WS_WOUT) + (size_t)l * 1024 * 1024, 1024, 256, 1024 / 64, scr, it, lane); }
__device__ __forceinline__ void wi_fold(const Args& A, LAS float* scr, int lane, int l, int it) { fold_item(A.in[8] + (size_t)l * 4 * 64 * 64, A.in[9] + l * 256, A.in[16] + (size_t)l * 256 * 256, A.in[17] + (size_t)l * 1024 * 1024, (bf16*)(A.ws + WS_WOUT) + (size_t)l * 1024 * 1024, scr, it, lane); }
__device__ __forceinline__ void weight_items(const Args& A, LAS float* scr, int lane, int first, int last, int w0, int nw) {
#pragma unroll 1
    for (int idx = first + w0; idx < last; idx += nw) {
        if (idx < WI_A) wi_in(A, scr, lane, 0, idx);
        else if (idx < WI_B) { const int a = idx - WI_A; if (a < 1408) wi_gu(A, scr, lane, 0, a); else if (a < 2112) wi_dn(A, scr, lane, 0, a - 1408); else if (a < 2240) wi_mid(A, scr, lane, 0, a - 2112); else wi_fold(A, scr, lane, 0, a - 2240); }
        else if (idx < WI_C) { const int b2 = idx - WI_B; if (b2 < 576) wi_in(A, scr, lane, 1, b2); else if (b2 < 704) wi_mid(A, scr, lane, 1, b2 - 576); else wi_fold(A, scr, lane, 1, b2 - 704); }
        else { const int c2 = idx - WI_C; if (c2 < 1408) wi_gu(A, scr, lane, 1, c2); else wi_dn(A, scr, lane, 1, c2 - 1408); }
    }
}
__device__ __forceinline__ void slack_weights(const Frame& F, const Args& A, LAS unsigned char* lds, int nwg, int first, int last) {
    const int rounds = (nwg + F.G - 1) / F.G, nfull = nwg - (rounds - 1) * F.G, c = (int)blockIdx.x;
    int sl = F.lane; asm volatile("" : "+v"(sl));
    LAS float* scr = (LAS float*)(lds + F.wave * 16640);
    if (nfull >= F.G) weight_items(A, scr, sl, first, last, F.gw, F.NGW);
    else if (c >= nfull) weight_items(A, scr, sl, first, last, (c - nfull) * NWAVES + F.wave, (F.G - nfull) * NWAVES);
    __syncthreads();
}
__device__ __forceinline__ void p0_prologue(const Frame& F, const Args& A, LAS unsigned char* lds) {
    unsigned char* ws = A.ws;
    LAS float* scr = (LAS float*)(lds + F.wave * 16640);
    int lane_l = F.lane; asm volatile("" : "+v"(lane_l)); const int gw = F.gw, NGW = F.NGW, lane = lane_l;
    weight_items(A, scr, lane, 0, SLACK_W ? WI_A : WI_END, gw, NGW);
    { bf16* XB = (bf16*)(ws + WS_XB); float* SS = (float*)(ws + WS_SS);
      for (int m0 = gw * 2; m0 < MT; m0 += NGW * 2) {
        f32x4 v[2][4];
#pragma unroll
        for (int q = 0; q < 2; ++q) { const int m = m0 + q; const float* xr = (m < MP) ? A.in[0] + (size_t)m * 1024 : A.in[1] + (size_t)(m - MP) * 1024;
#pragma unroll
            for (int j = 0; j < 4; ++j) v[q][j] = __builtin_nontemporal_load((const f32x4*)xr + lane + 64 * j); }
        __builtin_amdgcn_sched_barrier(0);
#pragma unroll
        for (int q = 0; q < 2; ++q) { const int m = m0 + q; float s = 0.f;
#pragma unroll
            for (int j = 0; j < 4; ++j) { const f32x4 w = v[q][j]; s += (w.x * w.x + w.y * w.y) + (w.z * w.z + w.w * w.w);
                v2u o; o.x = pk2(w.x, w.y); o.y = pk2(w.z, w.w); *((v2u*)(XB + (size_t)m * 1024) + lane + 64 * j) = o; }
            s = wave_sum(s);
            if (lane < 16) SS[(size_t)lane * MT + m] = (lane == 0) ? s : 0.f;
            if (m >= MP && lane < 32) SS[(size_t)16 * MT + lane * 256 + (m - MP)] = (lane == 0) ? s : 0.f; }
      } }
    { float* TAB = (float*)(ws + WS_TAB);
      for (int i = gw * 64 + lane; i < 2080 * 32; i += NGW * 64) { const int pos = i >> 5, f = i & 31;
        const float inv = powf(10000.0f, -(float)f / 32.0f); const float ang = (float)pos * inv; float sv, cv; sincosf(ang, &sv, &cv);
        TAB[pos * 64 + f] = cv; TAB[pos * 64 + 32 + f] = sv; } }
    if (gw < 2) { const float* lq = A.in[10] + gw * 256; const float a = wave_sum(lq[lane] * lq[64 + lane]), b = wave_sum(lq[128 + lane] * lq[192 + lane]);
        const float lam_init = 0.8f - 0.6f * expf(-0.3f * (float)gw);
        if (lane == 0) ((float*)(ws + WS_LAM))[gw] = expf(a) - expf(b) + lam_init; }
}

__device__ __forceinline__ int crow(int r, int hi) { return (r & 3) + 8 * (r >> 2) + 4 * hi; }
__device__ __forceinline__ void sample_attn_unit(const Frame& F, const Args& A, int l, int bh, int split, LAS unsigned char* lds) {
    int lane_l = F.lane; asm volatile("" : "+v"(lane_l)); const int b = bh >> 2, h = bh & 3, lane = lane_l, wid = F.wave, r32 = lane & 31, hi = lane >> 5;
    LAS unsigned short* PL = (LAS unsigned short*)lds;
    LAS float* OX = (LAS float*)(lds + 20480);
    LAS float* MB = (LAS float*)(lds + 40960);
    LAS float* LB = MB + 256;
    const bool last = (split == 7), two = last && (wid == 7);
    const int eb = wid & 3, kh = wid >> 2, nks = (last && kh == 1) ? 10 : 8;
    const size_t cro = ((size_t)(l * 8 + b) * 2048 + split * 256) * 512 + h * 128, nro = ((size_t)(l * 8 + b) * 32) * 512 + h * 128;
    const float* Kc = A.in[2] + cro; const float* Vc = A.in[3] + cro;
    const float* Kn = A.out + O_KS + nro; const float* Vn = A.out + O_VS + nro;
    const bf16* Qrow = (const bf16*)(A.ws + WS_Q) + (size_t)(MP + b * 32 + r32) * 512 + h * 128;
    bf16x8 vfr[10];
    { float t[10][8];
#pragma unroll
      for (int ks = 0; ks < 10; ++ks)
#pragma unroll
        for (int j = 0; j < 8; ++j) { const float* vp = (ks < 8) ? Vc + (size_t)(128 * kh + 16 * ks + 8 * hi + j) * 512 : Vn + (size_t)(16 * (ks - 8) + 8 * hi + j) * 512;
            t[ks][j] = (ks < nks) ? __builtin_nontemporal_load(vp + 32 * eb + r32) : 0.f; }
      __builtin_amdgcn_sched_barrier(0);
#pragma unroll
      for (int ks = 0; ks < 10; ++ks) { v4u w; w.x = pk2(t[ks][0], t[ks][1]); w.y = pk2(t[ks][2], t[ks][3]); w.z = pk2(t[ks][4], t[ks][5]); w.w = pk2(t[ks][6], t[ks][7]); vfr[ks] = __builtin_bit_cast(bf16x8, w); }
      __builtin_amdgcn_sched_barrier(0); }
    float* SPO = (float*)(A.ws + WS_SPO); float* SPM = (float*)(A.ws + WS_SPM);
    for (int c = 0; c < 2; ++c) {
        f32x16 s[2]; s[0] = f32x16{}; s[1] = f32x16{};
        bf16x8 qf[4];
        { v2u q0[4], q1[4]; f32x4 ka[2][4], kb[2][4];
#pragma unroll
          for (int d0 = 0; d0 < 4; ++d0) { const bf16* qp = Qrow + c * 64 + 32 * (d0 & 1) + 16 * hi + 4 * (d0 >> 1); q0[d0] = *(const v2u*)qp; q1[d0] = *(const v2u*)(qp + 8);
              const float* kp = Kc + (size_t)(32 * wid + r32) * 512 + c * 64 + 16 * d0 + 8 * hi; ka[0][d0] = __builtin_nontemporal_load((const f32x4*)kp); kb[0][d0] = __builtin_nontemporal_load((const f32x4*)(kp + 4));
              const float* kn = Kn + (size_t)r32 * 512 + c * 64 + 16 * d0 + 8 * hi;
              ka[1][d0] = two ? *(const f32x4*)kn : (f32x4){0.f, 0.f, 0.f, 0.f}; kb[1][d0] = two ? *(const f32x4*)(kn + 4) : (f32x4){0.f, 0.f, 0.f, 0.f}; }
          __builtin_amdgcn_sched_barrier(0);
#pragma unroll
          for (int d0 = 0; d0 < 4; ++d0) { v4u qw; qw.x = q0[d0].x; qw.y = q0[d0].y; qw.z = q1[d0].x; qw.w = q1[d0].y; qf[d0] = __builtin_bit_cast(bf16x8, qw); }
#pragma unroll
          for (int ch = 0; ch < 2; ++ch) if (ch == 0 || two) {
#pragma unroll
              for (int d0 = 0; d0 < 4; ++d0) { v4u kw; kw.x = pk2(ka[ch][d0].x, ka[ch][d0].y); kw.y = pk2(ka[ch][d0].z, ka[ch][d0].w); kw.z = pk2(kb[ch][d0].x, kb[ch][d0].y); kw.w = pk2(kb[ch][d0].z, kb[ch][d0].w);
                  s[ch] = __builtin_amdgcn_mfma_f32_32x32x16_bf16(__builtin_bit_cast(bf16x8, kw), qf[d0], s[ch], 0, 0, 0); } } }
        float m = s[0][0];
#pragma unroll
        for (int r = 1; r < 16; ++r) m = fmaxf(m, s[0][r]);
        if (two) {
#pragma unroll
            for (int r = 0; r < 16; ++r) m = fmaxf(m, s[1][r]); }
        m = fmaxf(m, __shfl_xor(m, 32));
        if (hi == 0) MB[wid * 32 + r32] = m;
        __syncthreads();
        float M = MB[r32];
#pragma unroll
        for (int w = 1; w < 8; ++w) M = fmaxf(M, MB[w * 32 + r32]);
        float lsum = 0.f;
#pragma unroll
        for (int ch = 0; ch < 2; ++ch) if (ch == 0 || two) {
#pragma unroll
            for (int r = 0; r < 16; ++r) { s[ch][r] = __builtin_amdgcn_exp2f(s[ch][r] - M); lsum += s[ch][r]; }
            const int kbase = (ch == 0) ? 32 * wid : 256;
#pragma unroll
            for (int t = 0; t < 4; ++t) { v2u w; w.x = pk2(s[ch][4 * t], s[ch][4 * t + 1]); w.y = pk2(s[ch][4 * t + 2], s[ch][4 * t + 3]);
                *(LAS v2u*)(PL + r32 * 296 + kbase + 8 * t + 4 * hi) = w; } }
        lsum += __shfl_xor(lsum, 32);
        if (hi == 0) LB[wid * 32 + r32] = lsum;
        __syncthreads();
        f32x16 o = {};
#pragma unroll
        for (int ks = 0; ks < 10; ++ks) if (ks < nks) {
            const int key0 = (ks < 8) ? 128 * kh + 16 * ks : 256 + 16 * (ks - 8);
            const bf16x8 pf = *(const LAS bf16x8*)(PL + r32 * 296 + key0 + 8 * hi);
            o = __builtin_amdgcn_mfma_f32_32x32x16_bf16(vfr[ks], pf, o, 0, 0, 0); }
        if (kh == 1) {
#pragma unroll
            for (int r = 0; r < 16; ++r) OX[eb * 1024 + r * 64 + lane] = o[r]; }
        __syncthreads();
        if (kh == 0) { const size_t pi = ((size_t)(bh * 8 + split) * 2 + c) * 32 + r32;
#pragma unroll
            for (int t = 0; t < 4; ++t) { f32x4 v; v.x = o[4 * t] + OX[eb * 1024 + (4 * t) * 64 + lane]; v.y = o[4 * t + 1] + OX[eb * 1024 + (4 * t + 1) * 64 + lane];
                v.z = o[4 * t + 2] + OX[eb * 1024 + (4 * t + 2) * 64 + lane]; v.w = o[4 * t + 3] + OX[eb * 1024 + (4 * t + 3) * 64 + lane];
                *(f32x4*)(SPO + pi * 128 + 32 * eb + 8 * t + 4 * hi) = v; }
            if (wid == 0 && hi == 0) { float Lq = LB[r32];
#pragma unroll
                for (int w = 1; w < 8; ++w) Lq += LB[w * 32 + r32];
                SPM[pi * 2] = M; SPM[pi * 2 + 1] = Lq; } }
    }
    __syncthreads();
}

template <int NB> __device__ __forceinline__ void sample_gemm_res(const Frame& F, const bf16* Arows, int lda, const bf16* Bt, int K, bf16* XBs, float* SS, LAS unsigned char* lds) {
    int lane_l = F.lane; asm volatile("" : "+v"(lane_l));
    const int lane = lane_l, ks = F.wave, r32 = lane & 31, hi = lane >> 5, rt = F.vcu >> 5, ct = F.vcu & 31;
    const int Kw = K >> 3, nst = Kw >> 4;
    const bf16* ap = Arows + (size_t)(32 * rt + r32) * lda + ks * Kw + 8 * hi;
    const bf16* bp = Bt + (size_t)(32 * ct + r32) * K + ks * Kw + 8 * hi;
    f32x16 acc = {};
#pragma unroll 1
    for (int s0 = 0; s0 < nst; s0 += NB) {
        bf16x8 a[NB], b[NB];
#pragma unroll
        for (int i = 0; i < NB; ++i) { a[i] = *(const bf16x8*)(ap + 16 * (s0 + i)); b[i] = *(const bf16x8*)(bp + 16 * (s0 + i)); }
        __builtin_amdgcn_sched_barrier(0);
#pragma unroll
        for (int i = 0; i < NB; ++i) acc = __builtin_amdgcn_mfma_f32_32x32x16_bf16(a[i], b[i], acc, 0, 0, 0);
        __builtin_amdgcn_sched_barrier(0);
    }
    LAS float* RED = (LAS float*)lds;
    LAS float* SSQ = (LAS float*)(lds + 32768);
    if (ks > 0) {
#pragma unroll
        for (int r = 0; r < 16; ++r) RED[(ks - 1) * 1024 + r * 64 + lane] = acc[r]; }
    __syncthreads();
    if (ks == 0) {
        float v[16]; unsigned xo[16];
#pragma unroll
        for (int r = 0; r < 16; ++r) { float t = acc[r];
#pragma unroll
            for (int w = 0; w < 7; ++w) t += RED[w * 1024 + r * 64 + lane];
            v[r] = t; xo[r] = (unsigned)XBs[(unsigned)(32 * rt + crow(r, hi)) * 1024 + 32 * ct + r32]; }
        __builtin_amdgcn_sched_barrier(0);
#pragma unroll
        for (int r = 0; r < 16; ++r) { const float x = v[r] + bflo(xo[r]);
            XBs[(unsigned)(32 * rt + crow(r, hi)) * 1024 + 32 * ct + r32] = (bf16)f2bf(x);
            SSQ[crow(r, hi) * 33 + r32] = x * x; }
    }
    __syncthreads();
    if (ks == 0 && lane < 32) { float s = 0.f;
#pragma unroll
        for (int c2 = 0; c2 < 32; ++c2) s += SSQ[lane * 33 + c2];
        SS[(size_t)16 * MT + ct * 256 + 32 * rt + lane] = s; }
    __syncthreads();
}

__device__ __forceinline__ void conv_item_fast(const Args& A, int l, int item, int lane) {
    const int row0 = item * 8; const bool smp = row0 >= MP;
    const int b = smp ? (row0 - MP) >> 5 : row0 >> 11, t0 = smp ? (row0 - MP) & 31 : row0 & 2047, L = smp ? 32 : 2048;
    const bf16* UC = (const bf16*)(A.ws + WS_UC) + (size_t)(row0 - t0) * 256 + 4 * lane;
    const float* dw = A.in[12] + (size_t)l * 31 * 256 + 4 * lane;
    v2u P[38];
#pragma unroll
    for (int s = 0; s < 38; ++s) { const int tt = t0 - 30 + s; P[s] = (v2u){0u, 0u}; if (tt >= 0) P[s] = *(const v2u*)(UC + (size_t)tt * 256); }
    f32x4 acc[8];
#pragma unroll
    for (int i = 0; i < 8; ++i) acc[i] = (f32x4){0.f, 0.f, 0.f, 0.f};
    f32x4 R[8];
#pragma unroll
    for (int i = 0; i < 7; ++i) { const v2u w = P[i]; R[i] = (f32x4){bflo(w.x), bfhi(w.x), bflo(w.y), bfhi(w.y)}; }
#pragma unroll
    for (int j = 0; j < 31; ++j) { const f32x4 wv = *(const f32x4*)(dw + j * 256);
        { const v2u w = P[7 + j]; R[7] = (f32x4){bflo(w.x), bfhi(w.x), bflo(w.y), bfhi(w.y)}; }
#pragma unroll
        for (int i = 0; i < 8; ++i) acc[i] += wv * R[i];
#pragma unroll
        for (int i = 0; i < 7; ++i) R[i] = R[i + 1];
        __builtin_amdgcn_sched_barrier(0); }
    if (t0 + 7 >= L - 30) { float* cout = A.out + (smp ? O_CS : O_CP) + ((size_t)(l * 8 + b) * 30) * 256 + 4 * lane;
#pragma unroll
        for (int i = 0; i < 8; ++i) { const int tq = t0 + i; const v2u w = P[30 + i]; if (tq >= L - 30) *(f32x4*)(cout + (size_t)(tq - (L - 30)) * 256) = (f32x4){bflo(w.x), bfhi(w.x), bflo(w.y), bfhi(w.y)}; } }
    const f32x4 bias = *(const f32x4*)(A.in[13] + l * 256 + 4 * lane), lg = *(const f32x4*)(A.in[14] + l * 256 + 4 * lane), lb = *(const f32x4*)(A.in[15] + l * 256 + 4 * lane);
    bf16* MIX = (bf16*)(A.ws + WS_MIX) + (size_t)row0 * 1024 + 768 + 4 * lane;
#pragma unroll
    for (int i = 0; i < 8; ++i) { f32x4 y = acc[i] + bias;
        const float mu = wave_sum((y.x + y.y) + (y.z + y.w)) * (1.0f / 256.0f); y = y - mu;
        const float var = wave_sum((y.x * y.x + y.y * y.y) + (y.z * y.z + y.w * y.w)) * (1.0f / 256.0f);
        const float rs = rsqrtf(var + 1e-6f); y = y * rs * lg + lb; y = y * pg8::sigm4(y);
        v2u o; o.x = pk2(y.x, y.y); o.y = pk2(y.z, y.w); *(v2u*)(MIX + (size_t)i * 1024) = o; }
}
__device__ __forceinline__ void conv_item(const Args& A, int l, int item, int lane) {
    const int row0 = item * 8; const bool smp = row0 >= MP;
    const int b = smp ? (row0 - MP) >> 5 : row0 >> 11, t0 = smp ? (row0 - MP) & 31 : row0 & 2047, L = smp ? 32 : 2048;
    const bf16* UC = (const bf16*)(A.ws + WS_UC) + (size_t)(row0 - t0) * 256 + 4 * lane;
    const float* hist = A.in[5] + ((size_t)(l * 8 + b) * 30) * 256 + 4 * lane;
    const float* dw = A.in[12] + (size_t)l * 31 * 256 + 4 * lane;
    f32x4 acc[8], R[8];
#pragma unroll
    for (int i = 0; i < 8; ++i) acc[i] = (f32x4){0.f, 0.f, 0.f, 0.f};
    float* cout = A.out + (smp ? O_CS : O_CP) + ((size_t)(l * 8 + b) * 30) * 256 + 4 * lane;
#define CONV_ROW(dst, tt_) do { const int tt = (tt_); const int ttc = tt < 0 ? 0 : tt; \
        const v2u w_ = *(const v2u*)(UC + (size_t)ttc * 256); f32x4 rv_ = (f32x4){bflo(w_.x), bfhi(w_.x), bflo(w_.y), bfhi(w_.y)}; \
        if (tt < 0) rv_ = (f32x4){0.f, 0.f, 0.f, 0.f}; dst = rv_; } while (0)
#define CONV_HIST(dst, tt_) do { const int tt = (tt_); int hr = 30 + tt; hr = hr < 0 ? 0 : (hr > 29 ? 29 : hr); const f32x4 hv_ = *(const f32x4*)(hist + (size_t)hr * 256); if (tt < 0) dst = hv_; } while (0)
#pragma unroll
    for (int i = 0; i < 7; ++i) CONV_ROW(R[i], t0 - 30 + i);
    if (smp) {
#pragma unroll
        for (int i = 0; i < 7; ++i) CONV_HIST(R[i], t0 - 30 + i); }
#pragma unroll 1
    for (int jb = 0; jb < 32; jb += 8) {
        f32x4 N[8], Wt[8];
#pragma unroll
        for (int jj = 0; jj < 8; ++jj) { const int j = jb + jj; int tt2 = t0 - 23 + j; if (tt2 > L - 1) tt2 = L - 1; CONV_ROW(N[jj], tt2);
            const int jc = j < 31 ? j : 30; Wt[jj] = *(const f32x4*)(dw + jc * 256); if (j >= 31) Wt[jj] = (f32x4){0.f, 0.f, 0.f, 0.f}; }
        if (smp && t0 - 23 + jb < 0) {
#pragma unroll
            for (int jj = 0; jj < 8; ++jj) CONV_HIST(N[jj], t0 - 23 + jb + jj); }
        __builtin_amdgcn_sched_barrier(0);
#pragma unroll
        for (int jj = 0; jj < 8; ++jj) { const int j = jb + jj; R[7] = N[jj];
            if (j >= 23 && j < 31) { const int tq = t0 + (j - 23); if (tq >= L - 30) *(f32x4*)(cout + (size_t)(tq - (L - 30)) * 256) = R[7]; }
#pragma unroll
            for (int i = 0; i < 8; ++i) acc[i] += Wt[jj] * R[i];
#pragma unroll
            for (int i = 0; i < 7; ++i) R[i] = R[i + 1]; }
    }
#undef CONV_HIST
#undef CONV_ROW
    const f32x4 bias = *(const f32x4*)(A.in[13] + l * 256 + 4 * lane), lg = *(const f32x4*)(A.in[14] + l * 256 + 4 * lane), lb = *(const f32x4*)(A.in[15] + l * 256 + 4 * lane);
    bf16* MIX = (bf16*)(A.ws + WS_MIX) + (size_t)row0 * 1024 + 768 + 4 * lane;
#pragma unroll
    for (int i = 0; i < 8; ++i) { f32x4 y = acc[i] + bias;
        const float mu = wave_sum((y.x + y.y) + (y.z + y.w)) * (1.0f / 256.0f); y = y - mu;
        const float var = wave_sum((y.x * y.x + y.y * y.y) + (y.z * y.z + y.w * y.w)) * (1.0f / 256.0f);
        const float rs = rsqrtf(var + 1e-6f); y = y * rs * lg + lb; y = y * pg8::sigm4(y);
        v2u o; o.x = pk2(y.x, y.y); o.y = pk2(y.z, y.w); *(v2u*)(MIX + (size_t)i * 1024) = o; }
}
__device__ __forceinline__ void pool_item(const Args& A, int l, int item, int lane) {
    const int row = item * 2 + (lane >> 5), c0 = (lane & 31) * 8, g = c0 >> 6, w = 2 << g;
    const bool smp = row >= MP; const int b = smp ? (row - MP) >> 5 : row >> 11, t = smp ? (row - MP) & 31 : row & 2047, L = smp ? 32 : 2048;
    const bf16* UP = (const bf16*)(A.ws + WS_UP) + (size_t)(row - t) * 256 + c0;
    const float* hist = A.in[4] + ((size_t)(l * 8 + b) * 15) * 256 + c0;
    float sum[8], own[8];
    v4u pv[16];
#pragma unroll
    for (int jj = 0; jj < 16; ++jj) { const int tt = t - jj; pv[jj] = (v4u){0u, 0u, 0u, 0u}; if (jj < w && tt >= 0) pv[jj] = *(const v4u*)(UP + (size_t)tt * 256); }
    __builtin_amdgcn_sched_barrier(0);
#pragma unroll
    for (int i = 0; i < 8; ++i) sum[i] = 0.f;
#pragma unroll
    for (int jj = 0; jj < 16; ++jj) { const v4u v = pv[jj];
        const float fv[8] = {bflo(v.x), bfhi(v.x), bflo(v.y), bfhi(v.y), bflo(v.z), bfhi(v.z), bflo(v.w), bfhi(v.w)};
#pragma unroll
        for (int i = 0; i < 8; ++i) { sum[i] += fv[i]; if (jj == 0) own[i] = fv[i]; } }
    if (smp && t < w - 1) { for (int jj = t + 1; jj < w; ++jj) { const int tt = t - jj;
            const f32x4 a = *(const f32x4*)(hist + (size_t)(15 + tt) * 256), bq = *(const f32x4*)(hist + (size_t)(15 + tt) * 256 + 4);
            sum[0] += a.x; sum[1] += a.y; sum[2] += a.z; sum[3] += a.w; sum[4] += bq.x; sum[5] += bq.y; sum[6] += bq.z; sum[7] += bq.w; } }
    const int cnt = smp ? w : ((t + 1 < w) ? t + 1 : w); const float ic = 1.0f / (float)cnt;
    v4u o; o.x = pk2(sum[0] * ic - own[0], sum[1] * ic - own[1]); o.y = pk2(sum[2] * ic - own[2], sum[3] * ic - own[3]);
    o.z = pk2(sum[4] * ic - own[4], sum[5] * ic - own[5]); o.w = pk2(sum[6] * ic - own[6], sum[7] * ic - own[7]);
    *(v4u*)((bf16*)(A.ws + WS_MIX) + (size_t)row * 1024 + c0) = o;
    if (t >= L - 15) { float* po = A.out + (smp ? O_PS : O_PP) + ((size_t)(l * 8 + b) * 15 + (t - (L - 15))) * 256 + c0;
        *(f32x4*)po = (f32x4){own[0], own[1], own[2], own[3]}; *(f32x4*)(po + 4) = (f32x4){own[4], own[5], own[6], own[7]}; }
}
__device__ __forceinline__ void post_item(const Args& A, int l, int row0, int lane, float lam, float osc) {
    const int h = lane >> 4, e = (lane & 15) * 8;
    const bf16* O4 = (const bf16*)(A.ws + WS_O4) + (size_t)row0 * 1024 + h * 256 + e;
    v4u a[4], bq[4];
#pragma unroll
    for (int i = 0; i < 4; ++i) { a[i] = *(const v4u*)(O4 + (size_t)i * 1024); bq[i] = *(const v4u*)(O4 + (size_t)i * 1024 + 128); }
    __builtin_amdgcn_sched_barrier(0);
    const f32x4 g0 = *(const f32x4*)(A.in[11] + l * 128 + e), g1 = *(const f32x4*)(A.in[11] + l * 128 + e + 4);
#pragma unroll
    for (int i = 0; i < 4; ++i) {
        float o[8] = {bflo(a[i].x) - lam * bflo(bq[i].x), bfhi(a[i].x) - lam * bfhi(bq[i].x), bflo(a[i].y) - lam * bflo(bq[i].y), bfhi(a[i].y) - lam * bfhi(bq[i].y),
                      bflo(a[i].z) - lam * bflo(bq[i].z), bfhi(a[i].z) - lam * bfhi(bq[i].z), bflo(a[i].w) - lam * bflo(bq[i].w), bfhi(a[i].w) - lam * bfhi(bq[i].w)};
        float ss = 0.f;
#pragma unroll
        for (int k = 0; k < 8; ++k) ss += o[k] * o[k];
        ss += __shfl_xor(ss, 1); ss += __shfl_xor(ss, 2); ss += __shfl_xor(ss, 4); ss += __shfl_xor(ss, 8);
        const float rs = rsqrtf(ss * (1.0f / 128.0f) + 1e-6f) * osc;
        v4u w; w.x = pk2(o[0] * rs * g0.x, o[1] * rs * g0.y); w.y = pk2(o[2] * rs * g0.z, o[3] * rs * g0.w); w.z = pk2(o[4] * rs * g1.x, o[5] * rs * g1.y); w.w = pk2(o[6] * rs * g1.z, o[7] * rs * g1.w);
        *(v4u*)((bf16*)(A.ws + WS_MIX) + (size_t)(row0 + i) * 1024 + 256 + h * 128 + e) = w; }
}
__device__ __forceinline__ void scomb_item(const Args& A, int l, int item, int lane, float lam, float osc) {
    const int rs_ = item >> 2, h = item & 3, b = rs_ >> 5, q = rs_ & 31, bh = b * 4 + h;
    const float* SPO = (const float*)(A.ws + WS_SPO); const float* SPM = (const float*)(A.ws + WS_SPM);
    float oc[2][2];
#pragma unroll
    for (int c = 0; c < 2; ++c) {
        typedef float f32x2t __attribute__((ext_vector_type(2)));
        f32x2t ml[8], ov[8];
#pragma unroll
        for (int s = 0; s < 8; ++s) { const size_t pi = ((size_t)(bh * 8 + s) * 2 + c) * 32 + q; ml[s] = *(const f32x2t*)(SPM + pi * 2); ov[s] = *(const f32x2t*)(SPO + pi * 128 + 2 * lane); }
        __builtin_amdgcn_sched_barrier(0);
        float M = ml[0].x;
#pragma unroll
        for (int s = 1; s < 8; ++s) M = fmaxf(M, ml[s].x);
        float Ls = 0.f, o0 = 0.f, o1 = 0.f;
#pragma unroll
        for (int s = 0; s < 8; ++s) { const float wgt = __builtin_amdgcn_exp2f(ml[s].x - M); Ls += wgt * ml[s].y; o0 += wgt * ov[s].x; o1 += wgt * ov[s].y; }
        const float il = 1.0f / Ls; oc[c][0] = o0 * il; oc[c][1] = o1 * il; }
    const float x0 = oc[0][0] - lam * oc[1][0], x1 = oc[0][1] - lam * oc[1][1];
    const float ss = wave_sum(x0 * x0 + x1 * x1); const float rs = rsqrtf(ss * (1.0f / 128.0f) + 1e-6f) * osc;
    const float* g = A.in[11] + l * 128 + 2 * lane;
    *(unsigned*)((bf16*)(A.ws + WS_MIX) + (size_t)(MP + rs_) * 1024 + 256 + h * 128 + 2 * lane) = pk2(x0 * rs * g[0], x1 * rs * g[1]);
}

__global__ void __launch_bounds__(NWAVES * 64, 2) mk_fwd(Args args) {
    extern __shared__ __attribute__((aligned(16))) unsigned char lds_raw[];
    LAS unsigned char* lds = (LAS unsigned char*)lds_raw;
    Frame F; F.tid = threadIdx.x; F.lane = F.tid & 63; F.wave = __builtin_amdgcn_readfirstlane(F.tid >> 6);
    F.G = gridDim.x; { const int bx = blockIdx.x; F.vcu = (F.G % 8 == 0) ? (bx % 8) * (F.G / 8) + bx / 8 : bx; }
    F.gw = F.vcu * NWAVES + F.wave; F.NGW = F.G * NWAVES;
    unsigned char* ws = args.ws;
    const int lo = args.ph_lo, hi = args.ph_hi;
#define IN(k) (lo <= (k) && (k) < hi)
#define SEAM(k) do { if (IN(k) && IN((k) + 1)) { xcd_barrier(bar); } } while (0)
    for (int u = F.tid; u < 64; u += NWAVES * 64) ((LAS unsigned*)(lds + MISC_OFF))[u] = 0u;
    __syncthreads();
    XcdBarrier bar; bar.bar = (unsigned*)ws; bar.x = 0; bar.st = nullptr;
    if (!MK_MULTI) bar = xcd_barrier_post((unsigned*)ws, (volatile LAS unsigned*)(lds + MISC_OFF) + 8);
    #ifndef REP_PRO
#define REP_PRO 1
#endif
#ifndef REP_INP
#define REP_INP 1
#endif
#ifndef REP_ATT
#define REP_ATT 1
#endif
#ifndef REP_MIX
#define REP_MIX 1
#endif
#ifndef REP_GU
#define REP_GU 1
#endif
    if (!MK_MULTI && lo < 0) cg::this_grid().sync();
    if (IN(0)) { for (int rep = 0; rep < REP_PRO; ++rep) { p0_prologue(F, args, lds); __syncthreads(); } }
    SEAM(0);
    for (int rep = 0; rep < REP_SYNC; ++rep) xcd_barrier(bar);
    float* X = args.out + O_Y;
    bf16* XB = (bf16*)(ws + WS_XB); float* SS = (float*)(ws + WS_SS);
#pragma unroll 1
    for (int l = 0; l < 2; ++l) {
        const int pb = 1 + 6 * l;
        if (IN(pb)) for (int rep = 0; rep < REP_INP; ++rep) {
            pg8::Gemm g{XB, (const bf16*)(ws + WS_WIN) + (size_t)l * INW * 1024, MT, INW, 1024}; pg8::StaticOrder S; S.init(MT, INW, F.G, (int)blockIdx.x);
            pg8::EpiInProj E{SS, (const float*)(ws + WS_TAB), (bf16*)(ws + WS_UP), (bf16*)(ws + WS_Q), (bf16*)(ws + WS_K), (bf16*)(ws + WS_V), (bf16*)(ws + WS_UC),
                args.out + O_KP + (size_t)l * 8 * 2048 * 512, args.out + O_KS + (size_t)l * 8 * 32 * 512, args.out + O_VP + (size_t)l * 8 * 2048 * 512, args.out + O_VS + (size_t)l * 8 * 32 * 512};
            pg8::gemm_phase<pg8::EpiInProj, pg8::StaticOrder, PG8_ALIGN, PG8_SP2>(lds, g, S, E);
            if (SLACK_W && rep == 0) { if (l == 0) slack_weights(F, args, lds, (MT / 256) * (INW / 256), WI_A, WI_B); else slack_weights(F, args, lds, (MT / 256) * (INW / 256), WI_C, WI_END); }
        }
        SEAM(pb);
        if (IN(pb + 1)) for (int rep = 0; rep < REP_ATT; ++rep) {
            const int bh = F.vcu >> 3, jj = F.vcu & 7, a = jj & 3, c = jj >> 2, b = bh >> 2, h = bh & 3;
            const attn_body::bf16* Qp = (const attn_body::bf16*)(ws + WS_Q); const attn_body::bf16* Kp = (const attn_body::bf16*)(ws + WS_K); const attn_body::bf16* Vp = (const attn_body::bf16*)(ws + WS_V);
            attn_body::bf16* Op = (attn_body::bf16*)(ws + WS_O4);
            const int spos = F.vcu % 5;
#pragma unroll 1
            for (int i = 0; i < 5; ++i) {
                if (i == spos) { sample_attn_unit(F, args, l, F.vcu >> 3, F.vcu & 7, lds); }
                else { const int k = i - (i > spos ? 1 : 0); const int vh = k >> 1, qb = (k & 1) ? 7 - a : a;
                    attn_body::attn_unit<8>(b, 2 * h + c, 2 * h + vh, qb, Qp, Kp, Vp, Op, h * 256 + c * 128 + vh * 64, (char*)lds_raw); __syncthreads(); }
            }
        }
        SEAM(pb + 1);
        if (IN(pb + 2)) for (int rep = 0; rep < REP_MIX; ++rep) {
            int mlane = F.lane; asm volatile("" : "+v"(mlane));
            const float lam = ((const float*)(ws + WS_LAM))[l]; const float osc = 1.0f - (0.8f - 0.6f * expf(-0.3f * (float)l));
            const bool heavy = (F.NGW == 2048) && ((F.gw & 63) == 0);
            const int lgw = (F.NGW == 2048) ? F.gw - ((F.gw + 63) >> 6) : F.gw, lng = (F.NGW == 2048) ? 2016 : F.NGW;
#pragma unroll 1
            for (int k = 0; k < 2; ++k) { if (k == 1 && !heavy) break; conv_item(args, l, k == 0 ? F.gw : MP / 8 + (F.gw >> 6), mlane); }
            if (!heavy) {
            for (int it = lgw; it < MT / 2; it += lng) pool_item(args, l, it, mlane);
            for (int it = lgw; it < MP / 4; it += lng) post_item(args, l, it * 4, mlane, lam, osc);
            for (int it = lgw; it < 1024; it += lng) scomb_item(args, l, it, mlane, lam, osc);
            }
        }
        SEAM(pb + 2);
#ifndef REP_OUT0
#define REP_OUT0 1
#endif
#ifndef REP_SYNC
#define REP_SYNC 0
#endif
#ifndef REP_FOLD
#define REP_FOLD 1
#endif
#ifndef REP_SLACK
#define REP_SLACK 1
#endif
#ifndef SLACK_W
#define SLACK_W 1
#endif
        if (IN(pb + 3)) for (int rep = 0; rep < (l == 0 ? REP_OUT0 : 1); ++rep) {
            pg8::Gemm g{(const bf16*)(ws + WS_MIX), (const bf16*)(ws + WS_WOUT) + (size_t)l * 1024 * 1024, MP, 1024, 1024}; pg8::StaticOrder S; S.init(MP, 1024, F.G, (int)blockIdx.x);
            pg8::EpiRes E{XB, SS, 0};
            pg8::gemm_phase<pg8::EpiRes, pg8::StaticOrder, PG8_ALIGN, PG8_SP2>(lds, g, S, E);
            sample_gemm_res<8>(F, (const bf16*)(ws + WS_MIX) + (size_t)MP * 1024, 1024, (const bf16*)(ws + WS_WOUT) + (size_t)l * 1024 * 1024, 1024, XB + (size_t)MP * 1024, SS, lds);
        }
        SEAM(pb + 3);
        if (IN(pb + 4)) for (int rep = 0; rep < REP_GU; ++rep) {
            pg8::Gemm g{XB, (const bf16*)(ws + WS_WGU) + (size_t)l * 2 * DFF * 1024, MT, 2 * DFF, 1024}; pg8::StaticOrder S; S.init(MT, 2 * DFF, F.G, (int)blockIdx.x);
            pg8::EpiSwiGLU E{(bf16*)(ws + WS_H), SS};
            pg8::gemm_phase<pg8::EpiSwiGLU, pg8::StaticOrder, PG8_ALIGN, PG8_SP2>(lds, g, S, E);
            if (SLACK_W && rep == 0 && l == 0) slack_weights(F, args, lds, (MT / 256) * (2 * DFF / 256), WI_B, WI_C);
        }
        SEAM(pb + 4);
#ifndef REP_DN
#define REP_DN 1
#endif
        if (IN(pb + 5)) for (int rep = 0; rep < REP_DN; ++rep) {
            pg8::Gemm g{(const bf16*)(ws + WS_H), (const bf16*)(ws + WS_WDN) + (size_t)l * 1024 * DFF, MP, 1024, DFF}; pg8::StaticOrder S; S.init(MP, 1024, F.G, (int)blockIdx.x);
            pg8::EpiRes E{XB, SS, rep < REP_DN - 1};
            pg8::gemm_phase<pg8::EpiRes, pg8::StaticOrder, PG8_ALIGN, PG8_SP2>(lds, g, S, E);
            if (rep == REP_DN - 1) sample_gemm_res<11>(F, (const bf16*)(ws + WS_H) + (size_t)MP * DFF, DFF, (const bf16*)(ws + WS_WDN) + (size_t)l * 1024 * DFF, DFF, XB + (size_t)MP * 1024, SS, lds);
        }
        SEAM(pb + 5);
    }
#ifndef REP_FIN
#define REP_FIN 1
#endif
    if (IN(13)) for (int rep = 0; rep < REP_FIN; ++rep) {
        const float* gf = args.in[21]; int flane = F.lane; asm volatile("" : "+v"(flane));
        for (int m0 = F.gw * 2; m0 < MT; m0 += F.NGW * 2) {
            v4u w[2][2];
#pragma unroll
            for (int q = 0; q < 2; ++q)
#pragma unroll
                for (int j = 0; j < 2; ++j) w[q][j] = *((const v4u*)(XB + (size_t)(m0 + q) * 1024) + flane + 64 * j);
            __builtin_amdgcn_sched_barrier(0);
#pragma unroll
            for (int q = 0; q < 2; ++q) { float v[2][8]; float s = 0.f;
#pragma unroll
                for (int j = 0; j < 2; ++j) { const v4u ww = w[q][j]; v[j][0] = bflo(ww.x); v[j][1] = bfhi(ww.x); v[j][2] = bflo(ww.y); v[j][3] = bfhi(ww.y); v[j][4] = bflo(ww.z); v[j][5] = bfhi(ww.z); v[j][6] = bflo(ww.w); v[j][7] = bfhi(ww.w);
#pragma unroll
                    for (int k = 0; k < 8; ++k) s += v[j][k] * v[j][k]; }
                const float r = rsqrtf(wave_sum(s) * (1.0f / 1024.0f) + 1e-6f);
#pragma unroll
                for (int j = 0; j < 2; ++j) { const f32x4 g0 = *((const f32x4*)gf + 2 * (flane + 64 * j)), g1 = *((const f32x4*)gf + 2 * (flane + 64 * j) + 1);
                    f32x4* yo = (f32x4*)(X + (size_t)(m0 + q) * 1024) + 2 * (flane + 64 * j);
                    yo[0] = (f32x4){v[j][0] * r * g0.x, v[j][1] * r * g0.y, v[j][2] * r * g0.z, v[j][3] * r * g0.w};
                    yo[1] = (f32x4){v[j][4] * r * g1.x, v[j][5] * r * g1.y, v[j][6] * r * g1.z, v[j][7] * r * g1.w}; } } }
    }
#undef IN
#undef SEAM
}

extern "C" void kernel_launch(void* const* d_in, const int* in_sizes, int n_in, void* d_out, int out_size, void* d_ws, size_t ws_size, hipStream_t stream) {
    static int grid = 0;
    if (grid == 0) {
        if (n_in != 22 || out_size != (int)O_END || ws_size < WS_END) { fprintf(stderr, "kernel_launch: unexpected shapes (n_in %d out %d ws %zu)\n", n_in, out_size, ws_size); grid = -1; return; }
        int dev = 0, cus = 0, per_cu = 0;
        hipGetDevice(&dev); hipDeviceGetAttribute(&cus, hipDeviceAttributeMultiprocessorCount, dev);
        if (hipFuncSetAttribute((const void*)mk_fwd, hipFuncAttributeMaxDynamicSharedMemorySize, LDS_BYTES) != hipSuccess) { fprintf(stderr, "kernel_launch: hipFuncSetAttribute failed\n"); grid = -1; return; }
        hipOccupancyMaxActiveBlocksPerMultiprocessor(&per_cu, (const void*)mk_fwd, NWAVES * 64, LDS_BYTES);
        (void)hipGetLastError();
        if (per_cu < 1) { fprintf(stderr, "kernel_launch: occupancy query says %d blocks per CU\n", per_cu); per_cu = 1; }
        grid = cus;
        if (grid > 256) grid = 256;
    }
    if (grid < 0) return;
    if (hipMemsetAsync(d_ws, 0, 65536, stream) != hipSuccess) { fprintf(stderr, "kernel_launch: memset failed\n"); return; }
    Args a{};
    for (int i = 0; i < 22; ++i) a.in[i] = (const float*)d_in[i];
    a.out = (float*)d_out; a.ws = (unsigned char*)d_ws;
#if MK_MULTI
    for (int p = 0; p < NPH; ++p) { a.ph_lo = p; a.ph_hi = p + 1; hipLaunchKernelGGL(mk_fwd, dim3(grid), dim3(NWAVES * 64), LDS_BYTES, stream, a); }
#else
    a.ph_lo = 0; a.ph_hi = NPH;
    void* kargs[] = {&a};
    hipError_t e = hipLaunchCooperativeKernel((const void*)mk_fwd, dim3(grid), dim3(NWAVES * 64), kargs, LDS_BYTES, stream);
    if (e != hipSuccess) fprintf(stderr, "kernel_launch: cooperative launch failed: %s (grid %d)\n", hipGetErrorString(e), grid);
#endif
}
```

```cpp
#define MK_MULTI 0
#include <hip/hip_runtime.h>
#include <hip/hip_cooperative_groups.h>
#include <cstdio>
#include <cstdint>
namespace cg = cooperative_groups;
namespace pg8 {
#define PG8_LAS __attribute__((address_space(3)))
typedef unsigned short bf16_t;
typedef short bf16x8 __attribute__((ext_vector_type(8)));
typedef float f32x4 __attribute__((ext_vector_type(4)));
typedef unsigned u32x4 __attribute__((ext_vector_type(4)));
constexpr int BM = 256, BK = 64, HALF = 128, HTB = HALF * BK * 2  , STAGE_BYTES = 8 * HTB, NXCD = 8, WGM = 4;

__host__ __device__ __forceinline__ int lds_byte(int r, int c) { const int st = (r >> 4) * 2 + (c >> 5), rr = r & 15, cc = c & 31, ob = rr * 64 + cc * 2; return st * 1024 + (ob ^ (((ob >> 9) & 1) << 5)); }
__host__ __device__ __forceinline__ void stage_rc(int b, int& R, int& C) { const int st = b / 1024, sb = b % 1024, swz = sb ^ (((sb >> 9) & 1) << 5); R = (st >> 1) * 16 + swz / 64; C = (st & 1) * 32 + (swz % 64) / 2; }
__host__ __device__ __forceinline__ int perm32(int rho) { const int n = rho >> 4, i = rho & 15; return 8 * (i >> 2) + 4 * n + (i & 3); }

struct Unit { int pm, pn; };
struct Gemm { const bf16_t* A; const bf16_t* Bt; int M, N, K; };

struct StaticOrder {
    int nM, nN, nwg, G, c;
    __host__ __device__ void init(int M, int N, int G_, int c_) { nM = M / BM; nN = N / BM; nwg = nM * nN; G = G_; c = c_; }
    __host__ __device__ bool next(int i, Unit& u) const {
        const long L = (long)i * G + c; if (L >= nwg) return false;
        int wgid = (int)L; { const int q = nwg / NXCD, r = nwg % NXCD, xcd = wgid % NXCD, off = wgid / NXCD; wgid = (xcd < r ? xcd * (q + 1) : r * (q + 1) + (xcd - r) * q) + off; }
        const int nig = WGM * nN, gid = wgid / nig, fm = gid * WGM, gsz = (nM - fm) < WGM ? (nM - fm) : WGM;
        u.pm = fm + ((wgid % nig) % gsz); u.pn = (wgid % nig) / gsz; return true;
    }
    __device__ __forceinline__ void a_ready(const Unit&) const {}
    __device__ __forceinline__ void done(const Unit&) const {}
};

__device__ __forceinline__ unsigned cvt_pk_bf16(float lo, float hi) { unsigned r; asm volatile("v_cvt_pk_bf16_f32 %0, %1, %2" : "=v"(r) : "v"(lo), "v"(hi)); return r; }
typedef float f32x2 __attribute__((ext_vector_type(2)));
template <class Epi, class Sched, bool ALIGN_EPI = false, bool SP2 = false>
__device__ __forceinline__ void gemm_phase(PG8_LAS unsigned char* lds, const Gemm g, const Sched& S, const Epi& E) {
    int tid_l = threadIdx.x; asm volatile("" : "+v"(tid_l));
    const int tid = tid_l, wid = __builtin_amdgcn_readfirstlane(tid >> 6), lane = tid & 63, wr = wid >> 2, wc = wid & 3, fr = lane & 15, fq = lane >> 4;
    const int K = g.K, nt = K / BK;
    unsigned voffA[2], voffB[2];
#pragma unroll
    for (int i = 0; i < 2; ++i) { int R, C; stage_rc(tid * 16 + i * 8192, R, C); const int Rb = Epi::PERM ? ((R & ~31) + perm32(R & 31)) : R;
        voffA[i] = (unsigned)(R * K + C) * 2u; voffB[i] = (unsigned)(Rb * K + C) * 2u; }
    const size_t kstep = (size_t)(BK * 2);
    const size_t hstep = (size_t)HALF * K * 2;
    const size_t tstep = 2 * hstep;
    const unsigned ldsw = (unsigned)wid * 1024u;
    const int aoff = lds_byte(wr * 64 + fr, fq * 8), boff = lds_byte(wc * 32 + fr, fq * 8);
#define PG8_SA(b, h) (((b) * 2 + (h)) * HTB)
#define PG8_SB(b, h) ((4 + (b) * 2 + (h)) * HTB)
#define PG8_STAGE(bufoff, gbase, voff) do { _Pragma("unroll") for (int _i = 0; _i < 2; ++_i) \
        __builtin_amdgcn_global_load_lds((const unsigned*)((const char*)(gbase) + (voff)[_i]), (PG8_LAS unsigned*)(lds + (bufoff) + ldsw + _i * 8192), 16, 0, 0); } while (0)
#define PG8_LDA(dst, b, h) do { _Pragma("unroll") for (int m = 0; m < 4; ++m) _Pragma("unroll") for (int k = 0; k < 2; ++k) dst[m][k] = *(const PG8_LAS bf16x8*)(lds + PG8_SA(b, h) + aoff + m * 2048 + k * 1024); } while (0)
#define PG8_LDB(dst, b, h) do { _Pragma("unroll") for (int n = 0; n < 2; ++n) _Pragma("unroll") for (int k = 0; k < 2; ++k) dst[n][k] = *(const PG8_LAS bf16x8*)(lds + PG8_SB(b, h) + boff + n * 2048 + k * 1024); } while (0)
#define PG8_MMA(ai, bj, At, Bt) do { __builtin_amdgcn_s_setprio(1); _Pragma("unroll") for (int m = 0; m < 4; ++m) _Pragma("unroll") for (int n = 0; n < 2; ++n) _Pragma("unroll") for (int k = 0; k < 2; ++k) \
        acc[ai][bj][m][n] = __builtin_amdgcn_mfma_f32_16x16x32_bf16(Bt[n][k], At[m][k], acc[ai][bj][m][n], 0, 0, 0); __builtin_amdgcn_s_setprio(0); } while (0)
#define PG8_WAIT_V(n) asm volatile("s_waitcnt vmcnt(" #n ")" ::: "memory")
#define PG8_WAIT_L(n) asm volatile("s_waitcnt lgkmcnt(" #n ")" ::: "memory")
#define PG8_BAR __builtin_amdgcn_s_barrier()
#define PG8_SCHED __builtin_amdgcn_sched_barrier(0)
    Unit cur, nxt; int ui = 0;
    if (!S.next(0, cur)) return;
    f32x4 acc[2][2][4][2];
#pragma unroll
    for (int a = 0; a < 2; ++a)
#pragma unroll
        for (int b = 0; b < 2; ++b)
#pragma unroll
            for (int m = 0; m < 4; ++m)
#pragma unroll
                for (int n = 0; n < 2; ++n) acc[a][b][m][n] = (f32x4){0.f, 0.f, 0.f, 0.f};
    bf16x8 At[4][2], B0[2][2], B1[2][2];
    const char* cA = (const char*)g.A + (size_t)cur.pm * tstep; const char* cB = (const char*)g.Bt + (size_t)cur.pn * tstep;
    S.a_ready(cur);
    if constexpr (SP2) {
        PG8_STAGE(PG8_SB(0, 0), cB, voffB); PG8_STAGE(PG8_SB(0, 1), cB + hstep, voffB); PG8_STAGE(PG8_SA(0, 0), cA, voffA); PG8_STAGE(PG8_SA(0, 1), cA + hstep, voffA);
        if (wr == 1) PG8_BAR;
        PG8_WAIT_V(2); PG8_BAR;
        PG8_STAGE(PG8_SB(1, 0), cB + kstep, voffB); PG8_STAGE(PG8_SA(1, 0), cA + kstep, voffA); PG8_STAGE(PG8_SB(1, 1), cB + hstep + kstep, voffB);
        PG8_WAIT_V(6); PG8_BAR;
    } else {
        PG8_STAGE(PG8_SB(0, 0), cB, voffB); PG8_STAGE(PG8_SA(0, 0), cA, voffA); PG8_STAGE(PG8_SB(0, 1), cB + hstep, voffB); PG8_STAGE(PG8_SA(0, 1), cA + hstep, voffA);
        if (wr == 1) PG8_BAR;
        PG8_WAIT_V(4); PG8_BAR;
        PG8_STAGE(PG8_SB(1, 0), cB + kstep, voffB); PG8_STAGE(PG8_SA(1, 0), cA + kstep, voffA); PG8_STAGE(PG8_SB(1, 1), cB + hstep + kstep, voffB);
        PG8_WAIT_V(6); PG8_BAR;
    }
    for (;;) {
        const bool has_next = S.next(ui + 1, nxt);
        const char* nA = has_next ? (const char*)g.A + (size_t)nxt.pm * tstep : cA; const char* nB = has_next ? (const char*)g.Bt + (size_t)nxt.pn * tstep : cB;
        for (int t = 0; t < nt; t += 2) {
            const bool last = (t == nt - 2);
            const char* a1 = cA + (size_t)(t + 1) * kstep;
            const char* a2 = last ? nA : cA + (size_t)(t + 2) * kstep; const char* b2 = last ? nB : cB + (size_t)(t + 2) * kstep;
            const char* a3 = a2 + kstep; const char* b3 = b2 + kstep;
            if (last && has_next) S.a_ready(nxt);
            if constexpr (SP2) {
            PG8_LDB(B0, 0, 0); PG8_LDB(B1, 0, 1); PG8_SCHED; PG8_LDA(At, 0, 0); PG8_STAGE(PG8_SA(1, 1), a1 + hstep, voffA);
            PG8_WAIT_V(8); PG8_WAIT_L(0); PG8_BAR; PG8_MMA(0, 0, At, B0); PG8_MMA(0, 1, At, B1); PG8_BAR; PG8_SCHED;
            PG8_LDA(At, 0, 1); PG8_STAGE(PG8_SB(0, 0), b2, voffB); PG8_STAGE(PG8_SB(0, 1), b2 + hstep, voffB); PG8_STAGE(PG8_SA(0, 0), a2, voffA);
            PG8_WAIT_V(8); PG8_WAIT_L(0); PG8_BAR; PG8_MMA(1, 0, At, B0); PG8_MMA(1, 1, At, B1); PG8_BAR; PG8_SCHED;
            PG8_LDB(B0, 1, 0); PG8_LDB(B1, 1, 1); PG8_SCHED; PG8_LDA(At, 1, 0); PG8_STAGE(PG8_SA(0, 1), a2 + hstep, voffA);
            PG8_WAIT_V(8); PG8_WAIT_L(0); PG8_BAR; PG8_MMA(0, 0, At, B0); PG8_MMA(0, 1, At, B1); PG8_BAR; PG8_SCHED;
            PG8_LDA(At, 1, 1); PG8_STAGE(PG8_SB(1, 0), b3, voffB); PG8_STAGE(PG8_SB(1, 1), b3 + hstep, voffB); PG8_STAGE(PG8_SA(1, 0), a3, voffA);
            PG8_WAIT_V(8); PG8_WAIT_L(0); PG8_BAR; PG8_MMA(1, 0, At, B0); PG8_MMA(1, 1, At, B1); PG8_BAR; PG8_SCHED;
            } else {
            PG8_LDB(B0, 0, 0); PG8_SCHED; PG8_LDA(At, 0, 0); PG8_STAGE(PG8_SA(1, 1), a1 + hstep, voffA);
            PG8_WAIT_L(8); PG8_BAR; PG8_WAIT_L(0); PG8_MMA(0, 0, At, B0); PG8_BAR; PG8_SCHED;
            PG8_LDB(B1, 0, 1); PG8_STAGE(PG8_SB(0, 0), b2, voffB);
            PG8_BAR; PG8_WAIT_L(0); PG8_MMA(0, 1, At, B1); PG8_BAR;
            PG8_LDA(At, 0, 1); PG8_STAGE(PG8_SA(0, 0), a2, voffA);
            PG8_BAR; PG8_WAIT_L(0); PG8_MMA(1, 0, At, B0); PG8_BAR; PG8_SCHED;
            PG8_STAGE(PG8_SB(0, 1), b2 + hstep, voffB);
            PG8_WAIT_V(6); PG8_BAR; PG8_MMA(1, 1, At, B1); PG8_BAR;
            PG8_LDB(B0, 1, 0); PG8_SCHED; PG8_LDA(At, 1, 0); PG8_STAGE(PG8_SA(0, 1), a2 + hstep, voffA);
            PG8_WAIT_L(8); PG8_BAR; PG8_WAIT_L(0); PG8_MMA(0, 0, At, B0); PG8_BAR; PG8_SCHED;
            PG8_LDB(B1, 1, 1); PG8_STAGE(PG8_SB(1, 0), b3, voffB);
            PG8_BAR; PG8_WAIT_L(0); PG8_MMA(0, 1, At, B1); PG8_BAR;
            PG8_LDA(At, 1, 1); PG8_STAGE(PG8_SA(1, 0), a3, voffA);
            PG8_BAR; PG8_WAIT_L(0); PG8_MMA(1, 0, At, B0); PG8_BAR; PG8_SCHED;
            PG8_STAGE(PG8_SB(1, 1), b3 + hstep, voffB);
            PG8_WAIT_V(6); PG8_BAR; PG8_MMA(1, 1, At, B1); PG8_BAR;
            }
        }
        if constexpr (ALIGN_EPI) { if (wr == 0) PG8_BAR; }
        if constexpr (!Epi::AFTER_DRAIN) { E(acc, cur, wr, wc, fr, fq); S.done(cur); }
        if (!has_next) break;
#pragma unroll
        for (int a = 0; a < 2; ++a)
#pragma unroll
            for (int b = 0; b < 2; ++b)
#pragma unroll
                for (int m = 0; m < 4; ++m)
#pragma unroll
                    for (int n = 0; n < 2; ++n) acc[a][b][m][n] = (f32x4){0.f, 0.f, 0.f, 0.f};
        cur = nxt; cA = nA; cB = nB; ++ui;
        if constexpr (ALIGN_EPI) { if (wr == 1) PG8_BAR; }
    }
    PG8_WAIT_V(0);
    if constexpr (!ALIGN_EPI) { if (wr == 0) PG8_BAR; }
    PG8_BAR;
    if constexpr (Epi::AFTER_DRAIN) { E.fused(acc, cur, wr, wc, fr, fq, lds, wid, lane); S.done(cur); }
#undef PG8_SA
#undef PG8_SB
#undef PG8_STAGE
#undef PG8_LDA
#undef PG8_LDB
#undef PG8_MMA
#undef PG8_WAIT_V
#undef PG8_WAIT_L
#undef PG8_BAR
#undef PG8_SCHED
}
}
#define PG8_SP2 true
#define PG8_ALIGN true
namespace pg8 {
constexpr int MT = 16640, MP = 16384;
constexpr float RMS_EPS = 1e-6f;
constexpr float QC2 = 0.125f * 1.4426950408889634f;
typedef unsigned u32x2 __attribute__((ext_vector_type(2)));
__device__ __forceinline__ float row_rs(const float* SS, int row, int fq) {
    float s = 0.f;
#pragma unroll
    for (int j = 0; j < 4; ++j) s += SS[(unsigned)(4 * fq + j) * MT + row];
    s += __shfl_xor(s, 16); s += __shfl_xor(s, 32);
    return rsqrtf(s * (1.0f / 1024.0f) + RMS_EPS);
}
__device__ __forceinline__ void rows_rs8(const float* SS, int row0, int fq, float (&r)[8]) {
    float s[8][4];
    if (row0 < MP) {
#pragma unroll
        for (int k = 0; k < 8; ++k)
#pragma unroll
            for (int j = 0; j < 4; ++j) s[k][j] = SS[(unsigned)(4 * fq + j) * MT + row0 + (k >> 2) * HALF + (k & 3) * 16];
    } else { const float* S2 = SS + 16 * MT + (row0 - MP);
#pragma unroll
        for (int h2 = 0; h2 < 2; ++h2) { float q[4][8];
            __builtin_amdgcn_sched_barrier(0);
#pragma unroll
            for (int k = 0; k < 4; ++k)
#pragma unroll
                for (int j = 0; j < 8; ++j) q[k][j] = S2[(unsigned)(8 * fq + j) * 256 + h2 * HALF + k * 16];
            __builtin_amdgcn_sched_barrier(0);
#pragma unroll
            for (int k = 0; k < 4; ++k)
#pragma unroll
                for (int j = 0; j < 4; ++j) s[h2 * 4 + k][j] = q[k][j] + q[k][j + 4]; }
    }
    __builtin_amdgcn_sched_barrier(0);
#pragma unroll
    for (int k = 0; k < 8; ++k) { float t = (s[k][0] + s[k][1]) + (s[k][2] + s[k][3]); t += __shfl_xor(t, 16); t += __shfl_xor(t, 32); r[k] = rsqrtf(t * (1.0f / 1024.0f) + RMS_EPS); }
    __builtin_amdgcn_sched_barrier(0);
}
__device__ __forceinline__ void store8(bf16_t* p, f32x4 a, f32x4 b) {
    u32x4 w; w.x = cvt_pk_bf16(a[0], a[1]); w.y = cvt_pk_bf16(a[2], a[3]); w.z = cvt_pk_bf16(b[0], b[1]); w.w = cvt_pk_bf16(b[2], b[3]);
    *(u32x4*)p = w;
}
__device__ __forceinline__ float sigm(float x) { return __builtin_amdgcn_rcpf(1.0f + __builtin_amdgcn_exp2f(-1.4426950408889634f * x)); }
__device__ __forceinline__ f32x4 sigm4(f32x4 x) { f32x4 r; r[0] = sigm(x[0]); r[1] = sigm(x[1]); r[2] = sigm(x[2]); r[3] = sigm(x[3]); return r; }

struct EpiRes {
    static constexpr bool PERM = true, AFTER_DRAIN = false;
    bf16_t* xb; float* SS; int dry;
    __device__ __forceinline__ void operator()(const f32x4 (&acc)[2][2][4][2], const Unit& u, int wr, int wc, int fr, int fq) const {
        const int col0 = u.pn * BM + wc * 32 + 8 * fq;
#pragma unroll
        for (int ai = 0; ai < 2; ++ai) {
            u32x4 xw[4][2];
#pragma unroll
            for (int m = 0; m < 4; ++m)
#pragma unroll
                for (int bj = 0; bj < 2; ++bj) xw[m][bj] = *(const u32x4*)(xb + (unsigned)(u.pm * BM + ai * HALF + wr * 64 + m * 16 + fr) * 1024 + col0 + bj * HALF);
            __builtin_amdgcn_sched_barrier(0);
#pragma unroll
            for (int m = 0; m < 4; ++m) {
                const int rl = ai * HALF + wr * 64 + m * 16 + fr;
                const unsigned goff = (unsigned)(u.pm * BM + rl) * 1024 + col0;
                float ss = 0.f;
#pragma unroll
                for (int bj = 0; bj < 2; ++bj) {
                    const u32x4 w = xw[m][bj];
                    f32x4 o0, o1;
                    o0[0] = __builtin_bit_cast(float, w.x << 16) + acc[ai][bj][m][0][0]; o0[1] = __builtin_bit_cast(float, w.x & 0xffff0000u) + acc[ai][bj][m][0][1];
                    o0[2] = __builtin_bit_cast(float, w.y << 16) + acc[ai][bj][m][0][2]; o0[3] = __builtin_bit_cast(float, w.y & 0xffff0000u) + acc[ai][bj][m][0][3];
                    o1[0] = __builtin_bit_cast(float, w.z << 16) + acc[ai][bj][m][1][0]; o1[1] = __builtin_bit_cast(float, w.z & 0xffff0000u) + acc[ai][bj][m][1][1];
                    o1[2] = __builtin_bit_cast(float, w.w << 16) + acc[ai][bj][m][1][2]; o1[3] = __builtin_bit_cast(float, w.w & 0xffff0000u) + acc[ai][bj][m][1][3];
                    if (!dry) store8(xb + goff + bj * HALF, o0, o1);
                    ss += (o0[0] * o0[0] + o0[1] * o0[1]) + (o0[2] * o0[2] + o0[3] * o0[3]) + (o1[0] * o1[0] + o1[1] * o1[1]) + (o1[2] * o1[2] + o1[3] * o1[3]);
                }
                ss += __shfl_xor(ss, 16); ss += __shfl_xor(ss, 32);
                if (fq == 0 && !dry) SS[(unsigned)(u.pn * 4 + wc) * MT + u.pm * BM + rl] = ss;
                if (dry) asm volatile("" :: "v"(ss));
            }
        }
    }
};
struct EpiSwiGLU {
    static constexpr bool PERM = true, AFTER_DRAIN = false;
    bf16_t* H; const float* SS;
    __device__ __forceinline__ void operator()(const f32x4 (&acc)[2][2][4][2], const Unit& u, int wr, int wc, int fr, int fq) const {
        const int row0 = u.pm * BM + wr * 64 + fr, col0 = u.pn * 128 + wc * 32 + 8 * fq;
        float r8[8]; rows_rs8(SS, row0, fq, r8);
#pragma unroll
        for (int ai = 0; ai < 2; ++ai)
#pragma unroll
            for (int m = 0; m < 4; ++m) {
                const int row = row0 + ai * HALF + m * 16; const float r = r8[ai * 4 + m];
                const f32x4 g0 = acc[ai][0][m][0] * r, g1 = acc[ai][0][m][1] * r, u0 = acc[ai][1][m][0] * r, u1 = acc[ai][1][m][1] * r;
                store8(H + (unsigned)row * 2816 + col0, g0 * sigm4(g0) * u0, g1 * sigm4(g1) * u1);
            }
    }
};
struct EpiInProj {
    static constexpr bool PERM = true, AFTER_DRAIN = false;
    const float* SS; const float* TAB; bf16_t *UP, *Q, *K, *V, *UC; float *kP, *kS, *vP, *vS;
    __device__ __forceinline__ void operator()(const f32x4 (&acc)[2][2][4][2], const Unit& u, int wr, int wc, int fr, int fq) const {
        const int pn = u.pn; const bool smp = (u.pm >= 64);
        const int row0 = u.pm * BM + wr * 64 + fr, cw = wc * 32 + 8 * fq;
        float r8[8]; rows_rs8(SS, row0, fq, r8);
        if (pn == 0) {
#pragma unroll
            for (int ai = 0; ai < 2; ++ai)
#pragma unroll
                for (int m = 0; m < 4; ++m) { const int row = row0 + ai * HALF + m * 16; const float r = r8[ai * 4 + m];
#pragma unroll
                    for (int bj = 0; bj < 2; ++bj) store8(UP + (unsigned)row * 256 + bj * HALF + cw, acc[ai][bj][m][0] * r, acc[ai][bj][m][1] * r); }
        } else if (pn <= 4) {
            const bool isq = pn <= 2; const int t2 = (pn - 1) & 1, j = 4 * (wc & 1) + fq;
#pragma unroll
            for (int ai = 0; ai < 2; ++ai) {
                f32x4 csv[4], snv[4];
#pragma unroll
                for (int m = 0; m < 4; ++m) { const int row = row0 + ai * HALF + m * 16; const int pos = smp ? 2048 + ((row - MP) & 31) : (row & 2047);
                    csv[m] = *(const f32x4*)(TAB + pos * 64 + 4 * j); snv[m] = *(const f32x4*)(TAB + pos * 64 + 32 + 4 * j); }
                __builtin_amdgcn_sched_barrier(0);
#pragma unroll
                for (int m = 0; m < 4; ++m) { const int row = row0 + ai * HALF + m * 16; const float r = r8[ai * 4 + m];
                    const f32x4 cs = csv[m], sn = snv[m];
#pragma unroll
                    for (int bj = 0; bj < 2; ++bj) { const int grp = t2 * 4 + bj * 2 + (wc >> 1);
                        const f32x4 x1 = acc[ai][bj][m][0] * r, x2 = acc[ai][bj][m][1] * r;
                        const f32x4 o1 = x1 * cs - x2 * sn, o2 = x2 * cs + x1 * sn;
                        const unsigned bo = (unsigned)row * 512 + grp * 64 + 32 * (wc & 1) + 8 * fq;
                        if (isq) store8(Q + bo, o1 * QC2, o2 * QC2);
                        else { store8(K + bo, o1, o2);
                            float* kf = (smp ? kS + (unsigned)(row - MP) * 512 : kP + (unsigned)row * 512) + grp * 64 + 4 * j;
                            __builtin_nontemporal_store(o1, (f32x4*)kf); __builtin_nontemporal_store(o2, (f32x4*)(kf + 32)); } } } }
        } else if (pn <= 6) {
#pragma unroll
            for (int ai = 0; ai < 2; ++ai)
#pragma unroll
                for (int m = 0; m < 4; ++m) { const int row = row0 + ai * HALF + m * 16; const float r = r8[ai * 4 + m];
#pragma unroll
                    for (int bj = 0; bj < 2; ++bj) { const int col = (pn - 5) * 256 + bj * HALF + cw;
                        const f32x4 v0 = acc[ai][bj][m][0] * r, v1 = acc[ai][bj][m][1] * r;
                        store8(V + (unsigned)row * 512 + col, v0, v1);
                        float* vf = (smp ? vS + (unsigned)(row - MP) * 512 : vP + (unsigned)row * 512) + col;
                        __builtin_nontemporal_store(v0, (f32x4*)vf); __builtin_nontemporal_store(v1, (f32x4*)(vf + 4)); } }
        } else {
            const int T = pn - 7;
#pragma unroll
            for (int ai = 0; ai < 2; ++ai)
#pragma unroll
                for (int m = 0; m < 4; ++m) { const int row = row0 + ai * HALF + m * 16; const float r = r8[ai * 4 + m];
                    const f32x4 a0 = acc[ai][0][m][0] * r, a1 = acc[ai][0][m][1] * r, b0 = acc[ai][1][m][0] * r, b1 = acc[ai][1][m][1] * r;
                    store8(UC + (unsigned)row * 256 + T * 128 + cw, a0 * sigm4(b0), a1 * sigm4(b1)); }
        }
    }
};
}
#include <hip/hip_bf16.h>
#include <cmath>
namespace attn_body {
using bf16=__hip_bfloat16;
using bf16x8=__attribute__((ext_vector_type(8)))short;
using s16x4=__attribute__((ext_vector_type(4)))short;
using f32x16=__attribute__((ext_vector_type(16)))float;
using u32x4=__attribute__((ext_vector_type(4)))unsigned;
constexpr int BATCH=8,NHEAD=8,SEQ=2048,D=64,DM=512;
constexpr int NW=8,QBLK=32,QB=QBLK*NW,KVBLK=64,NQB=SEQ/QB;
constexpr int ATTN_PITCH=DM, ATTN_UNIT_ROWS=QB;
__device__ __forceinline__ int crow(int r,int hi){return (r&3)+8*(r>>2)+4*hi;}
#define SBAR() __builtin_amdgcn_sched_barrier(0)
__device__ __forceinline__ void cmask(f32x16&p0,f32x16&p1,int jb,int wid){
  if(jb>(wid>>1)){ const float NEG=-INFINITY;
  #pragma unroll
  for(int r=0;r<16;++r){p0[r]=NEG;p1[r]=NEG;} }
}

constexpr int NSLOT=3, SLOTB=8192;
constexpr int LDS_K=0, LDS_V=NSLOT*SLOTB, LDS_WS=2*NSLOT*SLOTB, LDS_OST=LDS_WS+NW*64*4, LDS_BYTES=LDS_OST+NW*4096;
constexpr float C2=0.125f*1.4426950408889634f;
__device__ __forceinline__ void glds16(const void*gsrc,unsigned lds_dst){unsigned keep;
  asm volatile("s_mov_b32 %0, m0\n\ts_mov_b32 m0, %2\n\ts_nop 0\n\tglobal_load_lds_dwordx4 %1, off\n\ts_mov_b32 m0, %0":"=&s"(keep):"v"(gsrc),"s"(lds_dst):"memory");}
__device__ __forceinline__ float max3f(float a,float b,float c){float r;asm("v_max3_f32 %0, %1, %2, %3":"=v"(r):"v"(a),"v"(b),"v"(c));return r;}
__device__ __forceinline__ float max2f(float a,float b){float r;asm("v_max_f32_e32 %0, %1, %2":"=v"(r):"v"(a),"v"(b));return r;}
__device__ __forceinline__ float fadd_s(float a,float b){float r;asm("v_add_f32_e32 %0, %1, %2":"=v"(r):"v"(a),"v"(b));return r;}
__device__ __forceinline__ float fsub_s(float a,float b){float r;asm("v_sub_f32_e32 %0, %1, %2":"=v"(r):"v"(a),"v"(b));return r;}
typedef float f32x2_t __attribute__((ext_vector_type(2))); typedef __bf16 bf16x2_t __attribute__((ext_vector_type(2)));
__device__ __forceinline__ unsigned cvtpk_s(float lo,float hi){f32x2_t v={lo,hi};bf16x2_t b=__builtin_convertvector(v,bf16x2_t);return __builtin_bit_cast(unsigned,b);}
#define WAIT_BAR(N) asm volatile("s_waitcnt vmcnt(" #N ") lgkmcnt(0)\n\ts_barrier":::"memory")

__device__ __forceinline__ void qkt(f32x16&p0,f32x16&p1,const char*Kslot,const bf16x8*qr,const f32x16&negm,int r32,int hi){
  const char*kb=Kslot+hi*1024+r32*16;
  #pragma unroll
  for(int d0=0;d0<4;++d0){
    const bf16x8 b0=*reinterpret_cast<const bf16x8*>(kb+d0*2048);
    const bf16x8 b1=*reinterpret_cast<const bf16x8*>(kb+d0*2048+512);
    if(d0==0){p0=__builtin_amdgcn_mfma_f32_32x32x16_bf16(b0,qr[0],negm,0,0,0);p1=__builtin_amdgcn_mfma_f32_32x32x16_bf16(b1,qr[0],negm,0,0,0);}
    else{p0=__builtin_amdgcn_mfma_f32_32x32x16_bf16(b0,qr[d0],p0,0,0,0);p1=__builtin_amdgcn_mfma_f32_32x32x16_bf16(b1,qr[d0],p1,0,0,0);}}
}
typedef __attribute__((address_space(3))) const char* lds_cptr;
typedef short v4i16_t __attribute__((ext_vector_type(4)));
__device__ __forceinline__ void kload8(bf16x8*kf,lds_cptr kp){
  kf[0]=*(const __attribute__((address_space(3))) bf16x8*)(kp);      kf[1]=*(const __attribute__((address_space(3))) bf16x8*)(kp+512);
  kf[2]=*(const __attribute__((address_space(3))) bf16x8*)(kp+2048); kf[3]=*(const __attribute__((address_space(3))) bf16x8*)(kp+2560);
  kf[4]=*(const __attribute__((address_space(3))) bf16x8*)(kp+4096); kf[5]=*(const __attribute__((address_space(3))) bf16x8*)(kp+4608);
  kf[6]=*(const __attribute__((address_space(3))) bf16x8*)(kp+6144); kf[7]=*(const __attribute__((address_space(3))) bf16x8*)(kp+6656);
}
__device__ __forceinline__ void kload2(bf16x8*kf,lds_cptr kp,int j){ kf[2*j]=*(const __attribute__((address_space(3))) bf16x8*)(kp+j*2048); kf[2*j+1]=*(const __attribute__((address_space(3))) bf16x8*)(kp+j*2048+512); }
__device__ __forceinline__ s16x4 vtr(lds_cptr p){ return __builtin_bit_cast(s16x4,__builtin_amdgcn_ds_read_tr16_b64_v4i16((__attribute__((address_space(3))) v4i16_t*)p)); }
__device__ __forceinline__ float rowmax(const f32x16&p0,const f32x16&p1){
  float a=max3f(p0[0],p0[1],p1[0]),b=max3f(p0[2],p0[3],p1[1]);a=max3f(a,p1[2],p1[3]);
  #pragma unroll
  for(int r=4;r<16;r+=4){a=max3f(a,p0[r],p0[r+1]);b=max3f(b,p0[r+2],p0[r+3]);a=max3f(a,p1[r],p1[r+1]);b=max3f(b,p1[r+2],p1[r+3]);}
  const float m=max2f(a,b);
  auto rr=__builtin_amdgcn_permlane32_swap(__float_as_uint(m),__float_as_uint(m),false,false);
  return max2f(__uint_as_float(rr[0]),__uint_as_float(rr[1]));
}
__device__ __forceinline__ void pv(f32x16*o,int vb,bf16x8 pa0,bf16x8 pa1,bf16x8 pa2,bf16x8 pa3){
  #pragma unroll
  for(int d0=0;d0<2;++d0){s16x4 lo[4],hi[4];
    #pragma unroll
    for(int ks=0;ks<4;++ks){
      asm volatile("ds_read_b64_tr_b16 %0,%1 offset:%c2":"=&v"(lo[ks]):"v"(vb),"i"(d0*4096+ks*1024):"memory");
      asm volatile("ds_read_b64_tr_b16 %0,%1 offset:%c2":"=&v"(hi[ks]):"v"(vb),"i"(d0*4096+ks*1024+512):"memory");}
    asm volatile("s_waitcnt lgkmcnt(0)":::"memory");SBAR();
    #define PK(k) (bf16x8){lo[k][0],lo[k][1],lo[k][2],lo[k][3],hi[k][0],hi[k][1],hi[k][2],hi[k][3]}
    o[d0]=__builtin_amdgcn_mfma_f32_32x32x16_bf16(pa0,PK(0),o[d0],0,0,0);
    o[d0]=__builtin_amdgcn_mfma_f32_32x32x16_bf16(pa1,PK(1),o[d0],0,0,0);
    o[d0]=__builtin_amdgcn_mfma_f32_32x32x16_bf16(pa2,PK(2),o[d0],0,0,0);
    o[d0]=__builtin_amdgcn_mfma_f32_32x32x16_bf16(pa3,PK(3),o[d0],0,0,0);
    #undef PK
  }
}

#ifndef ATTN_STORE16
#define ATTN_STORE16(p,v) (*(u32x4*)(p)=(v))
#endif
template<int THRL> __device__ __forceinline__ void attn_unit(int b,int h,int hv,int qb,const bf16*Q,const bf16*__restrict__ K,const bf16*__restrict__ V,bf16*O,int ocol,char*shm){
  int tid_l=threadIdx.x; asm volatile("":"+v"(tid_l)); const int tid=tid_l,lane=tid&63,r32=lane&31,hi=lane>>5; const int wid=__builtin_amdgcn_readfirstlane(tid>>6);
  const long rowbase=(long)b*SEQ; const int q0=qb*QB;
  const bf16*Qw=Q+(rowbase+q0+wid*QBLK)*DM+h*D;
  const bf16*Kh=K+rowbase*DM+h*D,*Vh=V+rowbase*DM+hv*D;
  const unsigned lds0=(unsigned)(uintptr_t)shm;
  float*wsf=(float*)(shm+LDS_WS)+wid*64;
  const bf16*ksrc=Kh+(long)lane*DM+wid*8;
  const bf16*vsrc=Vh+(long)(16*(wid&3)+(lane>>2))*DM+(wid>>2)*32+(lane&3)*8;
  const unsigned kdst=lds0+LDS_K+wid*1024, vdst=lds0+LDS_V+wid*1024;
  #define DMA_K(t,slot) glds16(ksrc+(long)(t)*KVBLK*DM,(unsigned)__builtin_amdgcn_readfirstlane(kdst+(slot)))
  #define DMA_V(t,slot) glds16(vsrc+(long)(t)*KVBLK*DM,(unsigned)__builtin_amdgcn_readfirstlane(vdst+(slot)))
  const int vb0=(int)(lds0+LDS_V)+((lane>>4)&1)*32+(lane&3)*8+(4*hi+((lane&15)>>2))*64;
  const char*Kbase=shm+LDS_K; bf16x8 kf[8];
  const lds_cptr shm3=(lds_cptr)shm; const lds_cptr kp0=shm3+LDS_K+hi*1024+r32*16; const lds_cptr vp0=shm3+LDS_V+((lane>>4)&1)*32+(lane&3)*8+(4*hi+((lane&15)>>2))*64;
  const int NT=(q0+QB)/KVBLK;
  DMA_K(0,0);DMA_V(0,0);DMA_K(1,SLOTB);
  bf16x8 qr[4];
  #pragma unroll
  for(int d0=0;d0<4;++d0)qr[d0]=*reinterpret_cast<const bf16x8*>(&Qw[(long)r32*DM+d0*16+hi*8]);
  float mhat=0.f,l_reg=0.f;f32x16 o[2];o[0]=f32x16{};o[1]=f32x16{};f32x16 negm=f32x16{};asm volatile("":"+v"(negm));
  const int qrel=wid*QBLK+r32;
  #define CMASK(P0,P1,t) do{int jb_=(t)-(NT-4); if(jb_>=0)cmask(P0,P1,jb_,wid);}while(0)
  bool resc=false;
  #define START(P0,P1) do{ const float rm=rowmax(P0,P1); resc=false; \
    { const float dl=rm; mhat=fadd_s(mhat,dl); \
      _Pragma("unroll") for(int r=0;r<16;++r){P0[r]=fsub_s(P0[r],dl);P1[r]=fsub_s(P1[r],dl);} \
      _Pragma("unroll") for(int r=0;r<16;++r)negm[r]=-mhat; asm volatile("":"+v"(negm)); } \
    _Pragma("unroll") for(int r=0;r<16;++r)P0[r]=__builtin_amdgcn_exp2f(P0[r]); }while(0)
  #define RESC() do{ if(resc){ asm volatile("s_waitcnt lgkmcnt(0)":::"memory"); \
      _Pragma("unroll") for(int d_=0;d_<2;++d_) _Pragma("unroll") for(int r=0;r<16;++r)o[d_][r]*=wsf[crow(r,hi)]; } }while(0)
  f32x16 pA0,pA1,pB0,pB1;
  int sl_prev=0,sl_cur=0,sl_next=SLOTB;
  #define ROT() do{sl_prev=sl_cur;sl_cur=sl_next;sl_next=(sl_next==(NSLOT-1)*SLOTB)?0:sl_next+SLOTB;}while(0)
  DMA_K(2,2*SLOTB);
  WAIT_BAR(3);
  qkt(pA0,pA1,Kbase,qr,negm,r32,hi);asm volatile("s_nop 15\n\ts_nop 7":"+v"(pA0),"+v"(pA1));CMASK(pA0,pA1,0);
  START(pA0,pA1);
  _Pragma("unroll") for(int r=0;r<16;++r)pA1[r]=__builtin_amdgcn_exp2f(pA1[r]);
  WAIT_BAR(0);
  DMA_K(3,0);DMA_V(1,SLOTB);
  ROT();
  kload8(kf,kp0+sl_cur);
  WAIT_BAR(2);
  s16x4 vlo[8],vhi[8]; u32x4 pw0,pw1,pw2,pw3;
  #define PKW(P,B) cvtpk_s(P[B],P[B+1])
  #define PAF(k) __builtin_bit_cast(bf16x8,pw##k)
  #define VFR(i) (bf16x8){vlo[i][0],vlo[i][1],vlo[i][2],vlo[i][3],vhi[i][0],vhi[i][1],vhi[i][2],vhi[i][3]}
  #define PIN(x) asm volatile("":"+v"(x))
  #define MX3(a,b,c) __builtin_fmaxf(__builtin_fmaxf((a),(b)),(c))
  #define GAPA(MF,A0,A1,A2,A3,W0,W1,PW) do{ MF; sacc+=A0; sacc+=A1; sacc+=A2; sacc+=A3; PIN(sacc); W0; W1; PIN(PW); SBAR(); }while(0)
  #define EX(v) __builtin_amdgcn_exp2f(v)
  #define GAPB(MF,X,B) do{ MF; X[B]=EX(X[B]); X[B+1]=EX(X[B+1]); X[B+2]=EX(X[B+2]); X[B+3]=EX(X[B+3]); PIN(X); SBAR(); }while(0)
  #define VRD(i) do{ vlo[i]=vtr(vp_+(((i)>>2)*4096+((i)&3)*1024)); vhi[i]=vtr(vp_+(((i)>>2)*4096+((i)&3)*1024+512)); }while(0)
  #define KRD(G,j) do{ if(G){ kload2(kf,kp0+sl_next,j); SBAR(); } }while(0)
  #define STEP(C0,C1,P0,P1,t,GK,GV,GL) do{ SBAR(); \
    const lds_cptr vp_=vp0+sl_prev; \
    VRD(0); SBAR(); float sacc=(P0[0]+P0[1]); \
    GAPA(C0=__builtin_amdgcn_mfma_f32_32x32x16_bf16(kf[0],qr[0],negm,0,0,0), P0[2],P0[3],P0[4],P0[5],     pw0[0]=PKW(P0,0), pw0[1]=PKW(P0,2), pw0); \
    VRD(4); SBAR(); GAPA(C1=__builtin_amdgcn_mfma_f32_32x32x16_bf16(kf[1],qr[0],negm,0,0,0), P0[6],P0[7],P0[8],P0[9],     pw0[2]=PKW(P0,4), pw0[3]=PKW(P0,6), pw0); \
    VRD(1); SBAR(); GAPA(C0=__builtin_amdgcn_mfma_f32_32x32x16_bf16(kf[2],qr[1],C0,0,0,0),   P0[10],P0[11],P0[12],P0[13], pw1[0]=PKW(P0,8), pw1[1]=PKW(P0,10), pw1); \
    VRD(5); SBAR(); GAPA(C1=__builtin_amdgcn_mfma_f32_32x32x16_bf16(kf[3],qr[1],C1,0,0,0),   P0[14],P0[15],P1[0],P1[1],   pw1[2]=PKW(P0,12),pw1[3]=PKW(P0,14), pw1); \
    VRD(2); SBAR(); GAPA(C0=__builtin_amdgcn_mfma_f32_32x32x16_bf16(kf[4],qr[2],C0,0,0,0),   P1[2],P1[3],P1[4],P1[5],     pw2[0]=PKW(P1,0), pw2[1]=PKW(P1,2), pw2); \
    VRD(6); SBAR(); GAPA(C1=__builtin_amdgcn_mfma_f32_32x32x16_bf16(kf[5],qr[2],C1,0,0,0),   P1[6],P1[7],P1[8],P1[9],     pw2[2]=PKW(P1,4), pw2[3]=PKW(P1,6), pw2); \
    VRD(3); SBAR(); GAPA(C0=__builtin_amdgcn_mfma_f32_32x32x16_bf16(kf[6],qr[3],C0,0,0,0),   P1[10],P1[11],P1[12],P1[13], pw3[0]=PKW(P1,8), pw3[1]=PKW(P1,10), pw3); \
    VRD(7); SBAR(); GAPA(C1=__builtin_amdgcn_mfma_f32_32x32x16_bf16(kf[7],qr[3],C1,0,0,0),   P1[14],P1[15],0.f,0.f,       pw3[2]=PKW(P1,12),pw3[3]=PKW(P1,14), pw3); \
    l_reg+=sacc; \
    if(GK){DMA_K((t)+3,sl_cur);} if(GV){DMA_V((t)+1,sl_next);} \
    CMASK(C0,C1,t); \
    { float a=MX3(C0[0],C0[1],C1[0]),b=MX3(C0[2],C0[3],C1[1]); a=MX3(a,C1[2],C1[3]); \
      _Pragma("unroll") for(int r=4;r<16;r+=4){a=MX3(a,C0[r],C0[r+1]);b=MX3(b,C0[r+2],C0[r+3]);a=MX3(a,C1[r],C1[r+1]);b=MX3(b,C1[r+2],C1[r+3]);} \
      float rm=__builtin_fmaxf(a,b); { auto rr=__builtin_amdgcn_permlane32_swap(__float_as_uint(rm),__float_as_uint(rm),false,false); rm=__builtin_fmaxf(__uint_as_float(rr[0]),__uint_as_float(rr[1])); } \
      resc=false; \
      if(__builtin_expect(__any(rm>(float)THRL),0)){ const float dl=__builtin_fmaxf(rm,0.f); mhat+=dl; \
        _Pragma("unroll") for(int r=0;r<16;++r){C0[r]-=dl;C1[r]-=dl;} \
        _Pragma("unroll") for(int r=0;r<16;++r)negm[r]=-mhat; asm volatile("":"+v"(negm)); \
        const float f=__builtin_amdgcn_exp2f(-dl); l_reg*=f; if(hi==0)wsf[r32]=f; resc=true; } } \
    SBAR(); \
    GAPB(o[0]=__builtin_amdgcn_mfma_f32_32x32x16_bf16(PAF(0),VFR(0),o[0],0,0,0), C0,0); \
    GAPB(o[1]=__builtin_amdgcn_mfma_f32_32x32x16_bf16(PAF(0),VFR(4),o[1],0,0,0), C0,4); \
    KRD(GL,0); GAPB(o[0]=__builtin_amdgcn_mfma_f32_32x32x16_bf16(PAF(1),VFR(1),o[0],0,0,0), C0,8); \
    KRD(GL,1); GAPB(o[1]=__builtin_amdgcn_mfma_f32_32x32x16_bf16(PAF(1),VFR(5),o[1],0,0,0), C0,12); \
    KRD(GL,2); GAPB(o[0]=__builtin_amdgcn_mfma_f32_32x32x16_bf16(PAF(2),VFR(2),o[0],0,0,0), C1,0); \
    KRD(GL,3); GAPB(o[1]=__builtin_amdgcn_mfma_f32_32x32x16_bf16(PAF(2),VFR(6),o[1],0,0,0), C1,4); \
    GAPB(o[0]=__builtin_amdgcn_mfma_f32_32x32x16_bf16(PAF(3),VFR(3),o[0],0,0,0), C1,8); \
    GAPB(o[1]=__builtin_amdgcn_mfma_f32_32x32x16_bf16(PAF(3),VFR(7),o[1],0,0,0), C1,12); \
    }while(0)
  int t=1;
  #undef CMASK
  #define CMASK(P0,P1,t) do{}while(0)
  for(;t+5<NT;t+=2){
    STEP(pB0,pB1,pA0,pA1,t,true,true,true);     WAIT_BAR(2); RESC(); ROT();
    STEP(pA0,pA1,pB0,pB1,t+1,true,true,true);   WAIT_BAR(2); RESC(); ROT();
  }
  #undef CMASK
  #define CMASK(P0,P1,t) do{int jb_=(t)-(NT-4); if(jb_>=0)cmask(P0,P1,jb_,wid);}while(0)
  #define ENDW(tt) do{ if((tt)+3<NT){WAIT_BAR(2);} else if((tt)+2<NT){WAIT_BAR(1);} else {WAIT_BAR(0);} }while(0)
  for(;t+1<NT;t+=2){
    STEP(pB0,pB1,pA0,pA1,t,(t+3<NT),(t+1<NT),(t+1<NT));       ENDW(t);   RESC(); ROT();
    STEP(pA0,pA1,pB0,pB1,t+1,(t+4<NT),(t+2<NT),(t+2<NT));     ENDW(t+1); RESC(); ROT();
  }
  STEP(pB0,pB1,pA0,pA1,NT-1,false,false,false); RESC();
  { float sacc=pB0[0]+pB0[1]; _Pragma("unroll") for(int r=2;r<16;++r)sacc+=pB0[r]; _Pragma("unroll") for(int r=0;r<16;++r)sacc+=pB1[r]; l_reg+=sacc;
    pw0=(u32x4){PKW(pB0,0),PKW(pB0,2),PKW(pB0,4),PKW(pB0,6)};pw1=(u32x4){PKW(pB0,8),PKW(pB0,10),PKW(pB0,12),PKW(pB0,14)};pw2=(u32x4){PKW(pB1,0),PKW(pB1,2),PKW(pB1,4),PKW(pB1,6)};pw3=(u32x4){PKW(pB1,8),PKW(pB1,10),PKW(pB1,12),PKW(pB1,14)};
    SBAR(); pv(o,vb0+sl_cur,PAF(0),PAF(1),PAF(2),PAF(3)); }
  #undef PKW
  #undef PAF
  #undef VFR
  #undef PIN
  #undef MX3
  #undef GAPA
  #undef GAPB
  #undef EX
  #undef VRD
  #undef KRD
  #undef STEP
  #undef ENDW
  {auto rr=__builtin_amdgcn_permlane32_swap(__float_as_uint(l_reg),__float_as_uint(l_reg),false,false);l_reg=__uint_as_float(rr[0])+__uint_as_float(rr[1]);}
  if(hi==0)wsf[32+r32]=l_reg;asm volatile("s_waitcnt lgkmcnt(0)":::"memory");
  float rli[16];
  #pragma unroll
  for(int r=0;r<16;++r)rli[r]=__builtin_amdgcn_rcpf(wsf[32+crow(r,hi)]);
  bf16*Ow=O+(rowbase+q0+wid*QBLK)*1024+ocol;
  { bf16*stg=(bf16*)(shm+LDS_OST)+wid*2048;
    #pragma unroll
    for(int r=0;r<16;++r){const int orow=crow(r,hi);
      #pragma unroll
      for(int d0=0;d0<2;++d0)stg[orow*64+d0*32+r32]=__float2bfloat16(o[d0][r]*rli[r]);}
    asm volatile("s_waitcnt lgkmcnt(0)":::"memory");
    #pragma unroll
    for(int i=0;i<4;++i){const int row=i*8+(lane>>3),ch=lane&7; const u32x4 v=*(const u32x4*)(stg+row*64+ch*8); ATTN_STORE16(Ow+(long)row*1024+ch*8,v);} }
  asm volatile("s_waitcnt lgkmcnt(0)\n\ts_barrier":::"memory");
  #undef DMA_K
  #undef DMA_V
  #undef CMASK
  #undef START
  #undef RESC
  #undef ROT
}
constexpr int ATTN_LDS_BYTES=LDS_BYTES;
#undef SBAR
#undef WAIT_BAR
}
#ifndef MK_MULTI
#define MK_MULTI 0
#endif
#ifndef REP_SYNC
#define REP_SYNC 0
#endif
#ifndef REP_FOLD
#define REP_FOLD 1
#endif
#ifndef REP_SLACK
#define REP_SLACK 1
#endif
#ifndef SLACK_W
#define SLACK_W 1
#endif
constexpr int NWAVES = 8, NPH = 14;
constexpr int MT = pg8::MT, MP = pg8::MP, DM_ = 1024, INW = 2304, DFF = 2816;
constexpr size_t MiB = 1u << 20;
constexpr size_t WS_TAB = 1 * MiB;
constexpr size_t WS_LAM = 2 * MiB;
constexpr size_t WS_SS = 3 * MiB;
constexpr size_t WS_WIN = 5 * MiB, WS_WOUT = 14 * MiB, WS_WGU = 18 * MiB, WS_WDN = 40 * MiB;
constexpr size_t WS_XB = 52 * MiB;
constexpr size_t WS_SPO = 86 * MiB;
constexpr size_t WS_SPM = 95 * MiB;
constexpr size_t WS_Q = 96 * MiB, WS_K = 113 * MiB, WS_V = 130 * MiB, WS_UP = 147 * MiB, WS_UC = 156 * MiB, WS_O4 = 165 * MiB, WS_MIX = 197 * MiB;
constexpr size_t WS_H = 96 * MiB;
constexpr size_t WS_END = 230 * MiB;
static_assert(WS_H + (size_t)MT * DFF * 2 <= WS_MIX && WS_MIX + (size_t)MT * 1024 * 2 <= WS_END, "ws map");
constexpr size_t O_Y = 0, O_KP = 17039360, O_VP = 33816576, O_PP = 50593792, O_CP = 50655232, O_KS = 50778112, O_VS = 51040256, O_PS = 51302400, O_CS = 51363840, O_END = 51486720;
constexpr int LDS_BYTES = 147456;

#define LAS __attribute__((address_space(3)))
typedef unsigned short bf16;
typedef unsigned v4u __attribute__((ext_vector_type(4)));
typedef unsigned v2u __attribute__((ext_vector_type(2)));
typedef float f32x4 __attribute__((ext_vector_type(4)));
typedef float f32x16 __attribute__((ext_vector_type(16)));
typedef short bf16x8 __attribute__((ext_vector_type(8)));
__device__ __forceinline__ unsigned f2bf(float f) { unsigned u = __builtin_bit_cast(unsigned, f); return (u + 0x7fffu + ((u >> 16) & 1u)) >> 16; }
__device__ __forceinline__ unsigned pk2(float lo, float hi) { return f2bf(lo) | (f2bf(hi) << 16); }
__device__ __forceinline__ float bflo(unsigned w) { return __builtin_bit_cast(float, w << 16); }
__device__ __forceinline__ float bfhi(unsigned w) { return __builtin_bit_cast(float, w & 0xffff0000u); }
__device__ __forceinline__ float wave_sum(float v) {
#pragma unroll
    for (int o = 1; o < 64; o <<= 1) v += __shfl_xor(v, o);
    return v;
}
struct Args { const float* in[22]; float* out; unsigned char* ws; int ph_lo, ph_hi; };
struct Frame { int tid, lane, wave, vcu, G, gw, NGW; };

#define XB_TMO      128
#define XB_XCNT(j)  (256  + 64 * (j))
#define XB_XSUB(j)  (1280 + 64 * (j))
#define XB_XGEN(j)  (2304 + 64 * (j))
#define XB_TOP      3328
#define XB_TOPGEN   3392
#define XCD_BAR_WORDS 3456
#define XB_SPIN_CAP (1u << 18)

__device__ __forceinline__ unsigned xb_ld(unsigned* p)              { return __hip_atomic_load(p, __ATOMIC_RELAXED, __HIP_MEMORY_SCOPE_AGENT); }
__device__ __forceinline__ unsigned xb_add(unsigned* p, unsigned v) { return __hip_atomic_fetch_add(p, v, __ATOMIC_RELAXED, __HIP_MEMORY_SCOPE_AGENT); }
__device__ __forceinline__ unsigned xb_xcc_id() { return (unsigned)__builtin_amdgcn_s_getreg((3 << 11) | 20) & 0xFu; }
#define XB_SPIN(cond, bar) do { unsigned _sp = 0; while (cond) { __builtin_amdgcn_s_sleep(1); \
    if ((++_sp & 255u) == 0u) { if (xb_ld(&(bar)[XB_TMO])) break; if (_sp > XB_SPIN_CAP) { atomicAdd(&(bar)[XB_TMO], 1u); break; } } } } while (0)

struct XcdBarrier {
    unsigned* bar; unsigned x;
    volatile LAS unsigned* st;
};

__device__ __forceinline__ XcdBarrier xcd_barrier_post(unsigned* bar, volatile LAS unsigned* st) {
    XcdBarrier b; b.bar = bar; b.x = xb_xcc_id(); b.st = st;
    if (threadIdx.x == 0) (void)xb_add(&bar[XB_XCNT(b.x)], 1u);
    return b;
}
__device__ __forceinline__ void xcd_barrier_complete(unsigned* bar, unsigned x, unsigned& nloc, unsigned& nx) {
    const unsigned G = gridDim.x * gridDim.y * gridDim.z;
    unsigned sum, cnt, mine, sp = 0u;
    for (;;) {
        sum = 0u; cnt = 0u; mine = 0u;
#pragma unroll
        for (unsigned j = 0; j < 16; ++j) { const unsigned c = xb_ld(&bar[XB_XCNT(j)]); sum += c; cnt += (c > 0u) ? 1u : 0u; mine = (j == x) ? c : mine; }
        if (sum == G) break;
        __builtin_amdgcn_s_sleep(1);
        if ((++sp & 255u) == 0u) { if (xb_ld(&bar[XB_TMO])) break; if (sp > XB_SPIN_CAP) { atomicAdd(&bar[XB_TMO], 1u); break; } }
    }
    nloc = mine > 0u ? mine : 1u; nx = cnt > 0u ? cnt : 1u;
}

__device__ __forceinline__ void xcd_barrier(const XcdBarrier& b) {
    asm volatile("s_waitcnt vmcnt(0)" ::: "memory");
    __syncthreads();
    if (threadIdx.x == 0) {
        unsigned* bar = b.bar;
        __builtin_amdgcn_s_waitcnt(0);
        unsigned nloc = b.st[0], nx = b.st[1];
        if (nloc == 0u) { xcd_barrier_complete(bar, b.x, nloc, nx); b.st[0] = nloc; b.st[1] = nx; }
        const unsigned old = xb_add(&bar[XB_XSUB(b.x)], 1u);
        const unsigned gen = old / nloc;
        if (old + 1u == (gen + 1u) * nloc) {
            __builtin_amdgcn_fence(__ATOMIC_RELEASE, "agent");
            asm volatile("s_waitcnt vmcnt(0)" ::: "memory");
            const unsigned og = xb_add(&bar[XB_TOP], 1u);
            const unsigned tg = og / nx;
            if (og + 1u == (tg + 1u) * nx) xb_add(&bar[XB_TOPGEN], 1u);
            else XB_SPIN(xb_ld(&bar[XB_TOPGEN]) == tg, bar);
            __builtin_amdgcn_fence(__ATOMIC_ACQUIRE, "agent");
            xb_add(&bar[XB_XGEN(b.x)], 1u);
            asm volatile("s_waitcnt vmcnt(0)" ::: "memory");
        } else {
            XB_SPIN(xb_ld(&bar[XB_XGEN(b.x)]) == gen, bar);
            __builtin_amdgcn_fence(__ATOMIC_ACQUIRE, "agent");
            asm volatile("s_waitcnt vmcnt(0)" ::: "memory");
        }
    }
    __syncthreads();
}

constexpr int MISC_OFF = 147200;
__device__ __forceinline__ int perm_in(int n) {
    if (n < 256) return n;
    if (n < 1280) { const int p = n & 63, j = p >> 3, nn = (p >> 2) & 1, i = p & 3; return (n & ~63) + 32 * nn + 4 * j + i; }
    if (n < 1792) return n;
    const int x = n - 1792, T = x >> 8, bj = (x >> 7) & 1, cc = x & 127; return 1792 + 256 * bj + 128 * T + cc;
}
__device__ __forceinline__ int perm_gu(int n) { const int T = n >> 8, bj = (n >> 7) & 1, cc = n & 127; return 2816 * bj + 128 * T + cc; }
template <int MODE> __device__ __forceinline__ void transpose_item(const float* W, int ldw, const float* gk, bf16* WT, int ldwt, int koff, int nblk, LAS float* scr, int item, int lane) {
    (void)scr;
    const int kb = item / nblk, nb = item % nblk, k0 = 64 * kb, np = 64 * nb + lane;
    const int src = (MODE == 1) ? perm_in(np) : (MODE == 2) ? perm_gu(np) : np;
    const float* wp = W + (size_t)k0 * ldw + src;
    float v[64];
#pragma unroll
    for (int t = 0; t < 64; ++t) v[t] = __builtin_nontemporal_load(wp + (size_t)t * ldw);
    __builtin_amdgcn_sched_barrier(0);
    bf16* op = WT + (size_t)np * ldwt + koff + k0;
#pragma unroll
    for (int kc = 0; kc < 8; ++kc) {
        float g[8];
#pragma unroll
        for (int t = 0; t < 8; ++t) g[t] = gk ? gk[k0 + 8 * kc + t] : 1.0f;
        v4u o; o.x = pg8::cvt_pk_bf16(v[8 * kc] * g[0], v[8 * kc + 1] * g[1]); o.y = pg8::cvt_pk_bf16(v[8 * kc + 2] * g[2], v[8 * kc + 3] * g[3]);
        o.z = pg8::cvt_pk_bf16(v[8 * kc + 4] * g[4], v[8 * kc + 5] * g[5]); o.w = pg8::cvt_pk_bf16(v[8 * kc + 6] * g[6], v[8 * kc + 7] * g[7]);
        *(v4u*)(op + 8 * kc) = o; }
}
__device__ __forceinline__ void fold_item(const float* pool_w, const float* pool_scale, const float* conv_pw, const float* w_out, bf16* WT, LAS float* scr, int item, int lane) {
    const int kb = item >> 4, nb = item & 15, n = nb * 64 + lane;
    float acc[8];
#pragma unroll
    for (int i = 0; i < 8; ++i) acc[i] = 0.f;
    int k0, D, rb;
    if (kb < 32) { k0 = kb * 8; D = 64; const int g = k0 >> 6; rb = 64 * g; const float ps = pool_scale[64 * g + lane];
        float pw[8];
#pragma unroll
        for (int i = 0; i < 8; ++i) pw[i] = pool_w[(size_t)(g * 64 + ((k0 + i) & 63)) * 64 + lane];
        __builtin_amdgcn_sched_barrier(0);
#pragma unroll
        for (int i = 0; i < 8; ++i) scr[i * 64 + lane] = pw[i] * ps;
    } else { k0 = 768 + (kb - 32) * 8; D = 256; rb = 768;
        f32x4 cw[8];
#pragma unroll
        for (int i = 0; i < 8; ++i) cw[i] = *(const f32x4*)(conv_pw + (size_t)(k0 - 768 + i) * 256 + 4 * lane);
        __builtin_amdgcn_sched_barrier(0);
#pragma unroll
        for (int i = 0; i < 8; ++i) *(LAS f32x4*)(scr + i * 256 + 4 * lane) = cw[i];
    }
    asm volatile("s_waitcnt lgkmcnt(0)" ::: "memory");
    const float* wp = w_out + (size_t)rb * 1024 + n;
#pragma unroll 1
    for (int d = 0; d < D; d += 32) {
        float wv[32];
#pragma unroll
        for (int q = 0; q < 32; ++q) wv[q] = wp[(size_t)(d + q) * 1024];
        __builtin_amdgcn_sched_barrier(0);
#pragma unroll
        for (int q = 0; q < 32; q += 4)
#pragma unroll
            for (int i = 0; i < 8; ++i) { const f32x4 cf = *(const LAS f32x4*)(scr + i * D + d + q); acc[i] += (cf.x * wv[q] + cf.y * wv[q + 1]) + (cf.z * wv[q + 2] + cf.w * wv[q + 3]); }
        __builtin_amdgcn_sched_barrier(0);
    }
    asm volatile("s_waitcnt lgkmcnt(0)" ::: "memory");
    v4u o; o.x = pk2(acc[0], acc[1]); o.y = pk2(acc[2], acc[3]); o.z = pk2(acc[4], acc[5]); o.w = pk2(acc[6], acc[7]);
    *(v4u*)(WT + (size_t)n * 1024 + k0) = o;
}
constexpr int WI_A = 576, WI_B = 3840, WI_C = 5568, WI_END = 7680;
__device__ __forceinline__ void wi_in(const Args& A, LAS float* scr, int lane, int l, int it) { transpose_item<1>(A.in[7] + (size_t)l * 1024 * INW, INW, A.in[6] + l * 1024, (bf16*)(A.ws + WS_WIN) + (size_t)l * INW * 1024, 1024, 0, INW / 64, scr, it, lane); }
__device__ __forceinline__ void wi_gu(const Args& A, LAS float* scr, int lane, int l, int it) { transpose_item<2>(A.in[19] + (size_t)l * 1024 * 2 * DFF, 2 * DFF, A.in[18] + l * 1024, (bf16*)(A.ws + WS_WGU) + (size_t)l * 2 * DFF * 1024, 1024, 0, 2 * DFF / 64, scr, it, lane); }
__device__ __forceinline__ void wi_dn(const Args& A, LAS float* scr, int lane, int l, int it) { transpose_item<0>(A.in[20] + (size_t)l * DFF * 1024, 1024, nullptr, (bf16*)(A.ws + WS_WDN) + (size_t)l * 1024 * DFF, DFF, 0, 1024 / 64, scr, it, lane); }
__device__ __forceinline__ void wi_mid(const Args& A, LAS float* scr, int lane, int l, int it) { transpose_item<0>(A.in[17] + (size_t)l * 1024 * 1024 + 256 * 1024, 1024, nullptr, (bf16*)(A.ws + WS_WOUT) + (size_t)l * 1024 * 1024, 1024, 256, 1024 / 64, scr, it, lane); }
__device__ __forceinline__ void wi_fold(const Args& A, LAS float* scr, int lane, int l, int it) { fold_item(A.in[8] + (size_t)l * 4 * 64 * 64, A.in[9] + l * 256, A.in[16] + (size_t)l * 256 * 256, A.in[17] + (size_t)l * 1024 * 1024, (bf16*)(A.ws + WS_WOUT) + (size_t)l * 1024 * 1024, scr, it, lane); }
__device__ __forceinline__ void weight_items(const Args& A, LAS float* scr, int lane, int first, int last, int w0, int nw) {
#pragma unroll 1
    for (int idx = first + w0; idx < last; idx += nw) {
        if (idx < WI_A) wi_in(A, scr, lane, 0, idx);
        else if (idx < WI_B) { const int a = idx - WI_A; if (a < 1408) wi_gu(A, scr, lane, 0, a); else if (a < 2112) wi_dn(A, scr, lane, 0, a - 1408); else if (a < 2240) wi_mid(A, scr, lane, 0, a - 2112); else wi_fold(A, scr, lane, 0, a - 2240); }
        else if (idx < WI_C) { const int b2 = idx - WI_B; if (b2 < 576) wi_in(A, scr, lane, 1, b2); else if (b2 < 704) wi_mid(A, scr, lane, 1, b2 - 576); else wi_fold(A, scr, lane, 1, b2 - 704); }
        else { const int c2 = idx - WI_C; if (c2 < 1408) wi_gu(A, scr, lane, 1, c2); else wi_dn(A, scr, lane, 1, c2 - 1408); }
    }
}
__device__ __forceinline__ void slack_weights(const Frame& F, const Args& A, LAS unsigned char* lds, int nwg, int first, int last) {
    const int rounds = (nwg + F.G - 1) / F.G, nfull = nwg - (rounds - 1) * F.G, c = (int)blockIdx.x;
    int sl = F.lane; asm volatile("" : "+v"(sl));
    LAS float* scr = (LAS float*)(lds + F.wave * 16640);
    if (nfull >= F.G) weight_items(A, scr, sl, first, last, F.gw, F.NGW);
    else if (c >= nfull) weight_items(A, scr, sl, first, last, (c - nfull) * NWAVES + F.wave, (F.G - nfull) * NWAVES);
    __syncthreads();
}
__device__ __forceinline__ void p0_prologue(const Frame& F, const Args& A, LAS unsigned char* lds) {
    unsigned char* ws = A.ws;
    LAS float* scr = (LAS float*)(lds + F.wave * 16640);
    int lane_l = F.lane; asm volatile("" : "+v"(lane_l)); const int gw = F.gw, NGW = F.NGW, lane = lane_l;
    weight_items(A, scr, lane, 0, SLACK_W ? WI_A : WI_END, gw, NGW);
    { bf16* XB = (bf16*)(ws + WS_XB); float* SS = (float*)(ws + WS_SS);
      for (int m0 = gw * 2; m0 < MT; m0 += NGW * 2) {
        f32x4 v[2][4];
#pragma unroll
        for (int q = 0; q < 2; ++q) { const int m = m0 + q; const float* xr = (m < MP) ? A.in[0] + (size_t)m * 1024 : A.in[1] + (size_t)(m - MP) * 1024;
#pragma unroll
            for (int j = 0; j < 4; ++j) v[q][j] = __builtin_nontemporal_load((const f32x4*)xr + lane + 64 * j); }
        __builtin_amdgcn_sched_barrier(0);
#pragma unroll
        for (int q = 0; q < 2; ++q) { const int m = m0 + q; float s = 0.f;
#pragma unroll
            for (int j = 0; j < 4; ++j) { const f32x4 w = v[q][j]; s += (w.x * w.x + w.y * w.y) + (w.z * w.z + w.w * w.w);
                v2u o; o.x = pk2(w.x, w.y); o.y = pk2(w.z, w.w); *((v2u*)(XB + (size_t)m * 1024) + lane + 64 * j) = o; }
            s = wave_sum(s);
            if (lane < 16) SS[(size_t)lane * MT + m] = (lane == 0) ? s : 0.f;
            if (m >= MP && lane < 32) SS[(size_t)16 * MT + lane * 256 + (m - MP)] = (lane == 0) ? s : 0.f; }
      } }
    { float* TAB = (float*)(ws + WS_TAB);
      for (int i = gw * 64 + lane; i < 2080 * 32; i += NGW * 64) { const int pos = i >> 5, f = i & 31;
        const float inv = powf(10000.0f, -(float)f / 32.0f); const float ang = (float)pos * inv; float sv, cv; sincosf(ang, &sv, &cv);
        TAB[pos * 64 + f] = cv; TAB[pos * 64 + 32 + f] = sv; } }
    if (gw < 2) { const float* lq = A.in[10] + gw * 256; const float a = wave_sum(lq[lane] * lq[64 + lane]), b = wave_sum(lq[128 + lane] * lq[192 + lane]);
        const float lam_init = 0.8f - 0.6f * expf(-0.3f * (float)gw);
        if (lane == 0) ((float*)(ws + WS_LAM))[gw] = expf(a) - expf(b) + lam_init; }
}

__device__ __forceinline__ int crow(int r, int hi) { return (r & 3) + 8 * (r >> 2) + 4 * hi; }
__device__ __forceinline__ void sample_attn_unit(const Frame& F, const Args& A, int l, int bh, int split, LAS unsigned char* lds) {
    int lane_l = F.lane; asm volatile("" : "+v"(lane_l)); const int b = bh >> 2, h = bh & 3, lane = lane_l, wid = F.wave, r32 = lane & 31, hi = lane >> 5;
    LAS unsigned short* PL = (LAS unsigned short*)lds;
    LAS float* OX = (LAS float*)(lds + 20480);
    LAS float* MB = (LAS float*)(lds + 40960);
    LAS float* LB = MB + 256;
    const bool last = (split == 7), two = last && (wid == 7);
    const int eb = wid & 3, kh = wid >> 2, nks = (last && kh == 1) ? 10 : 8;
    const size_t cro = ((size_t)(l * 8 + b) * 2048 + split * 256) * 512 + h * 128, nro = ((size_t)(l * 8 + b) * 32) * 512 + h * 128;
    const float* Kc = A.in[2] + cro; const float* Vc = A.in[3] + cro;
    const float* Kn = A.out + O_KS + nro; const float* Vn = A.out + O_VS + nro;
    const bf16* Qrow = (const bf16*)(A.ws + WS_Q) + (size_t)(MP + b * 32 + r32) * 512 + h * 128;
    bf16x8 vfr[10];
    { float t[10][8];
#pragma unroll
      for (int ks = 0; ks < 10; ++ks)
#pragma unroll
        for (int j = 0; j < 8; ++j) { const float* vp = (ks < 8) ? Vc + (size_t)(128 * kh + 16 * ks + 8 * hi + j) * 512 : Vn + (size_t)(16 * (ks - 8) + 8 * hi + j) * 512;
            t[ks][j] = (ks < nks) ? __builtin_nontemporal_load(vp + 32 * eb + r32) : 0.f; }
      __builtin_amdgcn_sched_barrier(0);
#pragma unroll
      for (int ks = 0; ks < 10; ++ks) { v4u w; w.x = pk2(t[ks][0], t[ks][1]); w.y = pk2(t[ks][2], t[ks][3]); w.z = pk2(t[ks][4], t[ks][5]); w.w = pk2(t[ks][6], t[ks][7]); vfr[ks] = __builtin_bit_cast(bf16x8, w); }
      __builtin_amdgcn_sched_barrier(0); }
    float* SPO = (float*)(A.ws + WS_SPO); float* SPM = (float*)(A.ws + WS_SPM);
    for (int c = 0; c < 2; ++c) {
        f32x16 s[2]; s[0] = f32x16{}; s[1] = f32x16{};
        bf16x8 qf[4];
        { v2u q0[4], q1[4]; f32x4 ka[2][4], kb[2][4];
#pragma unroll
          for (int d0 = 0; d0 < 4; ++d0) { const bf16* qp = Qrow + c * 64 + 32 * (d0 & 1) + 16 * hi + 4 * (d0 >> 1); q0[d0] = *(const v2u*)qp; q1[d0] = *(const v2u*)(qp + 8);
              const float* kp = Kc + (size_t)(32 * wid + r32) * 512 + c * 64 + 16 * d0 + 8 * hi; ka[0][d0] = __builtin_nontemporal_load((const f32x4*)kp); kb[0][d0] = __builtin_nontemporal_load((const f32x4*)(kp + 4));
              const float* kn = Kn + (size_t)r32 * 512 + c * 64 + 16 * d0 + 8 * hi;
              ka[1][d0] = two ? *(const f32x4*)kn : (f32x4){0.f, 0.f, 0.f, 0.f}; kb[1][d0] = two ? *(const f32x4*)(kn + 4) : (f32x4){0.f, 0.f, 0.f, 0.f}; }
          __builtin_amdgcn_sched_barrier(0);
#pragma unroll
          for (int d0 = 0; d0 < 4; ++d0) { v4u qw; qw.x = q0[d0].x; qw.y = q0[d0].y; qw.z = q1[d0].x; qw.w = q1[d0].y; qf[d0] = __builtin_bit_cast(bf16x8, qw); }
#pragma unroll
          for (int ch = 0; ch < 2; ++ch) if (ch == 0 || two) {
#pragma unroll
              for (int d0 = 0; d0 < 4; ++d0) { v4u kw; kw.x = pk2(ka[ch][d0].x, ka[ch][d0].y); kw.y = pk2(ka[ch][d0].z, ka[ch][d0].w); kw.z = pk2(kb[ch][d0].x, kb[ch][d0].y); kw.w = pk2(kb[ch][d0].z, kb[ch][d0].w);
                  s[ch] = __builtin_amdgcn_mfma_f32_32x32x16_bf16(__builtin_bit_cast(bf16x8, kw), qf[d0], s[ch], 0, 0, 0); } } }
        float m = s[0][0];
#pragma unroll
        for (int r = 1; r < 16; ++r) m = fmaxf(m, s[0][r]);
        if (two) {
#pragma unroll
            for (int r = 0; r < 16; ++r) m = fmaxf(m, s[1][r]); }
        m = fmaxf(m, __shfl_xor(m, 32));
        if (hi == 0) MB[wid * 32 + r32] = m;
        __syncthreads();
        float M = MB[r32];
#pragma unroll
        for (int w = 1; w < 8; ++w) M = fmaxf(M, MB[w * 32 + r32]);
        float lsum = 0.f;
#pragma unroll
        for (int ch = 0; ch < 2; ++ch) if (ch == 0 || two) {
#pragma unroll
            for (int r = 0; r < 16; ++r) { s[ch][r] = __builtin_amdgcn_exp2f(s[ch][r] - M); lsum += s[ch][r]; }
            const int kbase = (ch == 0) ? 32 * wid : 256;
#pragma unroll
            for (int t = 0; t < 4; ++t) { v2u w; w.x = pk2(s[ch][4 * t], s[ch][4 * t + 1]); w.y = pk2(s[ch][4 * t + 2], s[ch][4 * t + 3]);
                *(LAS v2u*)(PL + r32 * 296 + kbase + 8 * t + 4 * hi) = w; } }
        lsum += __shfl_xor(lsum, 32);
        if (hi == 0) LB[wid * 32 + r32] = lsum;
        __syncthreads();
        f32x16 o = {};
#pragma unroll
        for (int ks = 0; ks < 10; ++ks) if (ks < nks) {
            const int key0 = (ks < 8) ? 128 * kh + 16 * ks : 256 + 16 * (ks - 8);
            const bf16x8 pf = *(const LAS bf16x8*)(PL + r32 * 296 + key0 + 8 * hi);
            o = __builtin_amdgcn_mfma_f32_32x32x16_bf16(vfr[ks], pf, o, 0, 0, 0); }
        if (kh == 1) {
#pragma unroll
            for (int r = 0; r < 16; ++r) OX[eb * 1024 + r * 64 + lane] = o[r]; }
        __syncthreads();
        if (kh == 0) { const size_t pi = ((size_t)(bh * 8 + split) * 2 + c) * 32 + r32;
#pragma unroll
            for (int t = 0; t < 4; ++t) { f32x4 v; v.x = o[4 * t] + OX[eb * 1024 + (4 * t) * 64 + lane]; v.y = o[4 * t + 1] + OX[eb * 1024 + (4 * t + 1) * 64 + lane];
                v.z = o[4 * t + 2] + OX[eb * 1024 + (4 * t + 2) * 64 + lane]; v.w = o[4 * t + 3] + OX[eb * 1024 + (4 * t + 3) * 64 + lane];
                *(f32x4*)(SPO + pi * 128 + 32 * eb + 8 * t + 4 * hi) = v; }
            if (wid == 0 && hi == 0) { float Lq = LB[r32];
#pragma unroll
                for (int w = 1; w < 8; ++w) Lq += LB[w * 32 + r32];
                SPM[pi * 2] = M; SPM[pi * 2 + 1] = Lq; } }
    }
    __syncthreads();
}

template <int NB> __device__ __forceinline__ void sample_gemm_res(const Frame& F, const bf16* Arows, int lda, const bf16* Bt, int K, bf16* XBs, float* SS, LAS unsigned char* lds) {
    int lane_l = F.lane; asm volatile("" : "+v"(lane_l));
    const int lane = lane_l, ks = F.wave, r32 = lane & 31, hi = lane >> 5, rt = F.vcu >> 5, ct = F.vcu & 31;
    const int Kw = K >> 3, nst = Kw >> 4;
    const bf16* ap = Arows + (size_t)(32 * rt + r32) * lda + ks * Kw + 8 * hi;
    const bf16* bp = Bt + (size_t)(32 * ct + r32) * K + ks * Kw + 8 * hi;
    f32x16 acc = {};
#pragma unroll 1
    for (int s0 = 0; s0 < nst; s0 += NB) {
        bf16x8 a[NB], b[NB];
#pragma unroll
        for (int i = 0; i < NB; ++i) { a[i] = *(const bf16x8*)(ap + 16 * (s0 + i)); b[i] = *(const bf16x8*)(bp + 16 * (s0 + i)); }
        __builtin_amdgcn_sched_barrier(0);
#pragma unroll
        for (int i = 0; i < NB; ++i) acc = __builtin_amdgcn_mfma_f32_32x32x16_bf16(a[i], b[i], acc, 0, 0, 0);
        __builtin_amdgcn_sched_barrier(0);
    }
    LAS float* RED = (LAS float*)lds;
    LAS float* SSQ = (LAS float*)(lds + 32768);
    if (ks > 0) {
#pragma unroll
        for (int r = 0; r < 16; ++r) RED[(ks - 1) * 1024 + r * 64 + lane] = acc[r]; }
    __syncthreads();
    if (ks == 0) {
        float v[16]; unsigned xo[16];
#pragma unroll
        for (int r = 0; r < 16; ++r) { float t = acc[r];
#pragma unroll
            for (int w = 0; w < 7; ++w) t += RED[w * 1024 + r * 64 + lane];
            v[r] = t; xo[r] = (unsigned)XBs[(unsigned)(32 * rt + crow(r, hi)) * 1024 + 32 * ct + r32]; }
        __builtin_amdgcn_sched_barrier(0);
#pragma unroll
        for (int r = 0; r < 16; ++r) { const float x = v[r] + bflo(xo[r]);
            XBs[(unsigned)(32 * rt + crow(r, hi)) * 1024 + 32 * ct + r32] = (bf16)f2bf(x);
            SSQ[crow(r, hi) * 33 + r32] = x * x; }
    }
    __syncthreads();
    if (ks == 0 && lane < 32) { float s = 0.f;
#pragma unroll
        for (int c2 = 0; c2 < 32; ++c2) s += SSQ[lane * 33 + c2];
        SS[(size_t)16 * MT + ct * 256 + 32 * rt + lane] = s; }
    __syncthreads();
}

__device__ __forceinline__ void conv_item_fast(const Args& A, int l, int item, int lane) {
    const int row0 = item * 8; const bool smp = row0 >= MP;
    const int b = smp ? (row0 - MP) >> 5 : row0 >> 11, t0 = smp ? (row0 - MP) & 31 : row0 & 2047, L = smp ? 32 : 2048;
    const bf16* UC = (const bf16*)(A.ws + WS_UC) + (size_t)(row0 - t0) * 256 + 4 * lane;
    const float* dw = A.in[12] + (size_t)l * 31 * 256 + 4 * lane;
    v2u P[38];
#pragma unroll
    for (int s = 0; s < 38; ++s) { const int tt = t0 - 30 + s; P[s] = (v2u){0u, 0u}; if (tt >= 0) P[s] = *(const v2u*)(UC + (size_t)tt * 256); }
    f32x4 acc[8];
#pragma unroll
    for (int i = 0; i < 8; ++i) acc[i] = (f32x4){0.f, 0.f, 0.f, 0.f};
    f32x4 R[8];
#pragma unroll
    for (int i = 0; i < 7; ++i) { const v2u w = P[i]; R[i] = (f32x4){bflo(w.x), bfhi(w.x), bflo(w.y), bfhi(w.y)}; }
#pragma unroll
    for (int j = 0; j < 31; ++j) { const f32x4 wv = *(const f32x4*)(dw + j * 256);
        { const v2u w = P[7 + j]; R[7] = (f32x4){bflo(w.x), bfhi(w.x), bflo(w.y), bfhi(w.y)}; }
#pragma unroll
        for (int i = 0; i < 8; ++i) acc[i] += wv * R[i];
#pragma unroll
        for (int i = 0; i < 7; ++i) R[i] = R[i + 1];
        __builtin_amdgcn_sched_barrier(0); }
    if (t0 + 7 >= L - 30) { float* cout = A.out + (smp ? O_CS : O_CP) + ((size_t)(l * 8 + b) * 30) * 256 + 4 * lane;
#pragma unroll
        for (int i = 0; i < 8; ++i) { const int tq = t0 + i; const v2u w = P[30 + i]; if (tq >= L - 30) *(f32x4*)(cout + (size_t)(tq - (L - 30)) * 256) = (f32x4){bflo(w.x), bfhi(w.x), bflo(w.y), bfhi(w.y)}; } }
    const f32x4 bias = *(const f32x4*)(A.in[13] + l * 256 + 4 * lane), lg = *(const f32x4*)(A.in[14] + l * 256 + 4 * lane), lb = *(const f32x4*)(A.in[15] + l * 256 + 4 * lane);
    bf16* MIX = (bf16*)(A.ws + WS_MIX) + (size_t)row0 * 1024 + 768 + 4 * lane;
#pragma unroll
    for (int i = 0; i < 8; ++i) { f32x4 y = acc[i] + bias;
        const float mu = wave_sum((y.x + y.y) + (y.z + y.w)) * (1.0f / 256.0f); y = y - mu;
        const float var = wave_sum((y.x * y.x + y.y * y.y) + (y.z * y.z + y.w * y.w)) * (1.0f / 256.0f);
        const float rs = rsqrtf(var + 1e-6f); y = y * rs * lg + lb; y = y * pg8::sigm4(y);
        v2u o; o.x = pk2(y.x, y.y); o.y = pk2(y.z, y.w); *(v2u*)(MIX + (size_t)i * 1024) = o; }
}
__device__ __forceinline__ void conv_item(const Args& A, int l, int item, int lane) {
    const int row0 = item * 8; const bool smp = row0 >= MP;
    const int b = smp ? (row0 - MP) >> 5 : row0 >> 11, t0 = smp ? (row0 - MP) & 31 : row0 & 2047, L = smp ? 32 : 2048;
    const bf16* UC = (const bf16*)(A.ws + WS_UC) + (size_t)(row0 - t0) * 256 + 4 * lane;
    const float* hist = A.in[5] + ((size_t)(l * 8 + b) * 30) * 256 + 4 * lane;
    const float* dw = A.in[12] + (size_t)l * 31 * 256 + 4 * lane;
    f32x4 acc[8], R[8];
#pragma unroll
    for (int i = 0; i < 8; ++i) acc[i] = (f32x4){0.f, 0.f, 0.f, 0.f};
    float* cout = A.out + (smp ? O_CS : O_CP) + ((size_t)(l * 8 + b) * 30) * 256 + 4 * lane;
#define CONV_ROW(dst, tt_) do { const int tt = (tt_); const int ttc = tt < 0 ? 0 : tt; \
        const v2u w_ = *(const v2u*)(UC + (size_t)ttc * 256); f32x4 rv_ = (f32x4){bflo(w_.x), bfhi(w_.x), bflo(w_.y), bfhi(w_.y)}; \
        if (tt < 0) rv_ = (f32x4){0.f, 0.f, 0.f, 0.f}; dst = rv_; } while (0)
#define CONV_HIST(dst, tt_) do { const int tt = (tt_); int hr = 30 + tt; hr = hr < 0 ? 0 : (hr > 29 ? 29 : hr); const f32x4 hv_ = *(const f32x4*)(hist + (size_t)hr * 256); if (tt < 0) dst = hv_; } while (0)
#pragma unroll
    for (int i = 0; i < 7; ++i) CONV_ROW(R[i], t0 - 30 + i);
    if (smp) {
#pragma unroll
        for (int i = 0; i < 7; ++i) CONV_HIST(R[i], t0 - 30 + i); }
#pragma unroll 1
    for (int jb = 0; jb < 32; jb += 8) {
        f32x4 N[8], Wt[8];
#pragma unroll
        for (int jj = 0; jj < 8; ++jj) { const int j = jb + jj; int tt2 = t0 - 23 + j; if (tt2 > L - 1) tt2 = L - 1; CONV_ROW(N[jj], tt2);
            const int jc = j < 31 ? j : 30; Wt[jj] = *(const f32x4*)(dw + jc * 256); if (j >= 31) Wt[jj] = (f32x4){0.f, 0.f, 0.f, 0.f}; }
        if (smp && t0 - 23 + jb < 0) {
#pragma unroll
            for (int jj = 0; jj < 8; ++jj) CONV_HIST(N[jj], t0 - 23 + jb + jj); }
        __builtin_amdgcn_sched_barrier(0);
#pragma unroll
        for (int jj = 0; jj < 8; ++jj) { const int j = jb + jj; R[7] = N[jj];
            if (j >= 23 && j < 31) { const int tq = t0 + (j - 23); if (tq >= L - 30) *(f32x4*)(cout + (size_t)(tq - (L - 30)) * 256) = R[7]; }
#pragma unroll
            for (int i = 0; i < 8; ++i) acc[i] += Wt[jj] * R[i];
#pragma unroll
            for (int i = 0; i < 7; ++i) R[i] = R[i + 1]; }
    }
#undef CONV_HIST
#undef CONV_ROW
    const f32x4 bias = *(const f32x4*)(A.in[13] + l * 256 + 4 * lane), lg = *(const f32x4*)(A.in[14] + l * 256 + 4 * lane), lb = *(const f32x4*)(A.in[15] + l * 256 + 4 * lane);
    bf16* MIX = (bf16*)(A.ws + WS_MIX) + (size_t)row0 * 1024 + 768 + 4 * lane;
#pragma unroll
    for (int i = 0; i < 8; ++i) { f32x4 y = acc[i] + bias;
        const float mu = wave_sum((y.x + y.y) + (y.z + y.w)) * (1.0f / 256.0f); y = y - mu;
        const float var = wave_sum((y.x * y.x + y.y * y.y) + (y.z * y.z + y.w * y.w)) * (1.0f / 256.0f);
        const float rs = rsqrtf(var + 1e-6f); y = y * rs * lg + lb; y = y * pg8::sigm4(y);
        v2u o; o.x = pk2(y.x, y.y); o.y = pk2(y.z, y.w); *(v2u*)(MIX + (size_t)i * 1024) = o; }
}
__device__ __forceinline__ void pool_item(const Args& A, int l, int item, int lane) {
    const int row = item * 2 + (lane >> 5), c0 = (lane & 31) * 8, g = c0 >> 6, w = 2 << g;
    const bool smp = row >= MP; const int b = smp ? (row - MP) >> 5 : row >> 11, t = smp ? (row - MP) & 31 : row & 2047, L = smp ? 32 : 2048;
    const bf16* UP = (const bf16*)(A.ws + WS_UP) + (size_t)(row - t) * 256 + c0;
    const float* hist = A.in[4] + ((size_t)(l * 8 + b) * 15) * 256 + c0;
    float sum[8], own[8];
    v4u pv[16];
#pragma unroll
    for (int jj = 0; jj < 16; ++jj) { const int tt = t - jj; pv[jj] = (v4u){0u, 0u, 0u, 0u}; if (jj < w && tt >= 0) pv[jj] = *(const v4u*)(UP + (size_t)tt * 256); }
    __builtin_amdgcn_sched_barrier(0);
#pragma unroll
    for (int i = 0; i < 8; ++i) sum[i] = 0.f;
#pragma unroll
    for (int jj = 0; jj < 16; ++jj) { const v4u v = pv[jj];
        const float fv[8] = {bflo(v.x), bfhi(v.x), bflo(v.y), bfhi(v.y), bflo(v.z), bfhi(v.z), bflo(v.w), bfhi(v.w)};
#pragma unroll
        for (int i = 0; i < 8; ++i) { sum[i] += fv[i]; if (jj == 0) own[i] = fv[i]; } }
    if (smp && t < w - 1) { for (int jj = t + 1; jj < w; ++jj) { const int tt = t - jj;
            const f32x4 a = *(const f32x4*)(hist + (size_t)(15 + tt) * 256), bq = *(const f32x4*)(hist + (size_t)(15 + tt) * 256 + 4);
            sum[0] += a.x; sum[1] += a.y; sum[2] += a.z; sum[3] += a.w; sum[4] += bq.x; sum[5] += bq.y; sum[6] += bq.z; sum[7] += bq.w; } }
    const int cnt = smp ? w : ((t + 1 < w) ? t + 1 : w); const float ic = 1.0f / (float)cnt;
    v4u o; o.x = pk2(sum[0] * ic - own[0], sum[1] * ic - own[1]); o.y = pk2(sum[2] * ic - own[2], sum[3] * ic - own[3]);
    o.z = pk2(sum[4] * ic - own[4], sum[5] * ic - own[5]); o.w = pk2(sum[6] * ic - own[6], sum[7] * ic - own[7]);
    *(v4u*)((bf16*)(A.ws + WS_MIX) + (size_t)row * 1024 + c0) = o;
    if (t >= L - 15) { float* po = A.out + (smp ? O_PS : O_PP) + ((size_t)(l * 8 + b) * 15 + (t - (L - 15))) * 256 + c0;
        *(f32x4*)po = (f32x4){own[0], own[1], own[2], own[3]}; *(f32x4*)(po + 4) = (f32x4){own[4], own[5], own[6], own[7]}; }
}
__device__ __forceinline__ void post_item(const Args& A, int l, int row0, int lane, float lam, float osc) {
    const int h = lane >> 4, e = (lane & 15) * 8;
    const bf16* O4 = (const bf16*)(A.ws + WS_O4) + (size_t)row0 * 1024 + h * 256 + e;
    v4u a[4], bq[4];
#pragma unroll
    for (int i = 0; i < 4; ++i) { a[i] = *(const v4u*)(O4 + (size_t)i * 1024); bq[i] = *(const v4u*)(O4 + (size_t)i * 1024 + 128); }
    __builtin_amdgcn_sched_barrier(0);
    const f32x4 g0 = *(const f32x4*)(A.in[11] + l * 128 + e), g1 = *(const f32x4*)(A.in[11] + l * 128 + e + 4);
#pragma unroll
    for (int i = 0; i < 4; ++i) {
        float o[8] = {bflo(a[i].x) - lam * bflo(bq[i].x), bfhi(a[i].x) - lam * bfhi(bq[i].x), bflo(a[i].y) - lam * bflo(bq[i].y), bfhi(a[i].y) - lam * bfhi(bq[i].y),
                      bflo(a[i].z) - lam * bflo(bq[i].z), bfhi(a[i].z) - lam * bfhi(bq[i].z), bflo(a[i].w) - lam * bflo(bq[i].w), bfhi(a[i].w) - lam * bfhi(bq[i].w)};
        float ss = 0.f;
#pragma unroll
        for (int k = 0; k < 8; ++k) ss += o[k] * o[k];
        ss += __shfl_xor(ss, 1); ss += __shfl_xor(ss, 2); ss += __shfl_xor(ss, 4); ss += __shfl_xor(ss, 8);
        const float rs = rsqrtf(ss * (1.0f / 128.0f) + 1e-6f) * osc;
        v4u w; w.x = pk2(o[0] * rs * g0.x, o[1] * rs * g0.y); w.y = pk2(o[2] * rs * g0.z, o[3] * rs * g0.w); w.z = pk2(o[4] * rs * g1.x, o[5] * rs * g1.y); w.w = pk2(o[6] * rs * g1.z, o[7] * rs * g1.w);
        *(v4u*)((bf16*)(A.ws + WS_MIX) + (size_t)(row0 + i) * 1024 + 256 + h * 128 + e) = w; }
}
__device__ __forceinline__ void scomb_item(const Args& A, int l, int item, int lane, float lam, float osc) {
    const int rs_ = item >> 2, h = item & 3, b = rs_ >> 5, q = rs_ & 31, bh = b * 4 + h;
    const float* SPO = (const float*)(A.ws + WS_SPO); const float* SPM = (const float*)(A.ws + WS_SPM);
    float oc[2][2];
#pragma unroll
    for (int c = 0; c < 2; ++c) {
        typedef float f32x2t __attribute__((ext_vector_type(2)));
        f32x2t ml[8], ov[8];
#pragma unroll
        for (int s = 0; s < 8; ++s) { const size_t pi = ((size_t)(bh * 8 + s) * 2 + c) * 32 + q; ml[s] = *(const f32x2t*)(SPM + pi * 2); ov[s] = *(const f32x2t*)(SPO + pi * 128 + 2 * lane); }
        __builtin_amdgcn_sched_barrier(0);
        float M = ml[0].x;
#pragma unroll
        for (int s = 1; s < 8; ++s) M = fmaxf(M, ml[s].x);
        float Ls = 0.f, o0 = 0.f, o1 = 0.f;
#pragma unroll
        for (int s = 0; s < 8; ++s) { const float wgt = __builtin_amdgcn_exp2f(ml[s].x - M); Ls += wgt * ml[s].y; o0 += wgt * ov[s].x; o1 += wgt * ov[s].y; }
        const float il = 1.0f / Ls; oc[c][0] = o0 * il; oc[c][1] = o1 * il; }
    const float x0 = oc[0][0] - lam * oc[1][0], x1 = oc[0][1] - lam * oc[1][1];
    const float ss = wave_sum(x0 * x0 + x1 * x1); const float rs = rsqrtf(ss * (1.0f / 128.0f) + 1e-6f) * osc;
    const float* g = A.in[11] + l * 128 + 2 * lane;
    *(unsigned*)((bf16*)(A.ws + WS_MIX) + (size_t)(MP + rs_) * 1024 + 256 + h * 128 + 2 * lane) = pk2(x0 * rs * g[0], x1 * rs * g[1]);
}

__global__ void __launch_bounds__(NWAVES * 64, 2) mk_fwd(Args args) {
    extern __shared__ __attribute__((aligned(16))) unsigned char lds_raw[];
    LAS unsigned char* lds = (LAS unsigned char*)lds_raw;
    Frame F; F.tid = threadIdx.x; F.lane = F.tid & 63; F.wave = __builtin_amdgcn_readfirstlane(F.tid >> 6);
    F.G = gridDim.x; { const int bx = blockIdx.x; F.vcu = (F.G % 8 == 0) ? (bx % 8) * (F.G / 8) + bx / 8 : bx; }
    F.gw = F.vcu * NWAVES + F.wave; F.NGW = F.G * NWAVES;
    unsigned char* ws = args.ws;
    const int lo = args.ph_lo, hi = args.ph_hi;
#define IN(k) (lo <= (k) && (k) < hi)
#define SEAM(k) do { if (IN(k) && IN((k) + 1)) { xcd_barrier(bar); } } while (0)
    for (int u = F.tid; u < 64; u += NWAVES * 64) ((LAS unsigned*)(lds + MISC_OFF))[u] = 0u;
    __syncthreads();
    XcdBarrier bar; bar.bar = (unsigned*)ws; bar.x = 0; bar.st = nullptr;
    if (!MK_MULTI) bar = xcd_barrier_post((unsigned*)ws, (volatile LAS unsigned*)(lds + MISC_OFF) + 8);
    #ifndef REP_PRO
#define REP_PRO 1
#endif
#ifndef REP_INP
#define REP_INP 1
#endif
#ifndef REP_ATT
#define REP_ATT 1
#endif
#ifndef REP_MIX
#define REP_MIX 1
#endif
#ifndef REP_GU
#define REP_GU 1
#endif
    if (!MK_MULTI && lo < 0) cg::this_grid().sync();
    if (IN(0)) { for (int rep = 0; rep < REP_PRO; ++rep) { p0_prologue(F, args, lds); __syncthreads(); } }
    SEAM(0);
    for (int rep = 0; rep < REP_SYNC; ++rep) xcd_barrier(bar);
    float* X = args.out + O_Y;
    bf16* XB = (bf16*)(ws + WS_XB); float* SS = (float*)(ws + WS_SS);
#pragma unroll 1
    for (int l = 0; l < 2; ++l) {
        const int pb = 1 + 6 * l;
        if (IN(pb)) for (int rep = 0; rep < REP_INP; ++rep) {
            pg8::Gemm g{XB, (const bf16*)(ws + WS_WIN) + (size_t)l * INW * 1024, MT, INW, 1024}; pg8::StaticOrder S; S.init(MT, INW, F.G, (int)blockIdx.x);
            pg8::EpiInProj E{SS, (const float*)(ws + WS_TAB), (bf16*)(ws + WS_UP), (bf16*)(ws + WS_Q), (bf16*)(ws + WS_K), (bf16*)(ws + WS_V), (bf16*)(ws + WS_UC),
                args.out + O_KP + (size_t)l * 8 * 2048 * 512, args.out + O_KS + (size_t)l * 8 * 32 * 512, args.out + O_VP + (size_t)l * 8 * 2048 * 512, args.out + O_VS + (size_t)l * 8 * 32 * 512};
            pg8::gemm_phase<pg8::EpiInProj, pg8::StaticOrder, PG8_ALIGN, PG8_SP2>(lds, g, S, E);
            if (SLACK_W && rep == 0) { if (l == 0) slack_weights(F, args, lds, (MT / 256) * (INW / 256), WI_A, WI_B); else slack_weights(F, args, lds, (MT / 256) * (INW / 256), WI_C, WI_END); }
        }
        SEAM(pb);
        if (IN(pb + 1)) for (int rep = 0; rep < REP_ATT; ++rep) {
            const int bh = F.vcu >> 3, jj = F.vcu & 7, a = jj & 3, c = jj >> 2, b = bh >> 2, h = bh & 3;
            const attn_body::bf16* Qp = (const attn_body::bf16*)(ws + WS_Q); const attn_body::bf16* Kp = (const attn_body::bf16*)(ws + WS_K); const attn_body::bf16* Vp = (const attn_body::bf16*)(ws + WS_V);
            attn_body::bf16* Op = (attn_body::bf16*)(ws + WS_O4);
            const int spos = F.vcu % 5;
#pragma unroll 1
            for (int i = 0; i < 5; ++i) {
                if (i == spos) { sample_attn_unit(F, args, l, F.vcu >> 3, F.vcu & 7, lds); }
                else { const int k = i - (i > spos ? 1 : 0); const int vh = k >> 1, qb = (k & 1) ? 7 - a : a;
                    attn_body::attn_unit<8>(b, 2 * h + c, 2 * h + vh, qb, Qp, Kp, Vp, Op, h * 256 + c * 128 + vh * 64, (char*)lds_raw); __syncthreads(); }
            }
        }
        SEAM(pb + 1);
        if (IN(pb + 2)) for (int rep = 0; rep < REP_MIX; ++rep) {
            int mlane = F.lane; asm volatile("" : "+v"(mlane));
            const float lam = ((const float*)(ws + WS_LAM))[l]; const float osc = 1.0f - (0.8f - 0.6f * expf(-0.3f * (float)l));
            const bool heavy = (F.NGW == 2048) && ((F.gw & 63) == 0);
            const int lgw = (F.NGW == 2048) ? F.gw - ((F.gw + 63) >> 6) : F.gw, lng = (F.NGW == 2048) ? 2016 : F.NGW;
#pragma unroll 1
            for (int k = 0; k < 2; ++k) { if (k == 1 && !heavy) break; conv_item(args, l, k == 0 ? F.gw : MP / 8 + (F.gw >> 6), mlane); }
            if (!heavy) {
            const int xq = F.vcu >> 5, gq = F.gw & 255, lw = gq - ((gq + 63) >> 6);
            (void)lgw; (void)lng;
            for (int j = lw; j < 1040; j += 252) pool_item(args, l, j < 1024 ? 1024 * xq + j : 8192 + 16 * xq + (j - 1024), mlane);
            for (int j = lw; j < 512; j += 252) post_item(args, l, (512 * xq + j) * 4, mlane, lam, osc);
            for (int j = lw; j < 128; j += 252) scomb_item(args, l, 128 * xq + j, mlane, lam, osc);
            }
        }
        SEAM(pb + 2);
#ifndef REP_OUT0
#define REP_OUT0 1
#endif
#ifndef REP_SYNC
#define REP_SYNC 0
#endif
#ifndef REP_FOLD
#define REP_FOLD 1
#endif
#ifndef REP_SLACK
#define REP_SLACK 1
#endif
#ifndef SLACK_W
#define SLACK_W 1
#endif
        if (IN(pb + 3)) for (int rep = 0; rep < (l == 0 ? REP_OUT0 : 1); ++rep) {
            pg8::Gemm g{(const bf16*)(ws + WS_MIX), (const bf16*)(ws + WS_WOUT) + (size_t)l * 1024 * 1024, MP, 1024, 1024}; pg8::StaticOrder S; S.init(MP, 1024, F.G, (int)blockIdx.x);
            pg8::EpiRes E{XB, SS, 0};
            pg8::gemm_phase<pg8::EpiRes, pg8::StaticOrder, PG8_ALIGN, PG8_SP2>(lds, g, S, E);
            sample_gemm_res<8>(F, (const bf16*)(ws + WS_MIX) + (size_t)MP * 1024, 1024, (const bf16*)(ws + WS_WOUT) + (size_t)l * 1024 * 1024, 1024, XB + (size_t)MP * 1024, SS, lds);
        }
        SEAM(pb + 3);
        if (IN(pb + 4)) for (int rep = 0; rep < REP_GU; ++rep) {
            pg8::Gemm g{XB, (const bf16*)(ws + WS_WGU) + (size_t)l * 2 * DFF * 1024, MT, 2 * DFF, 1024}; pg8::StaticOrder S; S.init(MT, 2 * DFF, F.G, (int)blockIdx.x);
            pg8::EpiSwiGLU E{(bf16*)(ws + WS_H), SS};
            pg8::gemm_phase<pg8::EpiSwiGLU, pg8::StaticOrder, PG8_ALIGN, PG8_SP2>(lds, g, S, E);
            if (SLACK_W && rep == 0 && l == 0) slack_weights(F, args, lds, (MT / 256) * (2 * DFF / 256), WI_B, WI_C);
        }
        SEAM(pb + 4);
#ifndef REP_DN
#define REP_DN 1
#endif
        if (IN(pb + 5)) for (int rep = 0; rep < REP_DN; ++rep) {
            pg8::Gemm g{(const bf16*)(ws + WS_H), (const bf16*)(ws + WS_WDN) + (size_t)l * 1024 * DFF, MP, 1024, DFF}; pg8::StaticOrder S; S.init(MP, 1024, F.G, (int)blockIdx.x);
            pg8::EpiRes E{XB, SS, rep < REP_DN - 1};
            pg8::gemm_phase<pg8::EpiRes, pg8::StaticOrder, PG8_ALIGN, PG8_SP2>(lds, g, S, E);
            if (rep == REP_DN - 1) sample_gemm_res<11>(F, (const bf16*)(ws + WS_H) + (size_t)MP * DFF, DFF, (const bf16*)(ws + WS_WDN) + (size_t)l * 1024 * DFF, DFF, XB + (size_t)MP * 1024, SS, lds);
        }
        SEAM(pb + 5);
    }
#ifndef REP_FIN
#define REP_FIN 1
#endif
    if (IN(13)) for (int rep = 0; rep < REP_FIN; ++rep) {
        const float* gf = args.in[21]; int flane = F.lane; asm volatile("" : "+v"(flane));
        for (int m0 = F.gw * 2; m0 < MT; m0 += F.NGW * 2) {
            v4u w[2][2];
#pragma unroll
            for (int q = 0; q < 2; ++q)
#pragma unroll
                for (int j = 0; j < 2; ++j) w[q][j] = *((const v4u*)(XB + (size_t)(m0 + q) * 1024) + flane + 64 * j);
            __builtin_amdgcn_sched_barrier(0);
#pragma unroll
            for (int q = 0; q < 2; ++q) { float v[2][8]; float s = 0.f;
#pragma unroll
                for (int j = 0; j < 2; ++j) { const v4u ww = w[q][j]; v[j][0] = bflo(ww.x); v[j][1] = bfhi(ww.x); v[j][2] = bflo(ww.y); v[j][3] = bfhi(ww.y); v[j][4] = bflo(ww.z); v[j][5] = bfhi(ww.z); v[j][6] = bflo(ww.w); v[j][7] = bfhi(ww.w);
#pragma unroll
                    for (int k = 0; k < 8; ++k) s += v[j][k] * v[j][k]; }
                const float r = rsqrtf(wave_sum(s) * (1.0f / 1024.0f) + 1e-6f);
#pragma unroll
                for (int j = 0; j < 2; ++j) { const f32x4 g0 = *((const f32x4*)gf + 2 * (flane + 64 * j)), g1 = *((const f32x4*)gf + 2 * (flane + 64 * j) + 1);
                    f32x4* yo = (f32x4*)(X + (size_t)(m0 + q) * 1024) + 2 * (flane + 64 * j);
                    yo[0] = (f32x4){v[j][0] * r * g0.x, v[j][1] * r * g0.y, v[j][2] * r * g0.z, v[j][3] * r * g0.w};
                    yo[1] = (f32x4){v[j][4] * r * g1.x, v[j][5] * r * g1.y, v[j][6] * r * g1.z, v[j][7] * r * g1.w}; } } }
    }
#undef IN
#undef SEAM
}

extern "C" void kernel_launch(void* const* d_in, const int* in_sizes, int n_in, void* d_out, int out_size, void* d_ws, size_t ws_size, hipStream_t stream) {
    static int grid = 0;
    if (grid == 0) {
        if (n_in != 22 || out_size != (int)O_END || ws_size < WS_END) { fprintf(stderr, "kernel_launch: unexpected shapes (n_in %d out %d ws %zu)\n", n_in, out_size, ws_size); grid = -1; return; }
        int dev = 0, cus = 0, per_cu = 0;
        hipGetDevice(&dev); hipDeviceGetAttribute(&cus, hipDeviceAttributeMultiprocessorCount, dev);
        if (hipFuncSetAttribute((const void*)mk_fwd, hipFuncAttributeMaxDynamicSharedMemorySize, LDS_BYTES) != hipSuccess) { fprintf(stderr, "kernel_launch: hipFuncSetAttribute failed\n"); grid = -1; return; }
        hipOccupancyMaxActiveBlocksPerMultiprocessor(&per_cu, (const void*)mk_fwd, NWAVES * 64, LDS_BYTES);
        (void)hipGetLastError();
        if (per_cu < 1) { fprintf(stderr, "kernel_launch: occupancy query says %d blocks per CU\n", per_cu); per_cu = 1; }
        grid = cus;
        if (grid > 256) grid = 256;
    }
    if (grid < 0) return;
    if (hipMemsetAsync(d_ws, 0, 65536, stream) != hipSuccess) { fprintf(stderr, "kernel_launch: memset failed\n"); return; }
    Args a{};
    for (int i = 0; i < 22; ++i) a.in[i] = (const float*)d_in[i];
    a.out = (float*)d_out; a.ws = (unsigned char*)d_ws;
#if MK_MULTI
    for (int p = 0; p < NPH; ++p) { a.ph_lo = p; a.ph_hi = p + 1; hipLaunchKernelGGL(mk_fwd, dim3(grid), dim3(NWAVES * 64), LDS_BYTES, stream, a); }
#else
    a.ph_lo = 0; a.ph_hi = NPH;
    void* kargs[] = {&a};
    hipError_t e = hipLaunchCooperativeKernel((const void*)mk_fwd, dim3(grid), dim3(NWAVES * 64), kargs, LDS_BYTES, stream);
    if (e != hipSuccess) fprintf(stderr, "kernel_launch: cooperative launch failed: %s (grid %d)\n", hipGetErrorString(e), grid);
#endif
}
```
